# Optimizing an MI355X kernel written in HIP

```python
import jax, jax.numpy as jnp
from jax import lax
import numpy as np

D_MODEL = 1024
BATCH = 2
SEQ = 8192
DEPTH = 1

HEAD_DIM = 64
RWKV_HEADS = 16
RWKV_DIM = RWKV_HEADS * HEAD_DIM
DECAY_LORA = 64
AAA_LORA = 64
GATE_LORA = 160
GN_EPS = HEAD_DIM * 1e-5
RWKV_IN = 3 * RWKV_DIM + DECAY_LORA + AAA_LORA + GATE_LORA
DIL_GROUPS = ((128, 1), (512, 4), (2048, 16))
HEADS_PER_GROUP = 4
ATTN_HEADS = 3 * HEADS_PER_GROUP
ATTN_DIM = ATTN_HEADS * HEAD_DIM
ATTN_OUT_DIM = HEADS_PER_GROUP * HEAD_DIM
IN_SPLITS = (RWKV_DIM, RWKV_DIM, RWKV_DIM, DECAY_LORA, AAA_LORA, GATE_LORA,
             ATTN_DIM, ATTN_DIM, ATTN_DIM, D_MODEL, D_MODEL)
N_IN = RWKV_IN + 3 * ATTN_DIM + 2 * D_MODEL
MEM_LEN = 256
XATTN_HEADS = 4
XATTN_HEAD_DIM = D_MODEL // XATTN_HEADS
FFN_DIM = 4 * D_MODEL
NORM_EPS = 1e-6

kernel_name = 'hybrid_rwkv7_dilated_alibi_gated'


def rmsnorm(x, g):
    xf = x.astype(jnp.float32)
    y = xf * lax.rsqrt(jnp.mean(xf * xf, axis=-1, keepdims=True) + NORM_EPS) * g.astype(jnp.float32)
    return y.astype(x.dtype)


def alibi_slopes(n_heads):
    return jnp.exp2(-8.0 * (jnp.arange(n_heads, dtype=jnp.float32) + 1.0) / n_heads)


def rwkv7_scan(r, w, k, v, a_, b_):
    B, S, H, N = r.shape

    def step(state, inp):
        r_t, w_t, k_t, v_t, a_t, b_t = inp
        sa = jnp.einsum('bhij,bhj->bhi', state, a_t)
        state = state * w_t[:, :, None, :] + sa[..., None] * b_t[:, :, None, :] + v_t[..., None] * k_t[:, :, None, :]
        return state, jnp.einsum('bhij,bhj->bhi', state, r_t)

    xs = tuple(jnp.moveaxis(t, 1, 0) for t in (r, w, k, v, a_, b_))
    _, ys = lax.scan(step, jnp.zeros((B, H, N, N), jnp.float32), xs)
    return jnp.moveaxis(ys, 0, 1)


def rwkv7_mix(p_r, p_k, p_v, p_wd, p_ad, p_gd, w0, w2, a0, a2, g2, k_k, k_a, r_k, gn_w, gn_b):
    B, S, _ = p_r.shape
    heads = lambda t: t.reshape(B, S, RWKV_HEADS, HEAD_DIM)
    w_log = -jax.nn.softplus(-(w0 + jnp.tanh(p_wd) @ w2)) - 0.5
    decay = jnp.exp(-jnp.exp(w_log))
    a = jax.nn.sigmoid(a0 + p_ad @ a2)
    g = jax.nn.sigmoid(p_gd) @ g2
    kk = heads(p_k * k_k)
    kk = kk / jnp.maximum(jnp.sqrt(jnp.sum(kk * kk, axis=-1, keepdims=True)), 1e-12)
    k = p_k * (1.0 + (a - 1.0) * k_a)
    r, k, v, decay, a = heads(p_r), heads(k), heads(p_v), heads(decay), heads(a)
    y = rwkv7_scan(r, decay, k, v, -kk, kk * a)
    mean = jnp.mean(y, axis=-1, keepdims=True)
    var = jnp.mean(jnp.square(y - mean), axis=-1, keepdims=True)
    yn = ((y - mean) * lax.rsqrt(var + GN_EPS)).reshape(B, S, RWKV_DIM) * gn_w + gn_b
    bonus = (jnp.sum(r * k * r_k, axis=-1, keepdims=True) * v).reshape(B, S, RWKV_DIM)
    return (yn + bonus) * g


def dilated_attention(q, k, v, window, dilation, slopes):
    B, S, H, Dh = q.shape
    blk = window // dilation
    span = blk * dilation
    Sp = -(-S // span) * span
    nb = Sp // span
    padw = ((0, 0), (0, Sp - S), (0, 0), (0, 0))

    def blocks(t):
        return jnp.pad(t, padw).astype(jnp.float32).reshape(B, nb, blk, dilation, H, Dh)

    def with_prev(t):
        prev = jnp.pad(t, ((0, 0), (1, 0), (0, 0), (0, 0), (0, 0), (0, 0)))[:, :-1]
        return jnp.concatenate([prev, t], axis=2)

    qb = blocks(q) * (Dh ** -0.5)
    kc, vc = with_prev(blocks(k)), with_prev(blocks(v))
    s = jnp.einsum('bnqrhc,bnkrhc->bnrhqk', qb, kc)
    qi = jnp.arange(blk)[:, None]
    ki = jnp.arange(2 * blk)[None, :]
    steps = qi + blk - ki
    in_band = (steps >= 0) & (steps <= blk)
    exists = (jnp.arange(nb)[:, None, None] > 0) | (ki >= blk)[None]
    valid = in_band[None] & exists
    bias = -slopes[:, None, None] * (steps * dilation).astype(jnp.float32)[None]
    s = jnp.where(valid[None, :, None, None], s + bias[None, None, None], -jnp.inf)
    lse = jax.nn.logsumexp(s, axis=-1)
    p = jnp.exp(s - lse[..., None])
    o = jnp.einsum('bnrhqk,bnkrhc->bnqrhc', p, vc).reshape(B, Sp, H, Dh)[:, :S]
    lse = jnp.transpose(lse, (0, 1, 4, 2, 3)).reshape(B, Sp, H)[:, :S]
    return o, lse


def dilated_mixture(q, k, v):
    B, S = q.shape[:2]
    slopes = alibi_slopes(ATTN_HEADS)
    outs, lses = [], []
    for gi, (window, dilation) in enumerate(DIL_GROUPS):
        hs = slice(gi * HEADS_PER_GROUP, (gi + 1) * HEADS_PER_GROUP)
        o, l = dilated_attention(q[:, :, hs], k[:, :, hs], v[:, :, hs], window, dilation, slopes[hs])
        outs.append(o)
        lses.append(l)
    wts = jax.nn.softmax(jnp.stack(lses, axis=0), axis=0)
    y = jnp.sum(wts[..., None] * jnp.stack(outs, axis=0), axis=0)
    return y.reshape(B, S, ATTN_OUT_DIM)


def memory_cross_attention(xn, memn, wq, w_kv, wo):
    B, S, _ = xn.shape
    q = (xn @ wq).astype(jnp.float32).reshape(B, S, XATTN_HEADS, XATTN_HEAD_DIM)
    kv = (memn @ w_kv).astype(jnp.float32).reshape(B, MEM_LEN, 2, XATTN_HEADS, XATTN_HEAD_DIM)
    s = jnp.einsum('bshc,bmhc->bhsm', q, kv[:, :, 0]) * (XATTN_HEAD_DIM ** -0.5)
    p = jax.nn.softmax(s, axis=-1)
    o = jnp.einsum('bhsm,bmhc->bshc', p, kv[:, :, 1]).reshape(B, S, D_MODEL)
    return (o @ wo.astype(jnp.float32)).astype(xn.dtype)


def setup_inputs(seed: int = 0) -> dict:
    key = jax.random.key(seed)
    ks = jax.random.split(key, 32)
    f32 = jnp.float32
    nrm = lambda k, shape, scale: jax.random.normal(k, shape, f32) * scale
    L = DEPTH
    return {
        'x': jax.random.normal(ks[0], (BATCH, SEQ, D_MODEL), f32),
        'mem': jax.random.normal(ks[1], (BATCH, MEM_LEN, D_MODEL), f32),
        'norm_mix_g': 1.0 + nrm(ks[2], (L, D_MODEL), 0.02),
        'w_in': nrm(ks[3], (L, D_MODEL, N_IN), D_MODEL ** -0.5),
        'shift_mu': jax.random.uniform(ks[4], (L, RWKV_IN), f32),
        'w0': jax.random.uniform(ks[5], (L, RWKV_DIM), f32, -5.0, 1.0),
        'w2': nrm(ks[6], (L, DECAY_LORA, RWKV_DIM), 0.1),
        'a0': nrm(ks[7], (L, RWKV_DIM), 0.1),
        'a2': nrm(ks[8], (L, AAA_LORA, RWKV_DIM), 0.1),
        'g2': nrm(ks[9], (L, GATE_LORA, RWKV_DIM), GATE_LORA ** -0.5),
        'k_k': 0.85 + nrm(ks[10], (L, RWKV_DIM), 0.05),
        'k_a': 1.0 + nrm(ks[11], (L, RWKV_DIM), 0.05),
        'r_k': nrm(ks[12], (L, RWKV_HEADS, HEAD_DIM), 0.1),
        'gn_w': 1.0 + nrm(ks[13], (L, RWKV_DIM), 0.02),
        'gn_b': nrm(ks[14], (L, RWKV_DIM), 0.02),
        'p_rwkv': nrm(ks[15], (L, RWKV_DIM, D_MODEL), RWKV_DIM ** -0.5),
        'p_attn': nrm(ks[16], (L, ATTN_OUT_DIM, D_MODEL), ATTN_OUT_DIM ** -0.5),
        'w_out': nrm(ks[17], (L, D_MODEL, D_MODEL), D_MODEL ** -0.5),
        'norm_x_g': 1.0 + nrm(ks[18], (L, D_MODEL), 0.02),
        'norm_mem_g': 1.0 + nrm(ks[19], (L, D_MODEL), 0.02),
        'xa_wq': nrm(ks[20], (L, D_MODEL, D_MODEL), D_MODEL ** -0.5),
        'xa_wkv': nrm(ks[21], (L, D_MODEL, 2 * D_MODEL), D_MODEL ** -0.5),
        'xa_wo': nrm(ks[22], (L, D_MODEL, D_MODEL), D_MODEL ** -0.5),
        'norm_ffn_g': 1.0 + nrm(ks[23], (L, D_MODEL), 0.02),
        'ffn_w1': nrm(ks[24], (L, D_MODEL, FFN_DIM), D_MODEL ** -0.5),
        'ffn_w2': nrm(ks[25], (L, FFN_DIM, D_MODEL), FFN_DIM ** -0.5),
        'norm_final_g': 1.0 + nrm(ks[26], (D_MODEL,), 0.02),
    }


def reference(x, mem, norm_mix_g, w_in, shift_mu, w0, w2, a0, a2, g2, k_k, k_a, r_k, gn_w, gn_b,
              p_rwkv, p_attn, w_out, norm_x_g, norm_mem_g, xa_wq, xa_wkv, xa_wo,
              norm_ffn_g, ffn_w1, ffn_w2, norm_final_g):
    f32 = jnp.float32
    B, S, _ = x.shape
    bounds = list(np.cumsum(IN_SPLITS)[:-1])
    h = x
    for l in range(DEPTH):
        n = rmsnorm(h, norm_mix_g[l])
        proj = (n @ w_in[l]).astype(f32)
        rw = proj[..., :RWKV_IN]
        rw_prev = jnp.pad(rw, ((0, 0), (1, 0), (0, 0)))[:, :-1]
        proj = jnp.concatenate([rw + shift_mu[l].astype(f32) * (rw_prev - rw), proj[..., RWKV_IN:]], axis=-1)
        (p_r, p_k, p_v, p_wd, p_ad, p_gd, q, k, v, gate_r, gate_a) = jnp.split(proj, bounds, axis=-1)
        y_rwkv = rwkv7_mix(p_r, p_k, p_v, p_wd, p_ad, p_gd,
                           w0[l].astype(f32), w2[l].astype(f32), a0[l].astype(f32), a2[l].astype(f32),
                           g2[l].astype(f32), k_k[l].astype(f32), k_a[l].astype(f32), r_k[l].astype(f32),
                           gn_w[l].astype(f32), gn_b[l].astype(f32))
        hd = lambda t: t.reshape(B, S, ATTN_HEADS, HEAD_DIM)
        y_attn = dilated_mixture(hd(q), hd(k), hd(v))
        merged = (jax.nn.sigmoid(gate_r) * (y_rwkv @ p_rwkv[l].astype(f32))
                  + jax.nn.sigmoid(gate_a) * (y_attn @ p_attn[l].astype(f32)))
        h = h + (merged @ w_out[l].astype(f32)).astype(h.dtype)
        h = h + memory_cross_attention(rmsnorm(h, norm_x_g[l]), rmsnorm(mem, norm_mem_g[l]),
                                       xa_wq[l], xa_wkv[l], xa_wo[l])
        u = rmsnorm(h, norm_ffn_g[l]) @ ffn_w1[l]
        h = h + (jnp.square(jax.nn.relu(u)) @ ffn_w2[l]).astype(h.dtype)
    return rmsnorm(h, norm_final_g)
```

```cpp
#include <hip/hip_runtime.h>
#include <cstdint>
#include <cstdio>

typedef unsigned short bf16_t;
typedef float f32x4 __attribute__((ext_vector_type(4)));

constexpr int BATCH = 2, SEQ = 8192, M = BATCH * SEQ, D = 1024;
constexpr int NIN = 7712;
constexpr int C_LORA = 3072, C_AQ = 3360, C_GATE = 5664;
constexpr int NLORA = 288, NAQKV = 2304, NGATE = 2048, NRKV = 3072;
constexpr int MEMLEN = 256, FF = 4096, KCAT = 1280;
constexpr int CH = 32;

constexpr size_t KiB = 1024, MiB = 1024 * 1024;
constexpr size_t WS_CTL = 0;
constexpr size_t WS_XN = 17 * MiB + 512 * KiB;
constexpr size_t WS_ACAT = WS_XN;
constexpr size_t WS_RKV = 57 * MiB + 512 * KiB;
constexpr size_t WS_LORA = 153 * MiB + 512 * KiB;
constexpr size_t WS_AQKV = 162 * MiB + 512 * KiB;
constexpr size_t WS_G = 234 * MiB + 512 * KiB;
constexpr size_t WS_WST = WS_G + 4 * MiB + 512 * KiB;
constexpr size_t WS_VWT = WS_WST + 4 * MiB;
constexpr size_t WS_KV = WS_VWT + 4 * MiB + 4 * MiB;
constexpr size_t WS_MEMN = WS_KV + 2 * MiB;
constexpr size_t WS_SS1 = WS_MEMN + 1 * MiB;
constexpr size_t WS_SS2 = WS_SS1 + 256 * KiB;
constexpr size_t WS_SS3 = WS_SS2 + 256 * KiB;
static_assert(WS_SS3 + 256 * KiB <= 256 * MiB, "ws map");
constexpr size_t WS_H2B = 73 * MiB + 512 * KiB;
constexpr size_t WS_S32 = WS_H2B;
constexpr size_t WS_S32A = 169 * MiB + 512 * KiB;
constexpr size_t WS_MERGED = 105 * MiB + 512 * KiB;
constexpr size_t WS_H1B = 137 * MiB + 512 * KiB;
constexpr size_t WS_PROB = 169 * MiB + 512 * KiB;
constexpr size_t WS_ACT = 105 * MiB + 512 * KiB;

constexpr int NTHREADS = 512, NWAVES = 8;
constexpr int LDS_BYTES = 147456;

__device__ __forceinline__ float bf2f(bf16_t v) { return __uint_as_float(((unsigned)v) << 16); }
__device__ __forceinline__ bf16_t f2bf(float f) { unsigned u = __float_as_uint(f); return (bf16_t)((u + 0x7fffu + ((u >> 16) & 1u)) >> 16); }
__device__ __forceinline__ float sigmoidf_(float x) { return 1.f / (1.f + __expf(-x)); }
__device__ __forceinline__ float wave_sum(float v) {
#pragma unroll
    for (int o = 1; o < 64; o <<= 1) v += __shfl_xor(v, o);
    return v;
}
__device__ __forceinline__ float wave_max(float v) {
#pragma unroll
    for (int o = 1; o < 64; o <<= 1) v = fmaxf(v, __shfl_xor(v, o));
    return v;
}

struct Args {
    const float* in[27];
    float* out;
    unsigned char* ws;
    int ph_lo, ph_hi;
};

enum { I_X = 0, I_MEM, I_NMIX, I_WIN, I_MU, I_W0, I_W2, I_A0, I_A2, I_G2, I_KK, I_KA, I_RK, I_GNW, I_GNB, I_PRWKV, I_PATTN, I_WOUT,
       I_NX, I_NMEM, I_WQ, I_WKV, I_WO, I_NFFN, I_W1, I_FW2, I_NFIN };

template <class AF, class BF, class EF>
__device__ __forceinline__ void naive_gemm(float* lds, int Mx, int Nx, int Kx, int unit0, int ustride, AF af, BF bf, EF ef) {
    float* As = lds;
    float* Bs = lds + 32 * 132;
    const int tid = threadIdx.x, ty = tid >> 4, tx = tid & 15;
    const int tm = Mx / 128, tn = (Nx + 63) / 64;
    for (int u = unit0; u < tm * tn; u += ustride) {
        const int m0 = (u / tn) * 128, n0 = (u % tn) * 64;
        float acc[4][4];
#pragma unroll
        for (int i = 0; i < 4; ++i)
#pragma unroll
            for (int j = 0; j < 4; ++j) acc[i][j] = 0.f;
        for (int k0 = 0; k0 < Kx; k0 += 32) {
            __syncthreads();
#pragma unroll
            for (int i = 0; i < 8; ++i) { const int idx = tid + i * 512, k = idx & 31, r = idx >> 5; As[k * 132 + r] = af(m0 + r, k0 + k); }
#pragma unroll
            for (int i = 0; i < 4; ++i) { const int idx = tid + i * 512, n = idx & 63, k = idx >> 6; Bs[k * 68 + n] = (n0 + n < Nx) ? bf(k0 + k, n0 + n) : 0.f; }
            __syncthreads();
#pragma unroll 8
            for (int k = 0; k < 32; ++k) {
                const f32x4 a = *(const f32x4*)(As + k * 132 + ty * 4), b = *(const f32x4*)(Bs + k * 68 + tx * 4);
#pragma unroll
                for (int i = 0; i < 4; ++i)
#pragma unroll
                    for (int j = 0; j < 4; ++j) acc[i][j] += a[i] * b[j];
            }
        }
#pragma unroll
        for (int i = 0; i < 4; ++i)
#pragma unroll
            for (int j = 0; j < 4; ++j) { const int n = n0 + tx * 4 + j; if (n < Nx) ef(m0 + ty * 4 + i, n, acc[i][j]); }
    }
    __syncthreads();
}

__device__ __forceinline__ void scan_naive(const Args& a, float* lds, int bh) {
    const int b = bh >> 4, h = bh & 15;
    const int tid = threadIdx.x, lane = tid & 63, wave = tid >> 6;
    const bf16_t* RKV = (const bf16_t*)(a.ws + WS_RKV);
    const bf16_t* LORA = (const bf16_t*)(a.ws + WS_LORA);
    bf16_t* ACAT = (bf16_t*)(a.ws + WS_ACAT);
    const float* mu = a.in[I_MU];
    float* actW = lds;
    float* actA = actW + CH * 64;
    float* actG = actA + CH * 64;
    float* Wd = actG + CH * 160;
    float* Kk = Wd + CH * 64;
    float* Aa = Kk + CH * 64;
    float* Bb = Aa + CH * 64;
    float* Rr = Bb + CH * 64;
    float* Vv = Rr + CH * 64;
    float* Gg = Vv + CH * 64;
    float* Yy = Gg + CH * 64;
    float* bon = Yy + CH * 64;
    const int hj0 = h * 64;
    float st[8];
#pragma unroll
    for (int e = 0; e < 8; ++e) st[e] = 0.f;
    const int row_i = wave * 8 + (lane >> 3), cg = lane & 7;
    for (int c0 = 0; c0 < SEQ; c0 += CH) {
        const size_t m0 = (size_t)b * SEQ + c0;
        __syncthreads();
        for (int idx = tid; idx < CH * NLORA; idx += NTHREADS) {
            const int t = idx / NLORA, c = idx % NLORA;
            const float cur = bf2f(LORA[(m0 + t) * NLORA + c]);
            const float prev = (c0 + t == 0) ? 0.f : bf2f(LORA[(m0 + t - 1) * NLORA + c]);
            const float s = cur + mu[C_LORA + c] * (prev - cur);
            if (c < 64) actW[t * 64 + c] = tanhf(s);
            else if (c < 128) actA[t * 64 + c - 64] = s;
            else actG[t * 160 + c - 128] = sigmoidf_(s);
        }
        for (int idx = tid; idx < CH * 64; idx += NTHREADS) {
            const int t = idx >> 6, j = idx & 63;
            const bool first = (c0 + t == 0);
#pragma unroll
            for (int q = 0; q < 3; ++q) {
                const int col = q * 1024 + hj0 + j;
                const float cur = bf2f(RKV[(m0 + t) * NRKV + col]);
                const float prev = first ? 0.f : bf2f(RKV[(m0 + t - 1) * NRKV + col]);
                const float s = cur + mu[col] * (prev - cur);
                if (q == 0) Rr[idx] = s; else if (q == 1) Kk[idx] = s; else Vv[idx] = s;
            }
        }
        __syncthreads();
        for (int idx = tid; idx < CH * 64; idx += NTHREADS) {
            const int t = idx >> 6, j = idx & 63, hj = hj0 + j;
            float wp = a.in[I_W0][hj], ap = a.in[I_A0][hj], g = 0.f;
            for (int c = 0; c < 64; ++c) { wp += actW[t * 64 + c] * a.in[I_W2][c * 1024 + hj]; ap += actA[t * 64 + c] * a.in[I_A2][c * 1024 + hj]; }
            for (int c = 0; c < 160; ++c) g += actG[t * 160 + c] * a.in[I_G2][c * 1024 + hj];
            const float z = -wp;
            const float sp = fmaxf(z, 0.f) + log1pf(__expf(-fabsf(z)));
            const float wlog = -sp - 0.5f;
            Wd[idx] = __expf(-__expf(wlog));
            Aa[idx] = sigmoidf_(ap);
            Gg[idx] = g;
        }
        __syncthreads();
#pragma unroll
        for (int q = 0; q < 4; ++q) {
            const int t = wave * 4 + q, idx = t * 64 + lane, hj = hj0 + lane;
            const float pk = Kk[idx], alr = Aa[idx];
            const float kr = pk * a.in[I_KK][hj];
            const float ss = wave_sum(kr * kr);
            const float kk = kr / fmaxf(sqrtf(ss), 1e-12f);
            const float kmod = pk * (1.f + (alr - 1.f) * a.in[I_KA][hj]);
            const float bs = wave_sum(Rr[idx] * kmod * a.in[I_RK][hj]);
            Aa[idx] = -kk; Bb[idx] = kk * alr; Kk[idx] = kmod;
            if (lane == 0) bon[t] = bs;
        }
        __syncthreads();
        for (int t = 0; t < CH; ++t) {
            const float* ap = Aa + t * 64 + cg * 8; const float* wp = Wd + t * 64 + cg * 8; const float* kp = Kk + t * 64 + cg * 8;
            const float* bp = Bb + t * 64 + cg * 8; const float* rp = Rr + t * 64 + cg * 8;
            float sa = 0.f;
#pragma unroll
            for (int e = 0; e < 8; ++e) sa += st[e] * ap[e];
            sa += __shfl_xor(sa, 1); sa += __shfl_xor(sa, 2); sa += __shfl_xor(sa, 4);
            const float vi = Vv[t * 64 + row_i];
            float y = 0.f;
#pragma unroll
            for (int e = 0; e < 8; ++e) { st[e] = st[e] * wp[e] + sa * bp[e] + vi * kp[e]; y += st[e] * rp[e]; }
            y += __shfl_xor(y, 1); y += __shfl_xor(y, 2); y += __shfl_xor(y, 4);
            if (cg == 0) Yy[t * 64 + row_i] = y;
        }
        __syncthreads();
#pragma unroll
        for (int q = 0; q < 4; ++q) {
            const int t = wave * 4 + q, idx = t * 64 + lane, hi = hj0 + lane;
            const float y = Yy[idx];
            const float mean = wave_sum(y) * (1.f / 64.f);
            const float dy = y - mean;
            const float var = wave_sum(dy * dy) * (1.f / 64.f);
            const float yn = dy * rsqrtf(var + 64.f * 1e-5f) * a.in[I_GNW][hi] + a.in[I_GNB][hi];
            const float o = (yn + bon[t] * Vv[idx]) * Gg[idx];
            ACAT[(m0 + t) * KCAT + hi] = f2bf(o);
        }
    }
}

__device__ __forceinline__ void dil_attn_naive(const Args& a, float* lds, int wave_gid, int nwaves_total) {
    const int lane = threadIdx.x & 63, wave = threadIdx.x >> 6;
    const bf16_t* AQ = (const bf16_t*)(a.ws + WS_AQKV);
    bf16_t* ACAT = (bf16_t*)(a.ws + WS_ACAT);
    float* pbuf = lds + wave * 640;
    float* qs = pbuf + 448;
    for (int task = wave_gid; task < M * 4; task += nwaves_total) {
        const int m = task >> 2, s = task & 3, p = m & (SEQ - 1);
#pragma unroll
        for (int g = 0; g < 3; ++g) qs[g * 64 + lane] = bf2f(AQ[(size_t)m * NAQKV + (g * 4 + s) * 64 + lane]);
        float sc[7];
        float mx = -INFINITY;
#pragma unroll
        for (int i = 0; i < 7; ++i) {
            const int idx = lane + i * 64;
            float v = -INFINITY;
            if (idx < 387) {
                const int g = idx / 129, stp = idx % 129, dil = (g == 0) ? 1 : (g == 1 ? 4 : 16), hd = g * 4 + s;
                if (stp * dil <= p) {
                    const bf16_t* kr = AQ + (size_t)(m - stp * dil) * NAQKV + 768 + hd * 64;
                    float dot = 0.f;
                    for (int c = 0; c < 64; ++c) dot += qs[g * 64 + c] * bf2f(kr[c]);
                    const float slope = exp2f(-8.f * (float)(hd + 1) / 12.f);
                    v = dot * 0.125f - slope * (float)(stp * dil);
                }
            }
            sc[i] = v; mx = fmaxf(mx, v);
        }
        mx = wave_max(mx);
        float sum = 0.f;
#pragma unroll
        for (int i = 0; i < 7; ++i) { const int idx = lane + i * 64; const float e = (sc[i] == -INFINITY) ? 0.f : __expf(sc[i] - mx); sum += e; if (idx < 448) pbuf[idx] = e; }
        sum = wave_sum(sum);
        float acc = 0.f;
        for (int idx = 0; idx < 387; ++idx) {
            const int g = idx / 129, stp = idx % 129, dil = (g == 0) ? 1 : (g == 1 ? 4 : 16), hd = g * 4 + s;
            if (stp * dil <= p) acc += pbuf[idx] * bf2f(AQ[(size_t)(m - stp * dil) * NAQKV + 1536 + hd * 64 + lane]);
        }
        ACAT[(size_t)m * KCAT + 1024 + s * 64 + lane] = f2bf(acc / sum);
    }
}

template <int PH> __global__ void __launch_bounds__(NTHREADS, 2) mk_fwd(Args a) {
    extern __shared__ __attribute__((aligned(16))) unsigned char lds_raw[];
    float* lds = (float*)lds_raw;
    const int tid = threadIdx.x, lane = tid & 63, wave = tid >> 6;
    const int G = gridDim.x, bid = blockIdx.x;
    const int gw = bid * NWAVES + wave, NGW = G * NWAVES;
    unsigned char* ws = a.ws;
    bf16_t* XN = (bf16_t*)(ws + WS_XN); bf16_t* RKV = (bf16_t*)(ws + WS_RKV); bf16_t* LORA = (bf16_t*)(ws + WS_LORA); bf16_t* AQKV = (bf16_t*)(ws + WS_AQKV);
    bf16_t* GATES = (bf16_t*)a.out; bf16_t* ACAT = (bf16_t*)(ws + WS_ACAT); bf16_t* WST = (bf16_t*)(ws + WS_WST); bf16_t* VWT = (bf16_t*)(ws + WS_VWT);
    bf16_t* KV = (bf16_t*)(ws + WS_KV); bf16_t* MEMN = (bf16_t*)(ws + WS_MEMN);
    float* SS1 = (float*)(ws + WS_SS1); float* SS2 = (float*)(ws + WS_SS2); float* SS3 = (float*)(ws + WS_SS3);
    bf16_t* H2B = (bf16_t*)(ws + WS_H2B); float* S32 = (float*)(ws + WS_S32); float* S32A = (float*)(ws + WS_S32A); bf16_t* MERGED = (bf16_t*)(ws + WS_MERGED); bf16_t* H1B = (bf16_t*)(ws + WS_H1B);
    bf16_t* PROB = (bf16_t*)(ws + WS_PROB); bf16_t* ACT = (bf16_t*)(ws + WS_ACT);
    float* OUT = a.out;

    {
        constexpr int ph = PH;
        if constexpr (ph == 0) {
            for (int r = gw; r < M + 512; r += NGW) {
                const bool ism = r >= M; const int rr = ism ? r - M : r;
                const float* src = (ism ? a.in[I_MEM] : a.in[I_X]) + (size_t)rr * D; const float* g = ism ? a.in[I_NMEM] : a.in[I_NMIX];
                bf16_t* dst = (ism ? MEMN : XN) + (size_t)rr * D;
                float v[16]; float ss = 0.f;
#pragma unroll
                for (int i = 0; i < 16; ++i) { v[i] = src[lane + 64 * i]; ss += v[i] * v[i]; }
                const float rstd = rsqrtf(wave_sum(ss) * (1.f / D) + 1e-6f);
#pragma unroll
                for (int i = 0; i < 16; ++i) dst[lane + 64 * i] = f2bf(v[i] * rstd * g[lane + 64 * i]);
            }
        } else if constexpr (ph == 1) {
            const float* W = a.in[I_WIN];
            naive_gemm(lds, M, NIN, D, bid, G,
                [&](int m, int k) { return bf2f(XN[(size_t)m * D + k]); },
                [&](int k, int n) { return W[(size_t)k * NIN + n]; },
                [&](int m, int n, float v) {
                    if (n < C_LORA) RKV[(size_t)m * NRKV + n] = f2bf(v);
                    else if (n < C_AQ) LORA[(size_t)m * NLORA + n - C_LORA] = f2bf(v);
                    else if (n < C_GATE) AQKV[(size_t)m * NAQKV + n - C_AQ] = f2bf(v);
                    else GATES[(size_t)m * NGATE + n - C_GATE] = f2bf(sigmoidf_(v));
                });
            const float* WKV = a.in[I_WKV];
            naive_gemm(lds, 512, 2048, D, bid, G,
                [&](int m, int k) { return bf2f(MEMN[(size_t)m * D + k]); },
                [&](int k, int n) { return WKV[(size_t)k * 2048 + n]; },
                [&](int m, int n, float v) { KV[(size_t)m * 2048 + n] = f2bf(v); });
        } else if constexpr (ph == 2) {
            const float* WQ = a.in[I_WQ]; const float* WO = a.in[I_WO]; const float* GX = a.in[I_NX];
            for (int bh = 0; bh < 8; ++bh) {
                const int b = bh >> 2, h = bh & 3;
                naive_gemm(lds, 256, 1024, 256, bid, G,
                    [&](int m, int k) { return bf2f(KV[(size_t)(b * 256 + m) * 2048 + h * 256 + k]); },
                    [&](int k, int n) { return WQ[(size_t)n * 1024 + h * 256 + k]; },
                    [&](int m, int n, float v) { WST[((size_t)b * 1024 + h * 256 + m) * 1024 + n] = f2bf(v * GX[n] * 0.0625f); });
                naive_gemm(lds, 1024, 256, 256, bid, G,
                    [&](int m, int k) { return WO[(size_t)(h * 256 + k) * 1024 + m]; },
                    [&](int k, int n) { return bf2f(KV[(size_t)(b * 256 + n) * 2048 + 1024 + h * 256 + k]); },
                    [&](int m, int n, float v) { VWT[((size_t)b * 1024 + m) * 1024 + h * 256 + n] = f2bf(v); });
            }
        } else if constexpr (ph == 3) {
            if (bid < 32) scan_naive(a, lds, bid);
            else dil_attn_naive(a, lds, (bid - 32) * NWAVES + wave, (G - 32) * NWAVES);
        } else if constexpr (ph == 5) {
            const float* PR = a.in[I_PRWKV]; const float* PA = a.in[I_PATTN];
            naive_gemm(lds, M, D, 1024, bid, G,
                [&](int m, int k) { return bf2f(ACAT[(size_t)m * KCAT + k]); },
                [&](int k, int n) { return PR[(size_t)k * D + n]; },
                [&](int m, int n, float v) { S32A[(size_t)m * D + n] = v * bf2f(GATES[(size_t)m * NGATE + n]); });
            __syncthreads();
            naive_gemm(lds, M, D, 256, bid, G,
                [&](int m, int k) { return bf2f(ACAT[(size_t)m * KCAT + 1024 + k]); },
                [&](int k, int n) { return PA[(size_t)k * D + n]; },
                [&](int m, int n, float v) { MERGED[(size_t)m * D + n] = f2bf(S32A[(size_t)m * D + n] + v * bf2f(GATES[(size_t)m * NGATE + 1024 + n])); });
        } else if constexpr (ph == 7) {
            const float* W = a.in[I_WOUT]; const float* X = a.in[I_X];
            naive_gemm(lds, M, D, D, bid, G,
                [&](int m, int k) { return bf2f(MERGED[(size_t)m * D + k]); },
                [&](int k, int n) { return W[(size_t)k * D + n]; },
                [&](int m, int n, float v) { const float h = X[(size_t)m * D + n] + v; OUT[(size_t)m * D + n] = h; H1B[(size_t)m * D + n] = f2bf(h); });
        } else if constexpr (ph == 71 || ph == 91 || ph == 111) {
            float* SS = (ph == 71) ? SS1 : (ph == 91 ? SS2 : SS3);
            for (int r = gw; r < M; r += NGW) {
                float ss = 0.f;
#pragma unroll
                for (int i = 0; i < 16; ++i) { const float v = OUT[(size_t)r * D + lane + 64 * i]; ss += v * v; }
                ss = wave_sum(ss);
                if (lane < 4) SS[r * 4 + lane] = (lane == 0) ? ss : 0.f;
            }
        } else if constexpr (ph == 8) {
            for (int b = 0; b < 2; ++b)
                naive_gemm(lds, SEQ, D, D, bid, G,
                    [&](int m, int k) { return bf2f(H1B[(size_t)(b * SEQ + m) * D + k]); },
                    [&](int k, int n) { return bf2f(WST[((size_t)b * 1024 + n) * 1024 + k]); },
                    [&](int m, int n, float v) { const int mm = b * SEQ + m; const float* s = SS1 + mm * 4;
                        const float rstd = rsqrtf((s[0] + s[1] + s[2] + s[3]) * (1.f / D) + 1e-6f); S32[(size_t)mm * D + n] = v * rstd; });
        } else if constexpr (ph == 81) {
            for (int task = gw; task < M * 4; task += NGW) {
                const float* s = S32 + (size_t)task * 256; float v[4]; float mx = -INFINITY;
#pragma unroll
                for (int i = 0; i < 4; ++i) { v[i] = s[lane + 64 * i]; mx = fmaxf(mx, v[i]); }
                mx = wave_max(mx); float sum = 0.f;
#pragma unroll
                for (int i = 0; i < 4; ++i) { v[i] = __expf(v[i] - mx); sum += v[i]; }
                const float inv = 1.f / wave_sum(sum);
#pragma unroll
                for (int i = 0; i < 4; ++i) PROB[(size_t)task * 256 + lane + 64 * i] = f2bf(v[i] * inv);
            }
        } else if constexpr (ph == 9) {
            for (int b = 0; b < 2; ++b)
                naive_gemm(lds, SEQ, D, D, bid, G,
                    [&](int m, int k) { return bf2f(PROB[(size_t)(b * SEQ + m) * D + k]); },
                    [&](int k, int n) { return bf2f(VWT[((size_t)b * 1024 + n) * 1024 + k]); },
                    [&](int m, int n, float v) { const size_t o = (size_t)(b * SEQ + m) * D + n; const float h = OUT[o] + v; OUT[o] = h; H2B[o] = f2bf(h); });
        } else if constexpr (ph == 10) {
            const float* W = a.in[I_W1]; const float* GF = a.in[I_NFFN];
            naive_gemm(lds, M, FF, D, bid, G,
                [&](int m, int k) { return bf2f(H2B[(size_t)m * D + k]); },
                [&](int k, int n) { return W[(size_t)k * FF + n] * GF[k]; },
                [&](int m, int n, float v) { const float* s = SS2 + m * 4; const float rstd = rsqrtf((s[0] + s[1] + s[2] + s[3]) * (1.f / D) + 1e-6f);
                    const float u = fmaxf(v * rstd, 0.f); ACT[(size_t)m * FF + n] = f2bf(u * u); });
        } else if constexpr (ph == 11) {
            const float* W = a.in[I_FW2];
            naive_gemm(lds, M, D, FF, bid, G,
                [&](int m, int k) { return bf2f(ACT[(size_t)m * FF + k]); },
                [&](int k, int n) { return W[(size_t)k * D + n]; },
                [&](int m, int n, float v) { OUT[(size_t)m * D + n] += v; });
        } else if constexpr (ph == 12) {
            const float* g = a.in[I_NFIN];
            for (int r = gw; r < M; r += NGW) {
                const float* s = SS3 + r * 4; const float rstd = rsqrtf((s[0] + s[1] + s[2] + s[3]) * (1.f / D) + 1e-6f);
#pragma unroll
                for (int i = 0; i < 16; ++i) { const size_t o = (size_t)r * D + lane + 64 * i; OUT[o] = OUT[o] * rstd * g[lane + 64 * i]; }
            }
        }
    }
}

extern "C" void kernel_launch(void* const* d_in, const int* in_sizes, int n_in, void* d_out, int out_size, void* d_ws, size_t ws_size, hipStream_t stream) {
    static int grid = 0;
    if (grid == 0) {
        if (n_in != 27 || out_size != M * D || ws_size < 256 * MiB) { fprintf(stderr, "kernel_launch: unexpected shapes (n_in %d out %d ws %zu)\n", n_in, out_size, ws_size); grid = -1; return; }
        grid = 256;
    }
    if (grid < 0) return;
    Args a{};
    for (int i = 0; i < 27; ++i) a.in[i] = (const float*)d_in[i];
    a.out = (float*)d_out; a.ws = (unsigned char*)d_ws;
#define LAUNCH(PH) do { if (first) (void)hipFuncSetAttribute((const void*)mk_fwd<PH>, hipFuncAttributeMaxDynamicSharedMemorySize, LDS_BYTES); \
        hipLaunchKernelGGL(mk_fwd<PH>, dim3(grid), dim3(NTHREADS), LDS_BYTES, stream, a); } while (0)
    static bool first = true;
    LAUNCH(0); LAUNCH(1); LAUNCH(2); LAUNCH(3); LAUNCH(5); LAUNCH(7); LAUNCH(71); LAUNCH(8); LAUNCH(81); LAUNCH(9); LAUNCH(91); LAUNCH(10); LAUNCH(11); LAUNCH(111); LAUNCH(12);
    first = false;
}
```

```cpp
#include <hip/hip_runtime.h>
#include <cstdint>
#include <cstdio>

typedef unsigned short bf16_t;
typedef float f32x4 __attribute__((ext_vector_type(4)));

constexpr int BATCH = 2, SEQ = 8192, M = BATCH * SEQ, D = 1024;
constexpr int NIN = 7712;
constexpr int C_LORA = 3072, C_AQ = 3360, C_GATE = 5664;
constexpr int NLORA = 288, NAQKV = 2304, NGATE = 2048, NRKV = 3072;
constexpr int MEMLEN = 256, FF = 4096, KCAT = 1280;
constexpr int CH = 32;

constexpr size_t KiB = 1024, MiB = 1024 * 1024;
constexpr size_t WS_CTL = 0;
constexpr size_t WS_WINT = 2 * MiB;
constexpr size_t WS_XN = 17 * MiB + 512 * KiB;
constexpr size_t WS_MEMN = 49 * MiB + 512 * KiB;
constexpr size_t WS_WKVT = 50 * MiB + 512 * KiB;
constexpr size_t WS_ACAT = WS_XN;
constexpr size_t WS_RKV = 57 * MiB + 512 * KiB;
constexpr size_t WS_LORA = 153 * MiB + 512 * KiB;
constexpr size_t WS_AQKV = 162 * MiB + 512 * KiB;
constexpr size_t WS_PCATT = 234 * MiB + 512 * KiB;
constexpr size_t WS_WOUTT = 237 * MiB;
constexpr size_t WS_WST = 239 * MiB;
constexpr size_t WS_VWT = 243 * MiB;
constexpr size_t WS_WQB = 247 * MiB;
constexpr size_t WS_WOT = 249 * MiB;
constexpr size_t WS_KV = 251 * MiB;
constexpr size_t WS_SS1 = 253 * MiB;
constexpr size_t WS_SS2 = 254 * MiB;
constexpr size_t WS_SS3 = 255 * MiB;
constexpr size_t WS_W1T = 57 * MiB + 512 * KiB;
constexpr size_t WS_W2T = 65 * MiB + 512 * KiB;
constexpr size_t WS_H2B = 73 * MiB + 512 * KiB;
constexpr size_t WS_MERGED = 105 * MiB + 512 * KiB;
constexpr size_t WS_H1B = 137 * MiB + 512 * KiB;
constexpr size_t WS_PROB = 169 * MiB + 512 * KiB;
constexpr size_t WS_ACT = 105 * MiB + 512 * KiB;

constexpr int NTHREADS = 512, NWAVES = 8;
constexpr int LDS_BYTES = 147456;

__device__ __forceinline__ float bf2f(bf16_t v) { return __uint_as_float(((unsigned)v) << 16); }
__device__ __forceinline__ bf16_t f2bf(float f) { unsigned u = __float_as_uint(f); return (bf16_t)((u + 0x7fffu + ((u >> 16) & 1u)) >> 16); }
__device__ __forceinline__ float sigmoidf_(float x) { return 1.f / (1.f + __expf(-x)); }
__device__ __forceinline__ float wave_sum(float v) {
#pragma unroll
    for (int o = 1; o < 64; o <<= 1) v += __shfl_xor(v, o);
    return v;
}
__device__ __forceinline__ float wave_max(float v) {
#pragma unroll
    for (int o = 1; o < 64; o <<= 1) v = fmaxf(v, __shfl_xor(v, o));
    return v;
}

struct Args {
    const float* in[27];
    float* out;
    unsigned char* ws;
    int ph_lo, ph_hi;
};

enum { I_X = 0, I_MEM, I_NMIX, I_WIN, I_MU, I_W0, I_W2, I_A0, I_A2, I_G2, I_KK, I_KA, I_RK, I_GNW, I_GNB, I_PRWKV, I_PATTN, I_WOUT,
       I_NX, I_NMEM, I_WQ, I_WKV, I_WO, I_NFFN, I_W1, I_FW2, I_NFIN };

template <class AF, class BF, class EF>
__device__ __forceinline__ void naive_gemm(float* lds, int Mx, int Nx, int Kx, int unit0, int ustride, AF af, BF bf, EF ef) {
    float* As = lds;
    float* Bs = lds + 32 * 132;
    const int tid = threadIdx.x, ty = tid >> 4, tx = tid & 15;
    const int tm = Mx / 128, tn = (Nx + 63) / 64;
    for (int u = unit0; u < tm * tn; u += ustride) {
        const int m0 = (u / tn) * 128, n0 = (u % tn) * 64;
        float acc[4][4];
#pragma unroll
        for (int i = 0; i < 4; ++i)
#pragma unroll
            for (int j = 0; j < 4; ++j) acc[i][j] = 0.f;
        for (int k0 = 0; k0 < Kx; k0 += 32) {
            __syncthreads();
#pragma unroll
            for (int i = 0; i < 8; ++i) { const int idx = tid + i * 512, k = idx & 31, r = idx >> 5; As[k * 132 + r] = af(m0 + r, k0 + k); }
#pragma unroll
            for (int i = 0; i < 4; ++i) { const int idx = tid + i * 512, n = idx & 63, k = idx >> 6; Bs[k * 68 + n] = (n0 + n < Nx) ? bf(k0 + k, n0 + n) : 0.f; }
            __syncthreads();
#pragma unroll 8
            for (int k = 0; k < 32; ++k) {
                const f32x4 a = *(const f32x4*)(As + k * 132 + ty * 4), b = *(const f32x4*)(Bs + k * 68 + tx * 4);
#pragma unroll
                for (int i = 0; i < 4; ++i)
#pragma unroll
                    for (int j = 0; j < 4; ++j) acc[i][j] += a[i] * b[j];
            }
        }
#pragma unroll
        for (int i = 0; i < 4; ++i)
#pragma unroll
            for (int j = 0; j < 4; ++j) { const int n = n0 + tx * 4 + j; if (n < Nx) ef(m0 + ty * 4 + i, n, acc[i][j]); }
    }
    __syncthreads();
}

__device__ __forceinline__ void scan_naive(const Args& a, float* lds, int bh) {
    const int b = bh >> 4, h = bh & 15;
    const int tid = threadIdx.x, lane = tid & 63, wave = tid >> 6;
    const bf16_t* RKV = (const bf16_t*)(a.ws + WS_RKV);
    const bf16_t* LORA = (const bf16_t*)(a.ws + WS_LORA);
    bf16_t* ACAT = (bf16_t*)(a.ws + WS_ACAT);
    const float* mu = a.in[I_MU];
    float* actW = lds;
    float* actA = actW + CH * 64;
    float* actG = actA + CH * 64;
    float* Wd = actG + CH * 160;
    float* Kk = Wd + CH * 64;
    float* Aa = Kk + CH * 64;
    float* Bb = Aa + CH * 64;
    float* Rr = Bb + CH * 64;
    float* Vv = Rr + CH * 64;
    float* Gg = Vv + CH * 64;
    float* Yy = Gg + CH * 64;
    float* bon = Yy + CH * 64;
    const int hj0 = h * 64;
    float st[8];
#pragma unroll
    for (int e = 0; e < 8; ++e) st[e] = 0.f;
    const int row_i = wave * 8 + (lane >> 3), cg = lane & 7;
    for (int c0 = 0; c0 < SEQ; c0 += CH) {
        const size_t m0 = (size_t)b * SEQ + c0;
        __syncthreads();
        for (int idx = tid; idx < CH * NLORA; idx += NTHREADS) {
            const int t = idx / NLORA, c = idx % NLORA;
            const float cur = bf2f(LORA[(m0 + t) * NLORA + c]);
            const float prev = (c0 + t == 0) ? 0.f : bf2f(LORA[(m0 + t - 1) * NLORA + c]);
            const float s = cur + mu[C_LORA + c] * (prev - cur);
            if (c < 64) actW[t * 64 + c] = tanhf(s);
            else if (c < 128) actA[t * 64 + c - 64] = s;
            else actG[t * 160 + c - 128] = sigmoidf_(s);
        }
        for (int idx = tid; idx < CH * 64; idx += NTHREADS) {
            const int t = idx >> 6, j = idx & 63;
            const bool first = (c0 + t == 0);
#pragma unroll
            for (int q = 0; q < 3; ++q) {
                const int col = q * 1024 + hj0 + j;
                const float cur = bf2f(RKV[(m0 + t) * NRKV + col]);
                const float prev = first ? 0.f : bf2f(RKV[(m0 + t - 1) * NRKV + col]);
                const float s = cur + mu[col] * (prev - cur);
                if (q == 0) Rr[idx] = s; else if (q == 1) Kk[idx] = s; else Vv[idx] = s;
            }
        }
        __syncthreads();
        for (int idx = tid; idx < CH * 64; idx += NTHREADS) {
            const int t = idx >> 6, j = idx & 63, hj = hj0 + j;
            float wp = a.in[I_W0][hj], ap = a.in[I_A0][hj], g = 0.f;
            for (int c = 0; c < 64; ++c) { wp += actW[t * 64 + c] * a.in[I_W2][c * 1024 + hj]; ap += actA[t * 64 + c] * a.in[I_A2][c * 1024 + hj]; }
            for (int c = 0; c < 160; ++c) g += actG[t * 160 + c] * a.in[I_G2][c * 1024 + hj];
            const float z = -wp;
            const float sp = fmaxf(z, 0.f) + log1pf(__expf(-fabsf(z)));
            const float wlog = -sp - 0.5f;
            Wd[idx] = __expf(-__expf(wlog));
            Aa[idx] = sigmoidf_(ap);
            Gg[idx] = g;
        }
        __syncthreads();
#pragma unroll
        for (int q = 0; q < 4; ++q) {
            const int t = wave * 4 + q, idx = t * 64 + lane, hj = hj0 + lane;
            const float pk = Kk[idx], alr = Aa[idx];
            const float kr = pk * a.in[I_KK][hj];
            const float ss = wave_sum(kr * kr);
            const float kk = kr / fmaxf(sqrtf(ss), 1e-12f);
            const float kmod = pk * (1.f + (alr - 1.f) * a.in[I_KA][hj]);
            const float bs = wave_sum(Rr[idx] * kmod * a.in[I_RK][hj]);
            Aa[idx] = -kk; Bb[idx] = kk * alr; Kk[idx] = kmod;
            if (lane == 0) bon[t] = bs;
        }
        __syncthreads();
        for (int t = 0; t < CH; ++t) {
            const float* ap = Aa + t * 64 + cg * 8; const float* wp = Wd + t * 64 + cg * 8; const float* kp = Kk + t * 64 + cg * 8;
            const float* bp = Bb + t * 64 + cg * 8; const float* rp = Rr + t * 64 + cg * 8;
            float sa = 0.f;
#pragma unroll
            for (int e = 0; e < 8; ++e) sa += st[e] * ap[e];
            sa += __shfl_xor(sa, 1); sa += __shfl_xor(sa, 2); sa += __shfl_xor(sa, 4);
            const float vi = Vv[t * 64 + row_i];
            float y = 0.f;
#pragma unroll
            for (int e = 0; e < 8; ++e) { st[e] = st[e] * wp[e] + sa * bp[e] + vi * kp[e]; y += st[e] * rp[e]; }
            y += __shfl_xor(y, 1); y += __shfl_xor(y, 2); y += __shfl_xor(y, 4);
            if (cg == 0) Yy[t * 64 + row_i] = y;
        }
        __syncthreads();
#pragma unroll
        for (int q = 0; q < 4; ++q) {
            const int t = wave * 4 + q, idx = t * 64 + lane, hi = hj0 + lane;
            const float y = Yy[idx];
            const float mean = wave_sum(y) * (1.f / 64.f);
            const float dy = y - mean;
            const float var = wave_sum(dy * dy) * (1.f / 64.f);
            const float yn = dy * rsqrtf(var + 64.f * 1e-5f) * a.in[I_GNW][hi] + a.in[I_GNB][hi];
            const float o = (yn + bon[t] * Vv[idx]) * Gg[idx];
            ACAT[(m0 + t) * KCAT + hi] = f2bf(o);
        }
    }
}

__device__ __forceinline__ void dil_attn_naive(const Args& a, float* lds, int wave_gid, int nwaves_total) {
    const int lane = threadIdx.x & 63, wave = threadIdx.x >> 6;
    const bf16_t* AQ = (const bf16_t*)(a.ws + WS_AQKV);
    bf16_t* ACAT = (bf16_t*)(a.ws + WS_ACAT);
    float* pbuf = lds + wave * 640;
    float* qs = pbuf + 448;
    for (int task = wave_gid; task < M * 4; task += nwaves_total) {
        const int m = task >> 2, s = task & 3, p = m & (SEQ - 1);
#pragma unroll
        for (int g = 0; g < 3; ++g) qs[g * 64 + lane] = bf2f(AQ[(size_t)m * NAQKV + (g * 4 + s) * 64 + lane]);
        float sc[7];
        float mx = -INFINITY;
#pragma unroll
        for (int i = 0; i < 7; ++i) {
            const int idx = lane + i * 64;
            float v = -INFINITY;
            if (idx < 387) {
                const int g = idx / 129, stp = idx % 129, dil = (g == 0) ? 1 : (g == 1 ? 4 : 16), hd = g * 4 + s;
                if (stp * dil <= p) {
                    const bf16_t* kr = AQ + (size_t)(m - stp * dil) * NAQKV + 768 + hd * 64;
                    float dot = 0.f;
                    for (int c = 0; c < 64; ++c) dot += qs[g * 64 + c] * bf2f(kr[c]);
                    const float slope = exp2f(-8.f * (float)(hd + 1) / 12.f);
                    v = dot * 0.125f - slope * (float)(stp * dil);
                }
            }
            sc[i] = v; mx = fmaxf(mx, v);
        }
        mx = wave_max(mx);
        float sum = 0.f;
#pragma unroll
        for (int i = 0; i < 7; ++i) { const int idx = lane + i * 64; const float e = (sc[i] == -INFINITY) ? 0.f : __expf(sc[i] - mx); sum += e; if (idx < 448) pbuf[idx] = e; }
        sum = wave_sum(sum);
        float acc = 0.f;
        for (int idx = 0; idx < 387; ++idx) {
            const int g = idx / 129, stp = idx % 129, dil = (g == 0) ? 1 : (g == 1 ? 4 : 16), hd = g * 4 + s;
            if (stp * dil <= p) acc += pbuf[idx] * bf2f(AQ[(size_t)(m - stp * dil) * NAQKV + 1536 + hd * 64 + lane]);
        }
        ACAT[(size_t)m * KCAT + 1024 + s * 64 + lane] = f2bf(acc / sum);
    }
}

#define LAS __attribute__((address_space(3)))
typedef short bf16x8 __attribute__((ext_vector_type(8)));
typedef unsigned u32x4 __attribute__((ext_vector_type(4)));
namespace ge {
constexpr int BM = 256, BK = 64, HALF = 128, HTB = HALF * BK * 2, STAGE_BYTES = 8 * HTB, NXCD = 8, WGM = 8;
__host__ __device__ __forceinline__ int lds_byte(int r, int c) { const int st = (r >> 4) * 2 + (c >> 5), rr = r & 15, cc = c & 31, ob = rr * 64 + cc * 2; return st * 1024 + (ob ^ (((ob >> 9) & 1) << 5)); }
__host__ __device__ __forceinline__ void stage_rc(int b, int& R, int& C) { const int st = b / 1024, sb = b % 1024, swz = sb ^ (((sb >> 9) & 1) << 5); R = (st >> 1) * 16 + swz / 64; C = (st & 1) * 32 + (swz % 64) / 2; }
__host__ __device__ __forceinline__ int perm32(int rho) { const int n = rho >> 4, i = rho & 15; return 8 * (i >> 2) + 4 * n + (i & 3); }

struct Unit { const char* A; const char* B; int pm, pn; };

struct Order {
    int nM, nN, nwg, G, c;
    __device__ __forceinline__ void init(int nM_, int nN_, int G_, int c_) { nM = nM_; nN = nN_; nwg = nM * nN; G = G_; c = c_; }
    __device__ __forceinline__ bool next(int i, int& pm, int& pn) const {
        const long L = (long)i * G + c; if (L >= nwg) return false;
        int wgid = (int)L; { const int q = nwg / NXCD, r = nwg % NXCD, xcd = wgid % NXCD, off = wgid / NXCD; wgid = (xcd < r ? xcd * (q + 1) : r * (q + 1) + (xcd - r) * q) + off; }
        const int nig = WGM * nN, gid = wgid / nig, fm = gid * WGM, gsz = (nM - fm) < WGM ? (nM - fm) : WGM;
        pm = fm + ((wgid % nig) % gsz); pn = (wgid % nig) / gsz; return true;
    }
};
struct Sched {
    Order o; const char* A; const char* B; size_t a_tile, b_tile, b_batch;
    __device__ __forceinline__ bool next(int i, Unit& u) const {
        int pm, pn; if (!o.next(i, pm, pn)) return false;
        u.pm = pm; u.pn = pn; u.A = A + (size_t)pm * a_tile; u.B = B + (size_t)pn * b_tile + (size_t)(pm >> 5) * b_batch; return true;
    }
};

__device__ __forceinline__ unsigned cvt_pk_bf16(float lo, float hi) { unsigned r; asm volatile("v_cvt_pk_bf16_f32 %0, %1, %2" : "=v"(r) : "v"(lo), "v"(hi)); return r; }
__device__ __forceinline__ u32x4 pack8(const f32x4 v0, const f32x4 v1) { u32x4 w; w.x = cvt_pk_bf16(v0[0], v0[1]); w.y = cvt_pk_bf16(v0[2], v0[3]); w.z = cvt_pk_bf16(v1[0], v1[1]); w.w = cvt_pk_bf16(v1[2], v1[3]); return w; }
__device__ __forceinline__ void unpack8(const u32x4 w, f32x4& v0, f32x4& v1) {
    v0[0] = __uint_as_float(w.x << 16); v0[1] = __uint_as_float(w.x & 0xffff0000u); v0[2] = __uint_as_float(w.y << 16); v0[3] = __uint_as_float(w.y & 0xffff0000u);
    v1[0] = __uint_as_float(w.z << 16); v1[1] = __uint_as_float(w.z & 0xffff0000u); v1[2] = __uint_as_float(w.w << 16); v1[3] = __uint_as_float(w.w & 0xffff0000u);
}

template <class Epi, class SchedT, bool ALIGN_EPI>
__device__ __forceinline__ void gemm_phase(LAS unsigned char* lds, const int lda, const int ldb, const int nt, const SchedT& S, const Epi& E) {
    const int tid = threadIdx.x, wid = __builtin_amdgcn_readfirstlane(tid >> 6), lane = tid & 63, wr = wid >> 2, wc = wid & 3, fr = lane & 15, fq = lane >> 4;
    unsigned voffA[2], voffB[2];
#pragma unroll
    for (int i = 0; i < 2; ++i) { int R, C; stage_rc(tid * 16 + i * 8192, R, C); const int Rb = (R & ~31) + perm32(R & 31);
        voffA[i] = (unsigned)(R * lda + C) * 2u; voffB[i] = (unsigned)(Rb * ldb + C) * 2u; }
    const size_t kstep = (size_t)(BK * 2);
    const size_t hstepA = (size_t)HALF * lda * 2, hstepB = (size_t)HALF * ldb * 2;
    const unsigned ldsw = (unsigned)wid * 1024u;
    const int aoff = lds_byte(wr * 64 + fr, fq * 8), boff = lds_byte(wc * 32 + fr, fq * 8);
#define GE_SA(b, h) (((b) * 2 + (h)) * ge::HTB)
#define GE_SB(b, h) ((4 + (b) * 2 + (h)) * ge::HTB)
#define GE_STAGE(bufoff, gbase, voff) do { _Pragma("unroll") for (int _i = 0; _i < 2; ++_i) \
        __builtin_amdgcn_global_load_lds((const unsigned*)((const char*)(gbase) + (voff)[_i]), (LAS unsigned*)(lds + (bufoff) + ldsw + _i * 8192), 16, 0, 0); } while (0)
#define GE_LDA(dst, b, h) do { _Pragma("unroll") for (int m = 0; m < 4; ++m) _Pragma("unroll") for (int k = 0; k < 2; ++k) dst[m][k] = *(const LAS bf16x8*)(lds + GE_SA(b, h) + aoff + m * 2048 + k * 1024); } while (0)
#define GE_LDB(dst, b, h) do { _Pragma("unroll") for (int n = 0; n < 2; ++n) _Pragma("unroll") for (int k = 0; k < 2; ++k) dst[n][k] = *(const LAS bf16x8*)(lds + GE_SB(b, h) + boff + n * 2048 + k * 1024); } while (0)
#define GE_MMA(ai, bj, At, Bt) do { __builtin_amdgcn_s_setprio(1); _Pragma("unroll") for (int m = 0; m < 4; ++m) _Pragma("unroll") for (int n = 0; n < 2; ++n) _Pragma("unroll") for (int k = 0; k < 2; ++k) \
        acc[ai][bj][m][n] = __builtin_amdgcn_mfma_f32_16x16x32_bf16(Bt[n][k], At[m][k], acc[ai][bj][m][n], 0, 0, 0); __builtin_amdgcn_s_setprio(0); } while (0)
#define GE_WAIT_V(n) asm volatile("s_waitcnt vmcnt(" #n ")" ::: "memory")
#define GE_WAIT_L(n) asm volatile("s_waitcnt lgkmcnt(" #n ")" ::: "memory")
#define GE_BAR __builtin_amdgcn_s_barrier()
#define GE_SCHED __builtin_amdgcn_sched_barrier(0)
    Unit cur, nxt; int ui = 0;
    if (!S.next(0, cur)) return;
    f32x4 acc[2][2][4][2];
#pragma unroll
    for (int a = 0; a < 2; ++a)
#pragma unroll
        for (int b = 0; b < 2; ++b)
#pragma unroll
            for (int m = 0; m < 4; ++m)
#pragma unroll
                for (int n = 0; n < 2; ++n) acc[a][b][m][n] = (f32x4){0.f, 0.f, 0.f, 0.f};
    bf16x8 At[4][2], B0[2][2], B1[2][2];
    const char* cA = cur.A; const char* cB = cur.B;
    GE_STAGE(GE_SB(0, 0), cB, voffB); GE_STAGE(GE_SB(0, 1), cB + hstepB, voffB); GE_STAGE(GE_SA(0, 0), cA, voffA); GE_STAGE(GE_SA(0, 1), cA + hstepA, voffA);
    if (wr == 1) GE_BAR;
    GE_WAIT_V(2); GE_BAR;
    GE_STAGE(GE_SB(1, 0), cB + kstep, voffB); GE_STAGE(GE_SA(1, 0), cA + kstep, voffA); GE_STAGE(GE_SB(1, 1), cB + hstepB + kstep, voffB);
    GE_WAIT_V(6); GE_BAR;
    for (;;) {
        const bool has_next = S.next(ui + 1, nxt);
        const char* nA = has_next ? nxt.A : cA; const char* nB = has_next ? nxt.B : cB;
        for (int t = 0; t < nt; t += 2) {
            if constexpr (Epi::HOOK) { if (t == E.hook_t) E.hook(acc, cur, wr, wc, fr, fq); }
            const bool last = (t == nt - 2);
            const char* a1 = cA + (size_t)(t + 1) * kstep;
            const char* a2 = last ? nA : cA + (size_t)(t + 2) * kstep; const char* b2 = last ? nB : cB + (size_t)(t + 2) * kstep;
            const char* a3 = a2 + kstep; const char* b3 = b2 + kstep;
            GE_LDB(B0, 0, 0); GE_LDB(B1, 0, 1); GE_SCHED; GE_LDA(At, 0, 0); GE_STAGE(GE_SA(1, 1), a1 + hstepA, voffA);
            GE_WAIT_V(8); GE_WAIT_L(0); GE_BAR; GE_MMA(0, 0, At, B0); GE_MMA(0, 1, At, B1); GE_BAR; GE_SCHED;
            GE_LDA(At, 0, 1); GE_STAGE(GE_SB(0, 0), b2, voffB); GE_STAGE(GE_SB(0, 1), b2 + hstepB, voffB); GE_STAGE(GE_SA(0, 0), a2, voffA);
            GE_WAIT_V(8); GE_WAIT_L(0); GE_BAR; GE_MMA(1, 0, At, B0); GE_MMA(1, 1, At, B1); GE_BAR; GE_SCHED;
            GE_LDB(B0, 1, 0); GE_LDB(B1, 1, 1); GE_SCHED; GE_LDA(At, 1, 0); GE_STAGE(GE_SA(0, 1), a2 + hstepA, voffA);
            GE_WAIT_V(8); GE_WAIT_L(0); GE_BAR; GE_MMA(0, 0, At, B0); GE_MMA(0, 1, At, B1); GE_BAR; GE_SCHED;
            GE_LDA(At, 1, 1); GE_STAGE(GE_SB(1, 0), b3, voffB); GE_STAGE(GE_SB(1, 1), b3 + hstepB, voffB); GE_STAGE(GE_SA(1, 0), a3, voffA);
            GE_WAIT_V(8); GE_WAIT_L(0); GE_BAR; GE_MMA(1, 0, At, B0); GE_MMA(1, 1, At, B1); GE_BAR; GE_SCHED;
        }
        if constexpr (ALIGN_EPI) { if (wr == 0) GE_BAR; }
        if constexpr (!Epi::AFTER_DRAIN) { E(acc, cur, wr, wc, fr, fq); }
        if (!has_next) break;
#pragma unroll
        for (int a = 0; a < 2; ++a)
#pragma unroll
            for (int b = 0; b < 2; ++b)
#pragma unroll
                for (int m = 0; m < 4; ++m)
#pragma unroll
                    for (int n = 0; n < 2; ++n) acc[a][b][m][n] = (f32x4){0.f, 0.f, 0.f, 0.f};
        cur = nxt; cA = nA; cB = nB; ++ui;
        if constexpr (ALIGN_EPI) { if (wr == 1) GE_BAR; }
    }
    GE_WAIT_V(0);
    if constexpr (!ALIGN_EPI) { if (wr == 0) GE_BAR; }
    GE_BAR;
    if constexpr (Epi::AFTER_DRAIN) { E.fused(acc, cur, wr, wc, fr, fq, lds, wid, lane); }
#undef GE_SA
#undef GE_SB
#undef GE_STAGE
#undef GE_LDA
#undef GE_LDB
#undef GE_MMA
#undef GE_WAIT_V
#undef GE_WAIT_L
#undef GE_BAR
#undef GE_SCHED
}

#define GE_ROW(ai, m) (u.pm * 256 + (ai) * 128 + wr * 64 + (m) * 16 + fr)
#define GE_COL(bj) (u.pn * 256 + (bj) * 128 + wc * 32 + 8 * fq)
typedef f32x4 Acc[2][2][4][2];

__device__ __forceinline__ float fast_sigmoid(float x) { return __builtin_amdgcn_rcpf(1.f + __expf(-x)); }

struct EpiProj {
    static constexpr bool AFTER_DRAIN = false, HOOK = false; int hook_t;
    bf16_t *RKV, *GATES, *AQKV, *LORA;
    __device__ __forceinline__ void hook(Acc&, const Unit&, int, int, int, int) const {}
    __device__ __forceinline__ void operator()(const Acc& acc, const Unit& u, int wr, int wc, int fr, int fq) const {
        const int pn = u.pn; bf16_t* base; int ld, cbase, climit = 1 << 30; bool sig = false;
        if (pn < 12) { base = RKV; ld = NRKV; cbase = pn * 256; }
        else if (pn < 20) { base = GATES; ld = NGATE; cbase = (pn - 12) * 256; sig = true; }
        else if (pn < 29) { base = AQKV; ld = NAQKV; cbase = (pn - 20) * 256; }
        else { base = LORA; ld = NLORA; cbase = (pn - 29) * 256; climit = NLORA; }
#pragma unroll
        for (int ai = 0; ai < 2; ++ai)
#pragma unroll
            for (int m = 0; m < 4; ++m) { bf16_t* rowp = base + (size_t)GE_ROW(ai, m) * ld;
#pragma unroll
                for (int bj = 0; bj < 2; ++bj) { const int c = cbase + bj * 128 + wc * 32 + 8 * fq;
                    if (c < climit) { f32x4 v0 = acc[ai][bj][m][0], v1 = acc[ai][bj][m][1];
                        if (sig) {
#pragma unroll
                            for (int j = 0; j < 4; ++j) { v0[j] = fast_sigmoid(v0[j]); v1[j] = fast_sigmoid(v1[j]); } }
                        *(u32x4*)(rowp + c) = pack8(v0, v1); } } }
    }
};
struct EpiMerged {
    static constexpr bool AFTER_DRAIN = false, HOOK = true; int hook_t;
    const bf16_t* GATES; bf16_t* MERGED;
    __device__ __forceinline__ void hook(Acc& acc, const Unit& u, int wr, int wc, int fr, int fq) const {
#pragma unroll
        for (int ai = 0; ai < 2; ++ai)
#pragma unroll
            for (int m = 0; m < 4; ++m) { const bf16_t* g = GATES + (size_t)GE_ROW(ai, m) * NGATE;
#pragma unroll
                for (int bj = 0; bj < 2; ++bj) { const int c = GE_COL(bj); f32x4 r0, r1, a0, a1;
                    unpack8(*(const u32x4*)(g + c), r0, r1); unpack8(*(const u32x4*)(g + 1024 + c), a0, a1);
#pragma unroll
                    for (int j = 0; j < 4; ++j) { acc[ai][bj][m][0][j] *= r0[j] * __builtin_amdgcn_rcpf(a0[j]); acc[ai][bj][m][1][j] *= r1[j] * __builtin_amdgcn_rcpf(a1[j]); } } }
    }
    __device__ __forceinline__ void operator()(const Acc& acc, const Unit& u, int wr, int wc, int fr, int fq) const {
#pragma unroll
        for (int ai = 0; ai < 2; ++ai)
#pragma unroll
            for (int m = 0; m < 4; ++m) { const size_t r = (size_t)GE_ROW(ai, m);
#pragma unroll
                for (int bj = 0; bj < 2; ++bj) { const int c = GE_COL(bj); f32x4 a0, a1;
                    unpack8(*(const u32x4*)(GATES + r * NGATE + 1024 + c), a0, a1);
                    *(u32x4*)(MERGED + r * D + c) = pack8(acc[ai][bj][m][0] * a0, acc[ai][bj][m][1] * a1); } }
    }
};
struct EpiResid {
    static constexpr bool AFTER_DRAIN = false, HOOK = false; int hook_t;
    const float* base; float* out; bf16_t* hb; float* SS;
    __device__ __forceinline__ void hook(Acc&, const Unit&, int, int, int, int) const {}
    __device__ __forceinline__ void operator()(const Acc& acc, const Unit& u, int wr, int wc, int fr, int fq) const {
#pragma unroll
        for (int ai = 0; ai < 2; ++ai)
#pragma unroll
            for (int m = 0; m < 4; ++m) { const size_t r = (size_t)GE_ROW(ai, m); float ss = 0.f;
#pragma unroll
                for (int bj = 0; bj < 2; ++bj) { const int c = GE_COL(bj);
                    const f32x4 o0 = *(const f32x4*)(base + r * D + c) + acc[ai][bj][m][0], o1 = *(const f32x4*)(base + r * D + c + 4) + acc[ai][bj][m][1];
                    *(f32x4*)(out + r * D + c) = o0; *(f32x4*)(out + r * D + c + 4) = o1;
                    ss += (o0[0] * o0[0] + o0[1] * o0[1]) + (o0[2] * o0[2] + o0[3] * o0[3]) + (o1[0] * o1[0] + o1[1] * o1[1]) + (o1[2] * o1[2] + o1[3] * o1[3]);
                    if (hb) *(u32x4*)(hb + r * D + c) = pack8(o0, o1); }
                ss += __shfl_xor(ss, 16); ss += __shfl_xor(ss, 32);
                if (fq == 0) SS[r * 16 + u.pn * 4 + wc] = ss; }
    }
};
__device__ __forceinline__ float rstd_from_ss(const float* SS, size_t r) {
    const f32x4 a = *(const f32x4*)(SS + r * 16), b = *(const f32x4*)(SS + r * 16 + 4), c = *(const f32x4*)(SS + r * 16 + 8), d = *(const f32x4*)(SS + r * 16 + 12);
    const float s = ((a[0] + a[1]) + (a[2] + a[3])) + ((b[0] + b[1]) + (b[2] + b[3])) + ((c[0] + c[1]) + (c[2] + c[3])) + ((d[0] + d[1]) + (d[2] + d[3]));
    return rsqrtf(s * (1.f / D) + 1e-6f);
}
struct EpiRelu2 {
    static constexpr bool AFTER_DRAIN = false, HOOK = false; int hook_t;
    const float* SS; bf16_t* ACT;
    __device__ __forceinline__ void hook(Acc&, const Unit&, int, int, int, int) const {}
    __device__ __forceinline__ void operator()(const Acc& acc, const Unit& u, int wr, int wc, int fr, int fq) const {
#pragma unroll
        for (int ai = 0; ai < 2; ++ai)
#pragma unroll
            for (int m = 0; m < 4; ++m) { const size_t r = (size_t)GE_ROW(ai, m); const float rstd = rstd_from_ss(SS, r);
#pragma unroll
                for (int bj = 0; bj < 2; ++bj) { const int c = GE_COL(bj); f32x4 v0 = acc[ai][bj][m][0] * rstd, v1 = acc[ai][bj][m][1] * rstd;
#pragma unroll
                    for (int j = 0; j < 4; ++j) { const float a = fmaxf(v0[j], 0.f), b = fmaxf(v1[j], 0.f); v0[j] = a * a; v1[j] = b * b; }
                    *(u32x4*)(ACT + r * FF + c) = pack8(v0, v1); } }
    }
};
struct EpiSoftmax {
    static constexpr bool AFTER_DRAIN = true, HOOK = false; int hook_t;
    const float* SS; bf16_t* PROB;
    __device__ __forceinline__ void hook(Acc&, const Unit&, int, int, int, int) const {}
    __device__ __forceinline__ void operator()(const Acc&, const Unit&, int, int, int, int) const {}
    __device__ __forceinline__ void fused(Acc& acc, const Unit& u, int wr, int wc, int fr, int fq, LAS unsigned char* lds, int wid, int lane) const {
        LAS float* Pm = (LAS float*)lds; LAS float* Ps = Pm + 1024;
#pragma unroll
        for (int ai = 0; ai < 2; ++ai)
#pragma unroll
            for (int m = 0; m < 4; ++m) { const float rstd = rstd_from_ss(SS, (size_t)GE_ROW(ai, m)); float mx = -INFINITY;
#pragma unroll
                for (int bj = 0; bj < 2; ++bj)
#pragma unroll
                    for (int n = 0; n < 2; ++n)
#pragma unroll
                        for (int j = 0; j < 4; ++j) { const float s = acc[ai][bj][m][n][j] * rstd; acc[ai][bj][m][n][j] = s; mx = fmaxf(mx, s); }
                mx = fmaxf(mx, __shfl_xor(mx, 16)); mx = fmaxf(mx, __shfl_xor(mx, 32));
                if (fq == 0) Pm[(ai * 128 + wr * 64 + m * 16 + fr) * 4 + wc] = mx; }
        asm volatile("s_waitcnt lgkmcnt(0)" ::: "memory"); __builtin_amdgcn_s_barrier(); asm volatile("" ::: "memory");
#pragma unroll
        for (int ai = 0; ai < 2; ++ai)
#pragma unroll
            for (int m = 0; m < 4; ++m) { const int rl = ai * 128 + wr * 64 + m * 16 + fr; const f32x4 pm4 = *(const LAS f32x4*)(Pm + rl * 4);
                const float mx = fmaxf(fmaxf(pm4[0], pm4[1]), fmaxf(pm4[2], pm4[3])) * 1.44269504f; float sum = 0.f;
#pragma unroll
                for (int bj = 0; bj < 2; ++bj)
#pragma unroll
                    for (int n = 0; n < 2; ++n)
#pragma unroll
                        for (int j = 0; j < 4; ++j) { const float e = __builtin_amdgcn_exp2f(acc[ai][bj][m][n][j] * 1.44269504f - mx); acc[ai][bj][m][n][j] = e; sum += e; }
                sum += __shfl_xor(sum, 16); sum += __shfl_xor(sum, 32);
                if (fq == 0) Ps[rl * 4 + wc] = sum; }
        asm volatile("s_waitcnt lgkmcnt(0)" ::: "memory"); __builtin_amdgcn_s_barrier(); asm volatile("" ::: "memory");
#pragma unroll
        for (int ai = 0; ai < 2; ++ai)
#pragma unroll
            for (int m = 0; m < 4; ++m) { const int rl = ai * 128 + wr * 64 + m * 16 + fr; const f32x4 ps4 = *(const LAS f32x4*)(Ps + rl * 4);
                const float inv = 1.f / ((ps4[0] + ps4[1]) + (ps4[2] + ps4[3])); const size_t r = (size_t)GE_ROW(ai, m);
#pragma unroll
                for (int bj = 0; bj < 2; ++bj) *(u32x4*)(PROB + r * D + GE_COL(bj)) = pack8(acc[ai][bj][m][0] * inv, acc[ai][bj][m][1] * inv); }
    }
};
}

__device__ __forceinline__ void transpose_item(const float* W, int ldw, int k0, int n0, bf16_t* WT, int ldt, int drow0, int dk0, const float* kscale, LAS float* scr, int lane) {
#pragma unroll 8
    for (int i = 0; i < 32; ++i) { const int kk = 2 * i + (lane >> 5); float v = W[(size_t)(k0 + kk) * ldw + n0 + (lane & 31)]; if (kscale) v *= kscale[k0 + kk]; scr[kk * 33 + (lane & 31)] = v; }
    asm volatile("s_waitcnt lgkmcnt(0)" ::: "memory");
    const int c = lane & 7;
#pragma unroll
    for (int j = 0; j < 4; ++j) { const int n = (lane >> 3) + 8 * j; const LAS float* s = scr + (8 * c) * 33 + n;
        u32x4 o; o.x = ge::cvt_pk_bf16(s[0 * 33], s[1 * 33]); o.y = ge::cvt_pk_bf16(s[2 * 33], s[3 * 33]); o.z = ge::cvt_pk_bf16(s[4 * 33], s[5 * 33]); o.w = ge::cvt_pk_bf16(s[6 * 33], s[7 * 33]);
        *(u32x4*)(WT + (size_t)(drow0 + n) * ldt + dk0 + k0 + 8 * c) = o; }
    asm volatile("s_waitcnt lgkmcnt(0)" ::: "memory");
}
__device__ __forceinline__ void transpose_matrix(const float* W, int K, int N, bf16_t* WT, int ldt, int dk0, const float* kscale, LAS float* scr, int lane, int gw, int NGW) {
    const int nblk = N / 32, items = (K / 64) * nblk;
    for (int it = gw; it < items; it += NGW) { const int kb = it / nblk, nb = it % nblk; transpose_item(W, N, kb * 64, nb * 32, WT, ldt, nb * 32, dk0, kscale, scr, lane); }
}
template <int PH> __global__ void __launch_bounds__(NTHREADS, 2) mk_fwd(Args a) {
    extern __shared__ __attribute__((aligned(16))) unsigned char lds_raw[];
    float* lds = (float*)lds_raw;
    LAS unsigned char* ldsl = (LAS unsigned char*)lds_raw;
    const int tid = threadIdx.x, lane = tid & 63, wave = tid >> 6;
    const int G = gridDim.x, bid = blockIdx.x;
    const int gw = bid * NWAVES + wave, NGW = G * NWAVES;
    unsigned char* ws = a.ws;
    bf16_t* XN = (bf16_t*)(ws + WS_XN); bf16_t* RKV = (bf16_t*)(ws + WS_RKV); bf16_t* LORA = (bf16_t*)(ws + WS_LORA); bf16_t* AQKV = (bf16_t*)(ws + WS_AQKV);
    bf16_t* GATES = (bf16_t*)a.out; bf16_t* ACAT = (bf16_t*)(ws + WS_ACAT); bf16_t* WST = (bf16_t*)(ws + WS_WST); bf16_t* VWT = (bf16_t*)(ws + WS_VWT);
    bf16_t* KV = (bf16_t*)(ws + WS_KV); bf16_t* MEMN = (bf16_t*)(ws + WS_MEMN);
    float* SS1 = (float*)(ws + WS_SS1); float* SS2 = (float*)(ws + WS_SS2); float* SS3 = (float*)(ws + WS_SS3);
    bf16_t* H2B = (bf16_t*)(ws + WS_H2B); bf16_t* MERGED = (bf16_t*)(ws + WS_MERGED); bf16_t* H1B = (bf16_t*)(ws + WS_H1B);
    bf16_t* PROB = (bf16_t*)(ws + WS_PROB); bf16_t* ACT = (bf16_t*)(ws + WS_ACT);
    bf16_t* WINT = (bf16_t*)(ws + WS_WINT); bf16_t* PCATT = (bf16_t*)(ws + WS_PCATT); bf16_t* WOUTT = (bf16_t*)(ws + WS_WOUTT);
    bf16_t* W1T = (bf16_t*)(ws + WS_W1T); bf16_t* W2T = (bf16_t*)(ws + WS_W2T);
    float* OUT = a.out;
    LAS float* scr = (LAS float*)(ldsl + wave * 16384);

    {
        constexpr int ph = PH;
        if constexpr (ph == 0) {
            {
                const float* W = a.in[I_WIN];
                for (int it = gw; it < 16 * 241; it += NGW) { const int kb = it / 241, nb = it % 241, c = nb * 32;
                    const int drow = (c < C_LORA) ? c : (c < C_AQ) ? 7424 + (c - C_LORA) : (c < C_GATE) ? 5120 + (c - C_AQ) : 3072 + (c - C_GATE);
                    transpose_item(W, NIN, kb * 64, c, WINT, D, drow, 0, nullptr, scr, lane); }
                for (int i = gw * 64 + lane; i < 224 * D / 8; i += NGW * 64) *(u32x4*)(WINT + (size_t)7712 * D + (size_t)i * 8) = (u32x4){0u, 0u, 0u, 0u};
            }
            transpose_matrix(a.in[I_PRWKV], 1024, 1024, PCATT, KCAT, 0, nullptr, scr, lane, gw, NGW);
            transpose_matrix(a.in[I_PATTN], 256, 1024, PCATT, KCAT, 1024, nullptr, scr, lane, gw, NGW);
            transpose_matrix(a.in[I_WOUT], 1024, 1024, WOUTT, D, 0, nullptr, scr, lane, gw, NGW);
            for (int r = gw; r < M + 512; r += NGW) {
                const bool ism = r >= M; const int rr = ism ? r - M : r;
                const float* src = (ism ? a.in[I_MEM] : a.in[I_X]) + (size_t)rr * D; const float* g = ism ? a.in[I_NMEM] : a.in[I_NMIX];
                bf16_t* dst = (ism ? MEMN : XN) + (size_t)rr * D;
                float v[16]; float ss = 0.f;
#pragma unroll
                for (int i = 0; i < 16; ++i) { v[i] = src[lane + 64 * i]; ss += v[i] * v[i]; }
                const float rstd = rsqrtf(wave_sum(ss) * (1.f / D) + 1e-6f);
#pragma unroll
                for (int i = 0; i < 16; ++i) dst[lane + 64 * i] = f2bf(v[i] * rstd * g[lane + 64 * i]);
            }
        } else if constexpr (ph == 1) {
            ge::Sched S; S.o.init(64, 31, G, bid); S.A = (const char*)XN; S.B = (const char*)WINT; S.a_tile = (size_t)256 * D * 2; S.b_tile = (size_t)256 * D * 2; S.b_batch = 0;
            ge::EpiProj E; E.hook_t = -1; E.RKV = RKV; E.GATES = GATES; E.AQKV = AQKV; E.LORA = LORA;
            ge::gemm_phase<ge::EpiProj, ge::Sched, true>(ldsl, D, D, 16, S, E);
        } else if constexpr (ph == 13) {
            const float* WKV = a.in[I_WKV];
            naive_gemm(lds, 512, 2048, D, bid, G,
                [&](int m, int k) { return bf2f(MEMN[(size_t)m * D + k]); },
                [&](int k, int n) { return WKV[(size_t)k * 2048 + n]; },
                [&](int m, int n, float v) { KV[(size_t)m * 2048 + n] = f2bf(v); });
        } else if constexpr (ph == 2) {
            const float* WQ = a.in[I_WQ]; const float* WO = a.in[I_WO]; const float* GX = a.in[I_NX];
            for (int bh = 0; bh < 8; ++bh) {
                const int b = bh >> 2, h = bh & 3;
                naive_gemm(lds, 256, 1024, 256, bid, G,
                    [&](int m, int k) { return bf2f(KV[(size_t)(b * 256 + m) * 2048 + h * 256 + k]); },
                    [&](int k, int n) { return WQ[(size_t)n * 1024 + h * 256 + k]; },
                    [&](int m, int n, float v) { WST[((size_t)b * 1024 + h * 256 + m) * 1024 + n] = f2bf(v * GX[n] * 0.0625f); });
                naive_gemm(lds, 1024, 256, 256, bid, G,
                    [&](int m, int k) { return WO[(size_t)(h * 256 + k) * 1024 + m]; },
                    [&](int k, int n) { return bf2f(KV[(size_t)(b * 256 + n) * 2048 + 1024 + h * 256 + k]); },
                    [&](int m, int n, float v) { VWT[((size_t)b * 1024 + m) * 1024 + h * 256 + n] = f2bf(v); });
            }
        } else if constexpr (ph == 3) {
            if (bid < 32) scan_naive(a, lds, bid);
            else dil_attn_naive(a, lds, (bid - 32) * NWAVES + wave, (G - 32) * NWAVES);
        } else if constexpr (ph == 4) {
            transpose_matrix(a.in[I_W1], 1024, 4096, W1T, D, 0, a.in[I_NFFN], scr, lane, gw, NGW);
            transpose_matrix(a.in[I_FW2], 4096, 1024, W2T, FF, 0, nullptr, scr, lane, gw, NGW);
        } else if constexpr (ph == 5) {
            ge::Sched S; S.o.init(64, 4, G, bid); S.A = (const char*)ACAT; S.B = (const char*)PCATT; S.a_tile = (size_t)256 * KCAT * 2; S.b_tile = (size_t)256 * KCAT * 2; S.b_batch = 0;
            ge::EpiMerged E; E.hook_t = 16; E.GATES = GATES; E.MERGED = MERGED;
            ge::gemm_phase<ge::EpiMerged, ge::Sched, false>(ldsl, KCAT, KCAT, 20, S, E);
        } else if constexpr (ph == 7) {
            ge::Sched S; S.o.init(64, 4, G, bid); S.A = (const char*)MERGED; S.B = (const char*)WOUTT; S.a_tile = (size_t)256 * D * 2; S.b_tile = (size_t)256 * D * 2; S.b_batch = 0;
            ge::EpiResid E; E.hook_t = -1; E.base = a.in[I_X]; E.out = OUT; E.hb = H1B; E.SS = SS1;
            ge::gemm_phase<ge::EpiResid, ge::Sched, false>(ldsl, D, D, 16, S, E);
        } else if constexpr (ph == 8) {
            ge::Sched S; S.o.init(64, 4, G, bid); S.A = (const char*)H1B; S.B = (const char*)WST; S.a_tile = (size_t)256 * D * 2; S.b_tile = (size_t)256 * D * 2; S.b_batch = (size_t)1024 * 1024 * 2;
            ge::EpiSoftmax E; E.hook_t = -1; E.SS = SS1; E.PROB = PROB;
            ge::gemm_phase<ge::EpiSoftmax, ge::Sched, false>(ldsl, D, D, 16, S, E);
        } else if constexpr (ph == 9) {
            ge::Sched S; S.o.init(64, 4, G, bid); S.A = (const char*)PROB; S.B = (const char*)VWT; S.a_tile = (size_t)256 * D * 2; S.b_tile = (size_t)256 * D * 2; S.b_batch = (size_t)1024 * 1024 * 2;
            ge::EpiResid E; E.hook_t = -1; E.base = OUT; E.out = OUT; E.hb = H2B; E.SS = SS2;
            ge::gemm_phase<ge::EpiResid, ge::Sched, false>(ldsl, D, D, 16, S, E);
        } else if constexpr (ph == 10) {
            ge::Sched S; S.o.init(64, 16, G, bid); S.A = (const char*)H2B; S.B = (const char*)W1T; S.a_tile = (size_t)256 * D * 2; S.b_tile = (size_t)256 * D * 2; S.b_batch = 0;
            ge::EpiRelu2 E; E.hook_t = -1; E.SS = SS2; E.ACT = ACT;
            ge::gemm_phase<ge::EpiRelu2, ge::Sched, true>(ldsl, D, D, 16, S, E);
        } else if constexpr (ph == 11) {
            ge::Sched S; S.o.init(64, 4, G, bid); S.A = (const char*)ACT; S.B = (const char*)W2T; S.a_tile = (size_t)256 * FF * 2; S.b_tile = (size_t)256 * FF * 2; S.b_batch = 0;
            ge::EpiResid E; E.hook_t = -1; E.base = OUT; E.out = OUT; E.hb = nullptr; E.SS = SS3;
            ge::gemm_phase<ge::EpiResid, ge::Sched, false>(ldsl, FF, FF, 64, S, E);
        } else if constexpr (ph == 12) {
            const float* g = a.in[I_NFIN];
            for (int r = gw; r < M; r += NGW) {
                const float rstd = ge::rstd_from_ss(SS3, (size_t)r);
#pragma unroll
                for (int i = 0; i < 4; ++i) { const size_t o = (size_t)r * D + (lane + 64 * i) * 4; const f32x4 v = *(const f32x4*)(OUT + o), gg = *(const f32x4*)(g + (lane + 64 * i) * 4); *(f32x4*)(OUT + o) = v * rstd * gg; }
            }
        }
    }
}

extern "C" void kernel_launch(void* const* d_in, const int* in_sizes, int n_in, void* d_out, int out_size, void* d_ws, size_t ws_size, hipStream_t stream) {
    static int grid = 0;
    if (grid == 0) {
        if (n_in != 27 || out_size != M * D || ws_size < 256 * MiB) { fprintf(stderr, "kernel_launch: unexpected shapes (n_in %d out %d ws %zu)\n", n_in, out_size, ws_size); grid = -1; return; }
        grid = 256;
    }
    if (grid < 0) return;
    Args a{};
    for (int i = 0; i < 27; ++i) a.in[i] = (const float*)d_in[i];
    a.out = (float*)d_out; a.ws = (unsigned char*)d_ws;
#define LAUNCH(PH) do { if (first) (void)hipFuncSetAttribute((const void*)mk_fwd<PH>, hipFuncAttributeMaxDynamicSharedMemorySize, LDS_BYTES); \
        hipLaunchKernelGGL(mk_fwd<PH>, dim3(grid), dim3(NTHREADS), LDS_BYTES, stream, a); } while (0)
    static bool first = true;
    LAUNCH(0); LAUNCH(1); LAUNCH(13); LAUNCH(2); LAUNCH(3); LAUNCH(4); LAUNCH(5); LAUNCH(7); LAUNCH(8); LAUNCH(9); LAUNCH(10); LAUNCH(11); LAUNCH(12);
    first = false;
}
```

```cpp
#include <hip/hip_runtime.h>
#include <hip/hip_cooperative_groups.h>
namespace cg = cooperative_groups;
#include <cstdint>
#include <cstdio>

typedef unsigned short bf16_t;
typedef float f32x4 __attribute__((ext_vector_type(4)));

constexpr int BATCH = 2, SEQ = 8192, M = BATCH * SEQ, D = 1024;
constexpr int NIN = 7712;
constexpr int C_LORA = 3072, C_AQ = 3360, C_GATE = 5664;
constexpr int NLORA = 288, NAQKV = 2304, NGATE = 2048, NRKV = 3072;
constexpr int MEMLEN = 256, FF = 4096, KCAT = 1280;
constexpr int CH = 32;

constexpr size_t KiB = 1024, MiB = 1024 * 1024;
constexpr size_t WS_CTL = 0;
constexpr size_t WS_WINT = 2 * MiB;
constexpr size_t WS_XN = 17 * MiB + 512 * KiB;
constexpr size_t WS_MEMN = 49 * MiB + 512 * KiB;
constexpr size_t WS_WKVT = 50 * MiB + 512 * KiB;
constexpr size_t WS_ACAT = WS_XN;
constexpr size_t WS_RKV = 57 * MiB + 512 * KiB;
constexpr size_t WS_LORA = 153 * MiB + 512 * KiB;
constexpr size_t WS_AQKV = 162 * MiB + 512 * KiB;
constexpr size_t WS_PCATT = 234 * MiB + 512 * KiB;
constexpr size_t WS_WOUTT = 237 * MiB;
constexpr size_t WS_WST = 239 * MiB;
constexpr size_t WS_VWT = 243 * MiB;
constexpr size_t WS_WQB = 247 * MiB;
constexpr size_t WS_WOT = 249 * MiB;
constexpr size_t WS_KV = 251 * MiB;
constexpr size_t WS_SS1 = 253 * MiB;
constexpr size_t WS_SS2 = 254 * MiB;
constexpr size_t WS_SS3 = 255 * MiB;
constexpr size_t WS_W1T = 57 * MiB + 512 * KiB;
constexpr size_t WS_W2T = 65 * MiB + 512 * KiB;
constexpr size_t WS_H2B = 73 * MiB + 512 * KiB;
constexpr size_t WS_MERGED = 105 * MiB + 512 * KiB;
constexpr size_t WS_H1B = 137 * MiB + 512 * KiB;
constexpr size_t WS_PROB = 169 * MiB + 512 * KiB;
constexpr size_t WS_ACT = 105 * MiB + 512 * KiB;

constexpr int NTHREADS = 512, NWAVES = 8;
constexpr int LDS_BYTES = 147456;

__device__ __forceinline__ float bf2f(bf16_t v) { return __uint_as_float(((unsigned)v) << 16); }
__device__ __forceinline__ bf16_t f2bf(float f) { unsigned u = __float_as_uint(f); return (bf16_t)((u + 0x7fffu + ((u >> 16) & 1u)) >> 16); }
__device__ __forceinline__ float sigmoidf_(float x) { return 1.f / (1.f + __expf(-x)); }
__device__ __forceinline__ float wave_sum(float v) {
#pragma unroll
    for (int o = 1; o < 64; o <<= 1) v += __shfl_xor(v, o);
    return v;
}
__device__ __forceinline__ float wave_max(float v) {
#pragma unroll
    for (int o = 1; o < 64; o <<= 1) v = fmaxf(v, __shfl_xor(v, o));
    return v;
}

struct Args {
    const float* in[27];
    float* out;
    unsigned char* ws;
    int ph_lo, ph_hi;
};

enum { I_X = 0, I_MEM, I_NMIX, I_WIN, I_MU, I_W0, I_W2, I_A0, I_A2, I_G2, I_KK, I_KA, I_RK, I_GNW, I_GNB, I_PRWKV, I_PATTN, I_WOUT,
       I_NX, I_NMEM, I_WQ, I_WKV, I_WO, I_NFFN, I_W1, I_FW2, I_NFIN };

__device__ __forceinline__ void scan_naive(const Args& a, float* lds, int bh) {
    const int b = bh >> 4, h = bh & 15;
    const int tid = threadIdx.x, lane = tid & 63, wave = tid >> 6;
    const bf16_t* RKV = (const bf16_t*)(a.ws + WS_RKV);
    const bf16_t* LORA = (const bf16_t*)(a.ws + WS_LORA);
    bf16_t* ACAT = (bf16_t*)(a.ws + WS_ACAT);
    const float* mu = a.in[I_MU];
    float* actW = lds;
    float* actA = actW + CH * 64;
    float* actG = actA + CH * 64;
    float* Wd = actG + CH * 160;
    float* Kk = Wd + CH * 64;
    float* Aa = Kk + CH * 64;
    float* Bb = Aa + CH * 64;
    float* Rr = Bb + CH * 64;
    float* Vv = Rr + CH * 64;
    float* Gg = Vv + CH * 64;
    float* Yy = Gg + CH * 64;
    float* bon = Yy + CH * 64;
    const int hj0 = h * 64;
    float st[8];
#pragma unroll
    for (int e = 0; e < 8; ++e) st[e] = 0.f;
    const int row_i = wave * 8 + (lane >> 3), cg = lane & 7;
    for (int c0 = 0; c0 < SEQ; c0 += CH) {
        const size_t m0 = (size_t)b * SEQ + c0;
        __syncthreads();
        for (int idx = tid; idx < CH * NLORA; idx += NTHREADS) {
            const int t = idx / NLORA, c = idx % NLORA;
            const float cur = bf2f(LORA[(m0 + t) * NLORA + c]);
            const float prev = (c0 + t == 0) ? 0.f : bf2f(LORA[(m0 + t - 1) * NLORA + c]);
            const float s = cur + mu[C_LORA + c] * (prev - cur);
            if (c < 64) actW[t * 64 + c] = tanhf(s);
            else if (c < 128) actA[t * 64 + c - 64] = s;
            else actG[t * 160 + c - 128] = sigmoidf_(s);
        }
        for (int idx = tid; idx < CH * 64; idx += NTHREADS) {
            const int t = idx >> 6, j = idx & 63;
            const bool first = (c0 + t == 0);
#pragma unroll
            for (int q = 0; q < 3; ++q) {
                const int col = q * 1024 + hj0 + j;
                const float cur = bf2f(RKV[(m0 + t) * NRKV + col]);
                const float prev = first ? 0.f : bf2f(RKV[(m0 + t - 1) * NRKV + col]);
                const float s = cur + mu[col] * (prev - cur);
                if (q == 0) Rr[idx] = s; else if (q == 1) Kk[idx] = s; else Vv[idx] = s;
            }
        }
        __syncthreads();
        for (int idx = tid; idx < CH * 64; idx += NTHREADS) {
            const int t = idx >> 6, j = idx & 63, hj = hj0 + j;
            float wp = a.in[I_W0][hj], ap = a.in[I_A0][hj], g = 0.f;
            for (int c = 0; c < 64; ++c) { wp += actW[t * 64 + c] * a.in[I_W2][c * 1024 + hj]; ap += actA[t * 64 + c] * a.in[I_A2][c * 1024 + hj]; }
            for (int c = 0; c < 160; ++c) g += actG[t * 160 + c] * a.in[I_G2][c * 1024 + hj];
            const float z = -wp;
            const float sp = fmaxf(z, 0.f) + log1pf(__expf(-fabsf(z)));
            const float wlog = -sp - 0.5f;
            Wd[idx] = __expf(-__expf(wlog));
            Aa[idx] = sigmoidf_(ap);
            Gg[idx] = g;
        }
        __syncthreads();
#pragma unroll
        for (int q = 0; q < 4; ++q) {
            const int t = wave * 4 + q, idx = t * 64 + lane, hj = hj0 + lane;
            const float pk = Kk[idx], alr = Aa[idx];
            const float kr = pk * a.in[I_KK][hj];
            const float ss = wave_sum(kr * kr);
            const float kk = kr / fmaxf(sqrtf(ss), 1e-12f);
            const float kmod = pk * (1.f + (alr - 1.f) * a.in[I_KA][hj]);
            const float bs = wave_sum(Rr[idx] * kmod * a.in[I_RK][hj]);
            Aa[idx] = -kk; Bb[idx] = kk * alr; Kk[idx] = kmod;
            if (lane == 0) bon[t] = bs;
        }
        __syncthreads();
        for (int t = 0; t < CH; ++t) {
            const float* ap = Aa + t * 64 + cg * 8; const float* wp = Wd + t * 64 + cg * 8; const float* kp = Kk + t * 64 + cg * 8;
            const float* bp = Bb + t * 64 + cg * 8; const float* rp = Rr + t * 64 + cg * 8;
            float sa = 0.f;
#pragma unroll
            for (int e = 0; e < 8; ++e) sa += st[e] * ap[e];
            sa += __shfl_xor(sa, 1); sa += __shfl_xor(sa, 2); sa += __shfl_xor(sa, 4);
            const float vi = Vv[t * 64 + row_i];
            float y = 0.f;
#pragma unroll
            for (int e = 0; e < 8; ++e) { st[e] = st[e] * wp[e] + sa * bp[e] + vi * kp[e]; y += st[e] * rp[e]; }
            y += __shfl_xor(y, 1); y += __shfl_xor(y, 2); y += __shfl_xor(y, 4);
            if (cg == 0) Yy[t * 64 + row_i] = y;
        }
        __syncthreads();
#pragma unroll
        for (int q = 0; q < 4; ++q) {
            const int t = wave * 4 + q, idx = t * 64 + lane, hi = hj0 + lane;
            const float y = Yy[idx];
            const float mean = wave_sum(y) * (1.f / 64.f);
            const float dy = y - mean;
            const float var = wave_sum(dy * dy) * (1.f / 64.f);
            const float yn = dy * rsqrtf(var + 64.f * 1e-5f) * a.in[I_GNW][hi] + a.in[I_GNB][hi];
            const float o = (yn + bon[t] * Vv[idx]) * Gg[idx];
            ACAT[(m0 + t) * KCAT + hi] = f2bf(o);
        }
    }
}

__device__ __forceinline__ void dil_attn_naive(const Args& a, float* lds, int wave_gid, int nwaves_total) {
    const int lane = threadIdx.x & 63, wave = threadIdx.x >> 6;
    const bf16_t* AQ = (const bf16_t*)(a.ws + WS_AQKV);
    bf16_t* ACAT = (bf16_t*)(a.ws + WS_ACAT);
    float* pbuf = lds + wave * 640;
    float* qs = pbuf + 448;
    for (int task = wave_gid; task < M * 4; task += nwaves_total) {
        const int m = task >> 2, s = task & 3, p = m & (SEQ - 1);
#pragma unroll
        for (int g = 0; g < 3; ++g) qs[g * 64 + lane] = bf2f(AQ[(size_t)m * NAQKV + (g * 4 + s) * 64 + lane]);
        float sc[7];
        float mx = -INFINITY;
#pragma unroll
        for (int i = 0; i < 7; ++i) {
            const int idx = lane + i * 64;
            float v = -INFINITY;
            if (idx < 387) {
                const int g = idx / 129, stp = idx % 129, dil = (g == 0) ? 1 : (g == 1 ? 4 : 16), hd = g * 4 + s;
                if (stp * dil <= p) {
                    const bf16_t* kr = AQ + (size_t)(m - stp * dil) * NAQKV + 768 + hd * 64;
                    float dot = 0.f;
                    for (int c = 0; c < 64; ++c) dot += qs[g * 64 + c] * bf2f(kr[c]);
                    const float slope = exp2f(-8.f * (float)(hd + 1) / 12.f);
                    v = dot * 0.125f - slope * (float)(stp * dil);
                }
            }
            sc[i] = v; mx = fmaxf(mx, v);
        }
        mx = wave_max(mx);
        float sum = 0.f;
#pragma unroll
        for (int i = 0; i < 7; ++i) { const int idx = lane + i * 64; const float e = (sc[i] == -INFINITY) ? 0.f : __expf(sc[i] - mx); sum += e; if (idx < 448) pbuf[idx] = e; }
        sum = wave_sum(sum);
        float acc = 0.f;
        for (int idx = 0; idx < 387; ++idx) {
            const int g = idx / 129, stp = idx % 129, dil = (g == 0) ? 1 : (g == 1 ? 4 : 16), hd = g * 4 + s;
            if (stp * dil <= p) acc += pbuf[idx] * bf2f(AQ[(size_t)(m - stp * dil) * NAQKV + 1536 + hd * 64 + lane]);
        }
        ACAT[(size_t)m * KCAT + 1024 + s * 64 + lane] = f2bf(acc / sum);
    }
}

#define LAS __attribute__((address_space(3)))
typedef short bf16x8 __attribute__((ext_vector_type(8)));
typedef unsigned u32x4 __attribute__((ext_vector_type(4)));
namespace ge {
constexpr int BM = 256, BK = 64, HALF = 128, HTB = HALF * BK * 2, STAGE_BYTES = 8 * HTB, NXCD = 8, WGM = 8;
__host__ __device__ __forceinline__ int lds_byte(int r, int c) { const int st = (r >> 4) * 2 + (c >> 5), rr = r & 15, cc = c & 31, ob = rr * 64 + cc * 2; return st * 1024 + (ob ^ (((ob >> 9) & 1) << 5)); }
__host__ __device__ __forceinline__ void stage_rc(int b, int& R, int& C) { const int st = b / 1024, sb = b % 1024, swz = sb ^ (((sb >> 9) & 1) << 5); R = (st >> 1) * 16 + swz / 64; C = (st & 1) * 32 + (swz % 64) / 2; }
__host__ __device__ __forceinline__ int perm32(int rho) { const int n = rho >> 4, i = rho & 15; return 8 * (i >> 2) + 4 * n + (i & 3); }

struct Unit { const char* A; const char* B; int pm, pn; };

struct Order {
    int nM, nN, nwg, G, c;
    __device__ __forceinline__ void init(int nM_, int nN_, int G_, int c_) { nM = nM_; nN = nN_; nwg = nM * nN; G = G_; c = c_; }
    __device__ __forceinline__ bool next(int i, int& pm, int& pn) const {
        const long L = (long)i * G + c; if (L >= nwg) return false;
        int wgid = (int)L; { const int q = nwg / NXCD, r = nwg % NXCD, xcd = wgid % NXCD, off = wgid / NXCD; wgid = (xcd < r ? xcd * (q + 1) : r * (q + 1) + (xcd - r) * q) + off; }
        const int nig = WGM * nN, gid = wgid / nig, fm = gid * WGM, gsz = (nM - fm) < WGM ? (nM - fm) : WGM;
        pm = fm + ((wgid % nig) % gsz); pn = (wgid % nig) / gsz; return true;
    }
};
struct Sched {
    Order o; const char* A; const char* B; size_t a_tile, b_tile, b_batch;
    __device__ __forceinline__ bool next(int i, Unit& u) const {
        int pm, pn; if (!o.next(i, pm, pn)) return false;
        u.pm = pm; u.pn = pn; u.A = A + (size_t)pm * a_tile; u.B = B + (size_t)pn * b_tile + (size_t)(pm >> 5) * b_batch; return true;
    }
};

__device__ __forceinline__ unsigned cvt_pk_bf16(float lo, float hi) { unsigned r; asm volatile("v_cvt_pk_bf16_f32 %0, %1, %2" : "=v"(r) : "v"(lo), "v"(hi)); return r; }
__device__ __forceinline__ u32x4 pack8(const f32x4 v0, const f32x4 v1) { u32x4 w; w.x = cvt_pk_bf16(v0[0], v0[1]); w.y = cvt_pk_bf16(v0[2], v0[3]); w.z = cvt_pk_bf16(v1[0], v1[1]); w.w = cvt_pk_bf16(v1[2], v1[3]); return w; }
__device__ __forceinline__ void unpack8(const u32x4 w, f32x4& v0, f32x4& v1) {
    v0[0] = __uint_as_float(w.x << 16); v0[1] = __uint_as_float(w.x & 0xffff0000u); v0[2] = __uint_as_float(w.y << 16); v0[3] = __uint_as_float(w.y & 0xffff0000u);
    v1[0] = __uint_as_float(w.z << 16); v1[1] = __uint_as_float(w.z & 0xffff0000u); v1[2] = __uint_as_float(w.w << 16); v1[3] = __uint_as_float(w.w & 0xffff0000u);
}

template <class Epi, class SchedT, bool ALIGN_EPI>
__device__ __forceinline__ void gemm_phase(LAS unsigned char* lds, const int lda, const int ldb, const int nt, const SchedT& S, const Epi& E) {
    int tid_o = threadIdx.x; asm volatile("" : "+v"(tid_o));
    const int tid = tid_o, wid = __builtin_amdgcn_readfirstlane(tid >> 6), lane = tid & 63, wr = wid >> 2, wc = wid & 3, fr = lane & 15, fq = lane >> 4;
    unsigned voffA[2], voffB[2];
#pragma unroll
    for (int i = 0; i < 2; ++i) { int R, C; stage_rc(tid * 16 + i * 8192, R, C); const int Rb = (R & ~31) + perm32(R & 31);
        voffA[i] = (unsigned)(R * lda + C) * 2u; voffB[i] = (unsigned)(Rb * ldb + C) * 2u; }
    const size_t kstep = (size_t)(BK * 2);
    const size_t hstepA = (size_t)HALF * lda * 2, hstepB = (size_t)HALF * ldb * 2;
    const unsigned ldsw = (unsigned)wid * 1024u;
    const int aoff = lds_byte(wr * 64 + fr, fq * 8), boff = lds_byte(wc * 32 + fr, fq * 8);
#define GE_SA(b, h) (((b) * 2 + (h)) * ge::HTB)
#define GE_SB(b, h) ((4 + (b) * 2 + (h)) * ge::HTB)
#define GE_STAGE(bufoff, gbase, voff) do { _Pragma("unroll") for (int _i = 0; _i < 2; ++_i) \
        __builtin_amdgcn_global_load_lds((const unsigned*)((const char*)(gbase) + (voff)[_i]), (LAS unsigned*)(lds + (bufoff) + ldsw + _i * 8192), 16, 0, 0); } while (0)
#define GE_LDA(dst, b, h) do { _Pragma("unroll") for (int m = 0; m < 4; ++m) _Pragma("unroll") for (int k = 0; k < 2; ++k) dst[m][k] = *(const LAS bf16x8*)(lds + GE_SA(b, h) + aoff + m * 2048 + k * 1024); } while (0)
#define GE_LDB(dst, b, h) do { _Pragma("unroll") for (int n = 0; n < 2; ++n) _Pragma("unroll") for (int k = 0; k < 2; ++k) dst[n][k] = *(const LAS bf16x8*)(lds + GE_SB(b, h) + boff + n * 2048 + k * 1024); } while (0)
#define GE_MMA(ai, bj, At, Bt) do { __builtin_amdgcn_s_setprio(1); _Pragma("unroll") for (int m = 0; m < 4; ++m) _Pragma("unroll") for (int n = 0; n < 2; ++n) _Pragma("unroll") for (int k = 0; k < 2; ++k) \
        acc[ai][bj][m][n] = __builtin_amdgcn_mfma_f32_16x16x32_bf16(Bt[n][k], At[m][k], acc[ai][bj][m][n], 0, 0, 0); __builtin_amdgcn_s_setprio(0); } while (0)
#define GE_WAIT_V(n) asm volatile("s_waitcnt vmcnt(" #n ")" ::: "memory")
#define GE_WAIT_L(n) asm volatile("s_waitcnt lgkmcnt(" #n ")" ::: "memory")
#define GE_BAR __builtin_amdgcn_s_barrier()
#define GE_SCHED __builtin_amdgcn_sched_barrier(0)
    Unit cur, nxt; int ui = 0;
    if (!S.next(0, cur)) return;
    f32x4 acc[2][2][4][2];
#pragma unroll
    for (int a = 0; a < 2; ++a)
#pragma unroll
        for (int b = 0; b < 2; ++b)
#pragma unroll
            for (int m = 0; m < 4; ++m)
#pragma unroll
                for (int n = 0; n < 2; ++n) acc[a][b][m][n] = (f32x4){0.f, 0.f, 0.f, 0.f};
    bf16x8 At[4][2], B0[2][2], B1[2][2];
    const char* cA = cur.A; const char* cB = cur.B;
    GE_STAGE(GE_SB(0, 0), cB, voffB); GE_STAGE(GE_SB(0, 1), cB + hstepB, voffB); GE_STAGE(GE_SA(0, 0), cA, voffA); GE_STAGE(GE_SA(0, 1), cA + hstepA, voffA);
    if (wr == 1) GE_BAR;
    GE_WAIT_V(2); GE_BAR;
    GE_STAGE(GE_SB(1, 0), cB + kstep, voffB); GE_STAGE(GE_SA(1, 0), cA + kstep, voffA); GE_STAGE(GE_SB(1, 1), cB + hstepB + kstep, voffB);
    GE_WAIT_V(6); GE_BAR;
    for (;;) {
        const bool has_next = S.next(ui + 1, nxt);
        const char* nA = has_next ? nxt.A : cA; const char* nB = has_next ? nxt.B : cB;
        for (int t = 0; t < nt; t += 2) {
            if constexpr (Epi::HOOK) { if (t == E.hook_t) E.hook(acc, cur, wr, wc, fr, fq); }
            const bool last = (t == nt - 2);
            const char* a1 = cA + (size_t)(t + 1) * kstep;
            const char* a2 = last ? nA : cA + (size_t)(t + 2) * kstep; const char* b2 = last ? nB : cB + (size_t)(t + 2) * kstep;
            const char* a3 = a2 + kstep; const char* b3 = b2 + kstep;
            GE_LDB(B0, 0, 0); GE_LDB(B1, 0, 1); GE_SCHED; GE_LDA(At, 0, 0); GE_STAGE(GE_SA(1, 1), a1 + hstepA, voffA);
            GE_WAIT_V(8); GE_WAIT_L(0); GE_BAR; GE_MMA(0, 0, At, B0); GE_MMA(0, 1, At, B1); GE_BAR; GE_SCHED;
            GE_LDA(At, 0, 1); GE_STAGE(GE_SB(0, 0), b2, voffB); GE_STAGE(GE_SB(0, 1), b2 + hstepB, voffB); GE_STAGE(GE_SA(0, 0), a2, voffA);
            GE_WAIT_V(8); GE_WAIT_L(0); GE_BAR; GE_MMA(1, 0, At, B0); GE_MMA(1, 1, At, B1); GE_BAR; GE_SCHED;
            GE_LDB(B0, 1, 0); GE_LDB(B1, 1, 1); GE_SCHED; GE_LDA(At, 1, 0); GE_STAGE(GE_SA(0, 1), a2 + hstepA, voffA);
            GE_WAIT_V(8); GE_WAIT_L(0); GE_BAR; GE_MMA(0, 0, At, B0); GE_MMA(0, 1, At, B1); GE_BAR; GE_SCHED;
            GE_LDA(At, 1, 1); GE_STAGE(GE_SB(1, 0), b3, voffB); GE_STAGE(GE_SB(1, 1), b3 + hstepB, voffB); GE_STAGE(GE_SA(1, 0), a3, voffA);
            GE_WAIT_V(8); GE_WAIT_L(0); GE_BAR; GE_MMA(1, 0, At, B0); GE_MMA(1, 1, At, B1); GE_BAR; GE_SCHED;
        }
        if constexpr (ALIGN_EPI) { if (wr == 0) GE_BAR; }
        if constexpr (!Epi::AFTER_DRAIN) { E(acc, cur, wr, wc, fr, fq); }
        if (!has_next) break;
#pragma unroll
        for (int a = 0; a < 2; ++a)
#pragma unroll
            for (int b = 0; b < 2; ++b)
#pragma unroll
                for (int m = 0; m < 4; ++m)
#pragma unroll
                    for (int n = 0; n < 2; ++n) acc[a][b][m][n] = (f32x4){0.f, 0.f, 0.f, 0.f};
        cur = nxt; cA = nA; cB = nB; ++ui;
        if constexpr (ALIGN_EPI) { if (wr == 1) GE_BAR; }
    }
    GE_WAIT_V(0);
    if constexpr (!ALIGN_EPI) { if (wr == 0) GE_BAR; }
    GE_BAR;
    if constexpr (Epi::AFTER_DRAIN) { E.fused(acc, cur, wr, wc, fr, fq, lds, wid, lane); }
#undef GE_SA
#undef GE_SB
#undef GE_STAGE
#undef GE_LDA
#undef GE_LDB
#undef GE_MMA
#undef GE_WAIT_V
#undef GE_WAIT_L
#undef GE_BAR
#undef GE_SCHED
}

#define GE_ROW(ai, m) (u.pm * 256 + (ai) * 128 + wr * 64 + (m) * 16 + fr)
#define GE_COL(bj) (u.pn * 256 + (bj) * 128 + wc * 32 + 8 * fq)
typedef f32x4 Acc[2][2][4][2];

__device__ __forceinline__ float fast_sigmoid(float x) { return __builtin_amdgcn_rcpf(1.f + __expf(-x)); }

struct EpiProj {
    static constexpr bool AFTER_DRAIN = false, HOOK = false; int hook_t;
    bf16_t *RKV, *GATES, *AQKV, *LORA, *KV;
    __device__ __forceinline__ void hook(Acc&, const Unit&, int, int, int, int) const {}
    __device__ __forceinline__ void operator()(const Acc& acc, const Unit& u, int wr, int wc, int fr, int fq) const {
        const int pn = u.pn; bf16_t* base; int ld, cbase, climit = 1 << 30; bool sig = false;
        if (pn >= 100) { base = KV; ld = 2048; cbase = (pn - 100) * 256; }
        else if (pn < 12) { base = RKV; ld = NRKV; cbase = pn * 256; }
        else if (pn < 20) { base = GATES; ld = NGATE; cbase = (pn - 12) * 256; sig = true; }
        else if (pn < 29) { base = AQKV; ld = NAQKV; cbase = (pn - 20) * 256; }
        else { base = LORA; ld = NLORA; cbase = (pn - 29) * 256; climit = NLORA; }
#pragma unroll
        for (int ai = 0; ai < 2; ++ai)
#pragma unroll
            for (int m = 0; m < 4; ++m) { bf16_t* rowp = base + (size_t)GE_ROW(ai, m) * ld;
#pragma unroll
                for (int bj = 0; bj < 2; ++bj) { const int c = cbase + bj * 128 + wc * 32 + 8 * fq;
                    if (c < climit) { f32x4 v0 = acc[ai][bj][m][0], v1 = acc[ai][bj][m][1];
                        if (sig) {
#pragma unroll
                            for (int j = 0; j < 4; ++j) { v0[j] = fast_sigmoid(v0[j]); v1[j] = fast_sigmoid(v1[j]); } }
                        *(u32x4*)(rowp + c) = pack8(v0, v1); } } }
    }
};
struct EpiMerged {
    static constexpr bool AFTER_DRAIN = false, HOOK = true; int hook_t;
    const bf16_t* GATES; bf16_t* MERGED;
    __device__ __forceinline__ void hook(Acc& acc, const Unit& u, int wr, int wc, int fr, int fq) const {
#pragma unroll
        for (int ai = 0; ai < 2; ++ai)
#pragma unroll
            for (int m = 0; m < 4; ++m) { const bf16_t* g = GATES + (size_t)GE_ROW(ai, m) * NGATE;
#pragma unroll
                for (int bj = 0; bj < 2; ++bj) { const int c = GE_COL(bj); f32x4 r0, r1, a0, a1;
                    unpack8(*(const u32x4*)(g + c), r0, r1); unpack8(*(const u32x4*)(g + 1024 + c), a0, a1);
#pragma unroll
                    for (int j = 0; j < 4; ++j) { acc[ai][bj][m][0][j] *= r0[j] * __builtin_amdgcn_rcpf(a0[j]); acc[ai][bj][m][1][j] *= r1[j] * __builtin_amdgcn_rcpf(a1[j]); } } }
    }
    __device__ __forceinline__ void operator()(const Acc& acc, const Unit& u, int wr, int wc, int fr, int fq) const {
#pragma unroll
        for (int ai = 0; ai < 2; ++ai)
#pragma unroll
            for (int m = 0; m < 4; ++m) { const size_t r = (size_t)GE_ROW(ai, m);
#pragma unroll
                for (int bj = 0; bj < 2; ++bj) { const int c = GE_COL(bj); f32x4 a0, a1;
                    unpack8(*(const u32x4*)(GATES + r * NGATE + 1024 + c), a0, a1);
                    *(u32x4*)(MERGED + r * D + c) = pack8(acc[ai][bj][m][0] * a0, acc[ai][bj][m][1] * a1); } }
    }
};
struct EpiResid {
    static constexpr bool AFTER_DRAIN = false, HOOK = false; int hook_t;
    const float* base; float* out; bf16_t* hb; float* SS;
    __device__ __forceinline__ void hook(Acc&, const Unit&, int, int, int, int) const {}
    __device__ __forceinline__ void operator()(const Acc& acc, const Unit& u, int wr, int wc, int fr, int fq) const {
#pragma unroll
        for (int ai = 0; ai < 2; ++ai)
#pragma unroll
            for (int m = 0; m < 4; ++m) { const size_t r = (size_t)GE_ROW(ai, m); float ss = 0.f;
#pragma unroll
                for (int bj = 0; bj < 2; ++bj) { const int c = GE_COL(bj);
                    const f32x4 o0 = *(const f32x4*)(base + r * D + c) + acc[ai][bj][m][0], o1 = *(const f32x4*)(base + r * D + c + 4) + acc[ai][bj][m][1];
                    *(f32x4*)(out + r * D + c) = o0; *(f32x4*)(out + r * D + c + 4) = o1;
                    ss += (o0[0] * o0[0] + o0[1] * o0[1]) + (o0[2] * o0[2] + o0[3] * o0[3]) + (o1[0] * o1[0] + o1[1] * o1[1]) + (o1[2] * o1[2] + o1[3] * o1[3]);
                    if (hb) *(u32x4*)(hb + r * D + c) = pack8(o0, o1); }
                ss += __shfl_xor(ss, 16); ss += __shfl_xor(ss, 32);
                if (fq == 0) SS[r * 16 + u.pn * 4 + wc] = ss; }
    }
};
__device__ __forceinline__ float rstd_from_ss(const float* SS, size_t r) {
    const f32x4 a = *(const f32x4*)(SS + r * 16), b = *(const f32x4*)(SS + r * 16 + 4), c = *(const f32x4*)(SS + r * 16 + 8), d = *(const f32x4*)(SS + r * 16 + 12);
    const float s = ((a[0] + a[1]) + (a[2] + a[3])) + ((b[0] + b[1]) + (b[2] + b[3])) + ((c[0] + c[1]) + (c[2] + c[3])) + ((d[0] + d[1]) + (d[2] + d[3]));
    return rsqrtf(s * (1.f / D) + 1e-6f);
}
struct EpiRelu2 {
    static constexpr bool AFTER_DRAIN = false, HOOK = false; int hook_t;
    const float* SS; bf16_t* ACT;
    __device__ __forceinline__ void hook(Acc&, const Unit&, int, int, int, int) const {}
    __device__ __forceinline__ void operator()(const Acc& acc, const Unit& u, int wr, int wc, int fr, int fq) const {
#pragma unroll
        for (int ai = 0; ai < 2; ++ai)
#pragma unroll
            for (int m = 0; m < 4; ++m) { const size_t r = (size_t)GE_ROW(ai, m); const float rstd = rstd_from_ss(SS, r);
#pragma unroll
                for (int bj = 0; bj < 2; ++bj) { const int c = GE_COL(bj); f32x4 v0 = acc[ai][bj][m][0] * rstd, v1 = acc[ai][bj][m][1] * rstd;
#pragma unroll
                    for (int j = 0; j < 4; ++j) { const float a = fmaxf(v0[j], 0.f), b = fmaxf(v1[j], 0.f); v0[j] = a * a; v1[j] = b * b; }
                    *(u32x4*)(ACT + r * FF + c) = pack8(v0, v1); } }
    }
};
struct EpiSoftmax {
    static constexpr bool AFTER_DRAIN = true, HOOK = false; int hook_t;
    const float* SS; bf16_t* PROB;
    __device__ __forceinline__ void hook(Acc&, const Unit&, int, int, int, int) const {}
    __device__ __forceinline__ void operator()(const Acc&, const Unit&, int, int, int, int) const {}
    __device__ __forceinline__ void fused(Acc& acc, const Unit& u, int wr, int wc, int fr, int fq, LAS unsigned char* lds, int wid, int lane) const {
        LAS float* Pm = (LAS float*)lds; LAS float* Ps = Pm + 1024;
#pragma unroll
        for (int ai = 0; ai < 2; ++ai)
#pragma unroll
            for (int m = 0; m < 4; ++m) { const float rstd = rstd_from_ss(SS, (size_t)GE_ROW(ai, m)); float mx = -INFINITY;
#pragma unroll
                for (int bj = 0; bj < 2; ++bj)
#pragma unroll
                    for (int n = 0; n < 2; ++n)
#pragma unroll
                        for (int j = 0; j < 4; ++j) { const float s = acc[ai][bj][m][n][j] * rstd; acc[ai][bj][m][n][j] = s; mx = fmaxf(mx, s); }
                mx = fmaxf(mx, __shfl_xor(mx, 16)); mx = fmaxf(mx, __shfl_xor(mx, 32));
                if (fq == 0) Pm[(ai * 128 + wr * 64 + m * 16 + fr) * 4 + wc] = mx; }
        asm volatile("s_waitcnt lgkmcnt(0)" ::: "memory"); __builtin_amdgcn_s_barrier(); asm volatile("" ::: "memory");
#pragma unroll
        for (int ai = 0; ai < 2; ++ai)
#pragma unroll
            for (int m = 0; m < 4; ++m) { const int rl = ai * 128 + wr * 64 + m * 16 + fr; const f32x4 pm4 = *(const LAS f32x4*)(Pm + rl * 4);
                const float mx = fmaxf(fmaxf(pm4[0], pm4[1]), fmaxf(pm4[2], pm4[3])) * 1.44269504f; float sum = 0.f;
#pragma unroll
                for (int bj = 0; bj < 2; ++bj)
#pragma unroll
                    for (int n = 0; n < 2; ++n)
#pragma unroll
                        for (int j = 0; j < 4; ++j) { const float e = __builtin_amdgcn_exp2f(acc[ai][bj][m][n][j] * 1.44269504f - mx); acc[ai][bj][m][n][j] = e; sum += e; }
                sum += __shfl_xor(sum, 16); sum += __shfl_xor(sum, 32);
                if (fq == 0) Ps[rl * 4 + wc] = sum; }
        asm volatile("s_waitcnt lgkmcnt(0)" ::: "memory"); __builtin_amdgcn_s_barrier(); asm volatile("" ::: "memory");
#pragma unroll
        for (int ai = 0; ai < 2; ++ai)
#pragma unroll
            for (int m = 0; m < 4; ++m) { const int rl = ai * 128 + wr * 64 + m * 16 + fr; const f32x4 ps4 = *(const LAS f32x4*)(Ps + rl * 4);
                const float inv = 1.f / ((ps4[0] + ps4[1]) + (ps4[2] + ps4[3])); const size_t r = (size_t)GE_ROW(ai, m);
#pragma unroll
                for (int bj = 0; bj < 2; ++bj) *(u32x4*)(PROB + r * D + GE_COL(bj)) = pack8(acc[ai][bj][m][0] * inv, acc[ai][bj][m][1] * inv); }
    }
};
}

__device__ __forceinline__ void transpose_item(const float* W, int ldw, int k0, int n0, bf16_t* WT, int ldt, int drow0, int dk0, const float* kscale, LAS float* scr, int lane) {
#pragma unroll 8
    for (int i = 0; i < 32; ++i) { const int kk = 2 * i + (lane >> 5); float v = W[(size_t)(k0 + kk) * ldw + n0 + (lane & 31)]; if (kscale) v *= kscale[k0 + kk]; scr[kk * 33 + (lane & 31)] = v; }
    asm volatile("s_waitcnt lgkmcnt(0)" ::: "memory");
    const int c = lane & 7;
#pragma unroll
    for (int j = 0; j < 4; ++j) { const int n = (lane >> 3) + 8 * j; const LAS float* s = scr + (8 * c) * 33 + n;
        u32x4 o; o.x = ge::cvt_pk_bf16(s[0 * 33], s[1 * 33]); o.y = ge::cvt_pk_bf16(s[2 * 33], s[3 * 33]); o.z = ge::cvt_pk_bf16(s[4 * 33], s[5 * 33]); o.w = ge::cvt_pk_bf16(s[6 * 33], s[7 * 33]);
        *(u32x4*)(WT + (size_t)(drow0 + n) * ldt + dk0 + k0 + 8 * c) = o; }
    asm volatile("s_waitcnt lgkmcnt(0)" ::: "memory");
}
__device__ __forceinline__ void transpose_matrix(const float* W, int K, int N, bf16_t* WT, int ldt, int dk0, const float* kscale, LAS float* scr, int lane, int gw, int NGW) {
    const int nblk = N / 32, items = (K / 64) * nblk;
    for (int it = gw; it < items; it += NGW) { const int kb = it / nblk, nb = it % nblk; transpose_item(W, N, kb * 64, nb * 32, WT, ldt, nb * 32, dk0, kscale, scr, lane); }
}
namespace ge {
struct EpiScaleCol {
    static constexpr bool AFTER_DRAIN = false, HOOK = false; int hook_t;
    const float* colscale; float mul; bool use_cs; bf16_t* out; int ld;
    __device__ __forceinline__ void hook(Acc&, const Unit&, int, int, int, int) const {}
    __device__ __forceinline__ void operator()(const Acc& acc, const Unit& u, int wr, int wc, int fr, int fq) const {
#pragma unroll
        for (int bj = 0; bj < 2; ++bj) { const int c = GE_COL(bj);
            f32x4 s0 = (f32x4){mul, mul, mul, mul}, s1 = s0;
            if (use_cs) { s0 = s0 * *(const f32x4*)(colscale + c); s1 = s1 * *(const f32x4*)(colscale + c + 4); }
#pragma unroll
            for (int ai = 0; ai < 2; ++ai)
#pragma unroll
                for (int m = 0; m < 4; ++m) *(u32x4*)(out + (size_t)GE_ROW(ai, m) * ld + c) = pack8(acc[ai][bj][m][0] * s0, acc[ai][bj][m][1] * s1); }
    }
};
struct SchedOne {
    bool has; Unit u;
    __device__ __forceinline__ bool next(int i, Unit& o) const { if (i > 0 || !has) return false; o = u; return true; }
};
struct SchedProj {
    Order o; const char* XN; const char* WINT; const char* MEMN; const char* WKVT;
    __device__ __forceinline__ bool next(int i, Unit& u) const {
        int pm, pn; if (o.next(i, pm, pn)) { u.pm = pm; u.pn = pn; u.A = XN + (size_t)pm * (256 * D * 2); u.B = WINT + (size_t)pn * (256 * D * 2); return true; }
        const long L = (long)i * o.G + o.c - o.nwg; if (L < 0 || L >= 16) return false;
        u.pm = (int)(L >> 3); u.pn = 100 + (int)(L & 7); u.A = MEMN + (size_t)u.pm * (256 * D * 2); u.B = WKVT + (size_t)(L & 7) * (256 * D * 2); return true;
    }
};
}

#define XB_TMO      128
#define XB_XCNT(j)  (256  + 64 * (j))
#define XB_XSUB(j)  (1280 + 64 * (j))
#define XB_XGEN(j)  (2304 + 64 * (j))
#define XB_TOP      3328
#define XB_TOPGEN   3392
#define XCD_BAR_WORDS 3456
#define XB_SPIN_CAP (1u << 18)
__device__ __forceinline__ unsigned xb_ld(unsigned* p)              { return __hip_atomic_load(p, __ATOMIC_RELAXED, __HIP_MEMORY_SCOPE_AGENT); }
__device__ __forceinline__ unsigned xb_add(unsigned* p, unsigned v) { return __hip_atomic_fetch_add(p, v, __ATOMIC_RELAXED, __HIP_MEMORY_SCOPE_AGENT); }
__device__ __forceinline__ unsigned xb_xcc_id() { return (unsigned)__builtin_amdgcn_s_getreg((3 << 11) | 20) & 0xFu; }
#define XB_SPIN(cond, bar) do { unsigned _sp = 0; while (cond) { __builtin_amdgcn_s_sleep(1); \
    if ((++_sp & 255u) == 0u) { if (xb_ld(&(bar)[XB_TMO])) break; if (_sp > XB_SPIN_CAP) { atomicAdd(&(bar)[XB_TMO], 1u); break; } } } } while (0)
struct XcdBarrier { unsigned* bar; unsigned x; volatile LAS unsigned* st; };
__device__ __forceinline__ XcdBarrier xcd_barrier_post(unsigned* bar, volatile LAS unsigned* st) {
    XcdBarrier b; b.bar = bar; b.x = xb_xcc_id(); b.st = st;
    if (threadIdx.x == 0) (void)xb_add(&bar[XB_XCNT(b.x)], 1u);
    return b;
}
__device__ __forceinline__ void xcd_barrier_complete(unsigned* bar, unsigned x, unsigned& nloc, unsigned& nx) {
    const unsigned G = gridDim.x * gridDim.y * gridDim.z;
    unsigned sum, cnt, mine, sp = 0u;
    for (;;) {
        sum = 0u; cnt = 0u; mine = 0u;
#pragma unroll
        for (unsigned j = 0; j < 16; ++j) { const unsigned c = xb_ld(&bar[XB_XCNT(j)]); sum += c; cnt += (c > 0u) ? 1u : 0u; mine = (j == x) ? c : mine; }
        if (sum == G) break;
        __builtin_amdgcn_s_sleep(1);
        if ((++sp & 255u) == 0u) { if (xb_ld(&bar[XB_TMO])) break; if (sp > XB_SPIN_CAP) { atomicAdd(&bar[XB_TMO], 1u); break; } }
    }
    nloc = mine > 0u ? mine : 1u; nx = cnt > 0u ? cnt : 1u;
}
__device__ __forceinline__ void xcd_barrier(const XcdBarrier& b) {
    asm volatile("s_waitcnt vmcnt(0)" ::: "memory");
    __syncthreads();
    if (threadIdx.x == 0) {
        unsigned* bar = b.bar;
        __builtin_amdgcn_s_waitcnt(0);
        unsigned nloc = b.st[0], nx = b.st[1];
        if (nloc == 0u) { xcd_barrier_complete(bar, b.x, nloc, nx); b.st[0] = nloc; b.st[1] = nx; }
        const unsigned old = xb_add(&bar[XB_XSUB(b.x)], 1u);
        const unsigned gen = old / nloc;
        if (old + 1u == (gen + 1u) * nloc) {
            __builtin_amdgcn_fence(__ATOMIC_RELEASE, "agent");
            asm volatile("s_waitcnt vmcnt(0)" ::: "memory");
            const unsigned og = xb_add(&bar[XB_TOP], 1u);
            const unsigned tg = og / nx;
            if (og + 1u == (tg + 1u) * nx) xb_add(&bar[XB_TOPGEN], 1u);
            else XB_SPIN(xb_ld(&bar[XB_TOPGEN]) == tg, bar);
            __builtin_amdgcn_fence(__ATOMIC_ACQUIRE, "agent");
            xb_add(&bar[XB_XGEN(b.x)], 1u);
            asm volatile("s_waitcnt vmcnt(0)" ::: "memory");
        } else {
            XB_SPIN(xb_ld(&bar[XB_XGEN(b.x)]) == gen, bar);
            __builtin_amdgcn_fence(__ATOMIC_ACQUIRE, "agent");
            asm volatile("s_waitcnt vmcnt(0)" ::: "memory");
        }
    }
    __syncthreads();
}

#define p_XN ((bf16_t*)(a.ws + WS_XN))
#define p_RKV ((bf16_t*)(a.ws + WS_RKV))
#define p_LORA ((bf16_t*)(a.ws + WS_LORA))
#define p_AQKV ((bf16_t*)(a.ws + WS_AQKV))
#define p_GATES ((bf16_t*)a.out)
#define p_ACAT ((bf16_t*)(a.ws + WS_ACAT))
#define p_WST ((bf16_t*)(a.ws + WS_WST))
#define p_VWT ((bf16_t*)(a.ws + WS_VWT))
#define p_KV ((bf16_t*)(a.ws + WS_KV))
#define p_MEMN ((bf16_t*)(a.ws + WS_MEMN))
#define p_SS1 ((float*)(a.ws + WS_SS1))
#define p_SS2 ((float*)(a.ws + WS_SS2))
#define p_SS3 ((float*)(a.ws + WS_SS3))
#define p_H2B ((bf16_t*)(a.ws + WS_H2B))
#define p_MERGED ((bf16_t*)(a.ws + WS_MERGED))
#define p_H1B ((bf16_t*)(a.ws + WS_H1B))
#define p_PROB ((bf16_t*)(a.ws + WS_PROB))
#define p_ACT ((bf16_t*)(a.ws + WS_ACT))
#define p_WINT ((bf16_t*)(a.ws + WS_WINT))
#define p_PCATT ((bf16_t*)(a.ws + WS_PCATT))
#define p_WOUTT ((bf16_t*)(a.ws + WS_WOUTT))
#define p_W1T ((bf16_t*)(a.ws + WS_W1T))
#define p_W2T ((bf16_t*)(a.ws + WS_W2T))
#define p_WKVT ((bf16_t*)(a.ws + WS_WKVT))
#define p_WQB ((bf16_t*)(a.ws + WS_WQB))
#define p_WOT ((bf16_t*)(a.ws + WS_WOT))
#define p_OUT (a.out)
constexpr int MISC_OFF = 131072 + 320;
__global__ void __launch_bounds__(NTHREADS, 2) mk_fwd(Args a) {
    extern __shared__ __attribute__((aligned(16))) unsigned char lds_raw[];
    float* lds = (float*)lds_raw;
    LAS unsigned char* ldsl = (LAS unsigned char*)lds_raw;
    const int tid = threadIdx.x, lane = tid & 63, wave = tid >> 6;
    const int G = gridDim.x, bid = blockIdx.x;
    const int gw = bid * NWAVES + wave, NGW = G * NWAVES;
    unsigned char* ws = a.ws;
    LAS float* scr = (LAS float*)(ldsl + wave * 16384);

    for (int u = tid; u < (LDS_BYTES - 131072) / 4; u += NTHREADS) ((LAS unsigned*)(ldsl + 131072))[u] = 0u;
    __syncthreads();
    XcdBarrier bar = xcd_barrier_post((unsigned*)(ws + WS_CTL) + 4096, (volatile LAS unsigned*)(ldsl + MISC_OFF) + 8);
    cg::grid_group grid = cg::this_grid();

    {
        {
            const float* W = a.in[I_WIN];
            for (int it = gw; it < 16 * 241; it += NGW) { const int kb = it / 241, nb = it % 241, c = nb * 32;
                const int drow = (c < C_LORA) ? c : (c < C_AQ) ? 7424 + (c - C_LORA) : (c < C_GATE) ? 5120 + (c - C_AQ) : 3072 + (c - C_GATE);
                transpose_item(W, NIN, kb * 64, c, p_WINT, D, drow, 0, nullptr, scr, lane); }
            for (int i = gw * 64 + lane; i < 224 * D / 8; i += NGW * 64) *(u32x4*)(p_WINT + (size_t)7712 * D + (size_t)i * 8) = (u32x4){0u, 0u, 0u, 0u};
        }
        transpose_matrix(a.in[I_WKV], 1024, 2048, p_WKVT, D, 0, nullptr, scr, lane, gw, NGW);
        transpose_matrix(a.in[I_PRWKV], 1024, 1024, p_PCATT, KCAT, 0, nullptr, scr, lane, gw, NGW);
        transpose_matrix(a.in[I_PATTN], 256, 1024, p_PCATT, KCAT, 1024, nullptr, scr, lane, gw, NGW);
        transpose_matrix(a.in[I_WOUT], 1024, 1024, p_WOUTT, D, 0, nullptr, scr, lane, gw, NGW);
        transpose_matrix(a.in[I_WO], 1024, 1024, p_WOT, D, 0, nullptr, scr, lane, gw, NGW);
        { const float* WQ = a.in[I_WQ]; for (int i = gw * 64 + lane; i < D * D / 8; i += NGW * 64) { const f32x4 v0 = *(const f32x4*)(WQ + (size_t)i * 8), v1 = *(const f32x4*)(WQ + (size_t)i * 8 + 4); *(u32x4*)(p_WQB + (size_t)i * 8) = ge::pack8(v0, v1); } }
        for (int r = gw; r < M + 512; r += NGW) {
            const bool ism = r >= M; const int rr = ism ? r - M : r;
            const float* src = (ism ? a.in[I_MEM] : a.in[I_X]) + (size_t)rr * D; const float* g = ism ? a.in[I_NMEM] : a.in[I_NMIX];
            bf16_t* dst = (ism ? p_MEMN : p_XN) + (size_t)rr * D;
            f32x4 v[4]; float ss = 0.f;
#pragma unroll
            for (int i = 0; i < 4; ++i) { v[i] = *(const f32x4*)(src + (lane + 64 * i) * 4); ss += (v[i][0] * v[i][0] + v[i][1] * v[i][1]) + (v[i][2] * v[i][2] + v[i][3] * v[i][3]); }
            const float rstd = rsqrtf(wave_sum(ss) * (1.f / D) + 1e-6f);
#pragma unroll
            for (int i = 0; i < 4; ++i) { const f32x4 gg = *(const f32x4*)(g + (lane + 64 * i) * 4), o = v[i] * rstd * gg;
                unsigned long long w = (unsigned long long)ge::cvt_pk_bf16(o[0], o[1]) | ((unsigned long long)ge::cvt_pk_bf16(o[2], o[3]) << 32);
                *(unsigned long long*)(dst + (lane + 64 * i) * 4) = w; }
        }
    }
    grid.sync();
    {
        ge::SchedProj S; S.o.init(64, 31, G, bid); S.XN = (const char*)p_XN; S.WINT = (const char*)p_WINT; S.MEMN = (const char*)p_MEMN; S.WKVT = (const char*)p_WKVT;
        ge::EpiProj E; E.hook_t = -1; E.RKV = p_RKV; E.GATES = p_GATES; E.AQKV = p_AQKV; E.LORA = p_LORA; E.KV = p_KV;
        ge::gemm_phase<ge::EpiProj, ge::SchedProj, true>(ldsl, D, D, 16, S, E);
    }
    xcd_barrier(bar);
    if (bid < 32) scan_naive(a, lds, bid);
    else {
        if (bid < 96) {
            const bool isw = bid < 64; const int u = (bid - 32) & 31, pm = u >> 2, pn = u & 3;
            ge::SchedOne S; S.has = true; S.u.pm = pm; S.u.pn = pn;
            S.u.A = isw ? (const char*)(p_KV + (size_t)((pm >> 2) * 256) * 2048 + (pm & 3) * 256) : (const char*)(p_WOT + (size_t)((pm & 3) * 256) * 1024 + pn * 256);
            S.u.B = isw ? (const char*)(p_WQB + (size_t)(pn * 256) * 1024 + (pm & 3) * 256) : (const char*)(p_KV + (size_t)((pm >> 2) * 256) * 2048 + 1024 + pn * 256);
            ge::EpiScaleCol E; E.hook_t = -1; E.colscale = a.in[I_NX]; E.mul = isw ? 0.0625f : 1.f; E.use_cs = isw; E.out = isw ? p_WST : p_VWT; E.ld = 1024;
            ge::gemm_phase<ge::EpiScaleCol, ge::SchedOne, false>(ldsl, isw ? 2048 : 1024, isw ? 1024 : 2048, 4, S, E);
            __syncthreads();
        }
        dil_attn_naive(a, lds, (bid - 32) * NWAVES + wave, (G - 32) * NWAVES);
    }
    xcd_barrier(bar);
    {
        ge::Sched S; S.o.init(64, 4, G, bid); S.A = (const char*)p_ACAT; S.B = (const char*)p_PCATT; S.a_tile = (size_t)256 * KCAT * 2; S.b_tile = (size_t)256 * KCAT * 2; S.b_batch = 0;
        ge::EpiMerged E; E.hook_t = 16; E.GATES = p_GATES; E.MERGED = p_MERGED;
        ge::gemm_phase<ge::EpiMerged, ge::Sched, false>(ldsl, KCAT, KCAT, 20, S, E);
        __syncthreads();
        transpose_matrix(a.in[I_W1], 1024, 4096, p_W1T, D, 0, a.in[I_NFFN], scr, lane, gw, NGW);
        transpose_matrix(a.in[I_FW2], 4096, 1024, p_W2T, FF, 0, nullptr, scr, lane, gw, NGW);
    }
    xcd_barrier(bar);
    {
        ge::Sched S; S.o.init(64, 4, G, bid); S.A = (const char*)p_MERGED; S.B = (const char*)p_WOUTT; S.a_tile = (size_t)256 * D * 2; S.b_tile = (size_t)256 * D * 2; S.b_batch = 0;
        ge::EpiResid E; E.hook_t = -1; E.base = a.in[I_X]; E.out = p_OUT; E.hb = p_H1B; E.SS = p_SS1;
        ge::gemm_phase<ge::EpiResid, ge::Sched, false>(ldsl, D, D, 16, S, E);
    }
    xcd_barrier(bar);
    {
        ge::Sched S; S.o.init(64, 4, G, bid); S.A = (const char*)p_H1B; S.B = (const char*)p_WST; S.a_tile = (size_t)256 * D * 2; S.b_tile = (size_t)256 * D * 2; S.b_batch = (size_t)1024 * 1024 * 2;
        ge::EpiSoftmax E; E.hook_t = -1; E.SS = p_SS1; E.PROB = p_PROB;
        ge::gemm_phase<ge::EpiSoftmax, ge::Sched, false>(ldsl, D, D, 16, S, E);
    }
    xcd_barrier(bar);
    {
        ge::Sched S; S.o.init(64, 4, G, bid); S.A = (const char*)p_PROB; S.B = (const char*)p_VWT; S.a_tile = (size_t)256 * D * 2; S.b_tile = (size_t)256 * D * 2; S.b_batch = (size_t)1024 * 1024 * 2;
        ge::EpiResid E; E.hook_t = -1; E.base = p_OUT; E.out = p_OUT; E.hb = p_H2B; E.SS = p_SS2;
        ge::gemm_phase<ge::EpiResid, ge::Sched, false>(ldsl, D, D, 16, S, E);
    }
    xcd_barrier(bar);
    {
        ge::Sched S; S.o.init(64, 16, G, bid); S.A = (const char*)p_H2B; S.B = (const char*)p_W1T; S.a_tile = (size_t)256 * D * 2; S.b_tile = (size_t)256 * D * 2; S.b_batch = 0;
        ge::EpiRelu2 E; E.hook_t = -1; E.SS = p_SS2; E.ACT = p_ACT;
        ge::gemm_phase<ge::EpiRelu2, ge::Sched, true>(ldsl, D, D, 16, S, E);
    }
    xcd_barrier(bar);
    {
        ge::Sched S; S.o.init(64, 4, G, bid); S.A = (const char*)p_ACT; S.B = (const char*)p_W2T; S.a_tile = (size_t)256 * FF * 2; S.b_tile = (size_t)256 * FF * 2; S.b_batch = 0;
        ge::EpiResid E; E.hook_t = -1; E.base = p_OUT; E.out = p_OUT; E.hb = nullptr; E.SS = p_SS3;
        ge::gemm_phase<ge::EpiResid, ge::Sched, false>(ldsl, FF, FF, 64, S, E);
    }
    xcd_barrier(bar);
    {
        const float* g = a.in[I_NFIN];
        for (int r = gw; r < M; r += NGW) {
            const float rstd = ge::rstd_from_ss(p_SS3, (size_t)r);
#pragma unroll
            for (int i = 0; i < 4; ++i) { const size_t o = (size_t)r * D + (lane + 64 * i) * 4; const f32x4 v = *(const f32x4*)(p_OUT + o), gg = *(const f32x4*)(g + (lane + 64 * i) * 4); *(f32x4*)(p_OUT + o) = v * rstd * gg; }
        }
    }
}

extern "C" void kernel_launch(void* const* d_in, const int* in_sizes, int n_in, void* d_out, int out_size, void* d_ws, size_t ws_size, hipStream_t stream) {
    static int grid = 0;
    if (grid == 0) {
        if (n_in != 27 || out_size != M * D || ws_size < 256 * MiB) { fprintf(stderr, "kernel_launch: unexpected shapes (n_in %d out %d ws %zu)\n", n_in, out_size, ws_size); grid = -1; return; }
        int dev = 0, cus = 0, per_cu = 0;
        if (hipGetDevice(&dev) != hipSuccess || hipDeviceGetAttribute(&cus, hipDeviceAttributeMultiprocessorCount, dev) != hipSuccess) { fprintf(stderr, "kernel_launch: device query failed\n"); grid = -1; return; }
        if (hipFuncSetAttribute((const void*)mk_fwd, hipFuncAttributeMaxDynamicSharedMemorySize, LDS_BYTES) != hipSuccess) { fprintf(stderr, "kernel_launch: hipFuncSetAttribute failed\n"); grid = -1; return; }
        if (hipOccupancyMaxActiveBlocksPerMultiprocessor(&per_cu, (const void*)mk_fwd, NTHREADS, LDS_BYTES) != hipSuccess || per_cu < 1) { fprintf(stderr, "kernel_launch: occupancy query says %d blocks per CU\n", per_cu); per_cu = 1; }
        (void)hipGetLastError();
        grid = cus;
        if (grid != 256) fprintf(stderr, "kernel_launch: %d CUs; this kernel is built for 256\n", grid);
    }
    if (grid < 0) return;
    (void)hipMemsetAsync((char*)d_ws + WS_CTL, 0, 64 * 1024, stream);
    Args a{};
    for (int i = 0; i < 27; ++i) a.in[i] = (const float*)d_in[i];
    a.out = (float*)d_out; a.ws = (unsigned char*)d_ws;
    void* kargs[] = {&a};
    hipError_t e = hipLaunchCooperativeKernel((const void*)mk_fwd, dim3(grid), dim3(NTHREADS), kargs, LDS_BYTES, stream);
    if (e != hipSuccess) fprintf(stderr, "kernel_launch: cooperative launch failed: %s (grid %d)\n", hipGetErrorString(e), grid);
}
```

```cpp
#include <hip/hip_runtime.h>
#include <hip/hip_cooperative_groups.h>
namespace cg = cooperative_groups;
#include <cstdint>
#include <cstdio>

typedef unsigned short bf16_t;
typedef float f32x4 __attribute__((ext_vector_type(4)));

constexpr int BATCH = 2, SEQ = 8192, M = BATCH * SEQ, D = 1024;
constexpr int NIN = 7712;
constexpr int C_LORA = 3072, C_AQ = 3360, C_GATE = 5664;
constexpr int NLORA = 288, NAQKV = 2304, NGATE = 2048, NRKV = 3072;
constexpr int MEMLEN = 256, FF = 4096, KCAT = 1280;
constexpr int CH = 32;

constexpr size_t KiB = 1024, MiB = 1024 * 1024;
constexpr size_t WS_CTL = 0;
constexpr size_t WS_LW2T = 1 * MiB;
constexpr size_t WS_LA2T = 1 * MiB + 128 * KiB;
constexpr size_t WS_LG2T = 1 * MiB + 256 * KiB;
constexpr size_t WS_WINT = 2 * MiB;
constexpr size_t WS_XN = 17 * MiB + 512 * KiB;
constexpr size_t WS_MEMN = 49 * MiB + 512 * KiB;
constexpr size_t WS_WKVT = 50 * MiB + 512 * KiB;
constexpr size_t WS_ACAT = WS_XN;
constexpr size_t WS_RKV = 57 * MiB + 512 * KiB;
constexpr size_t WS_LORA = 153 * MiB + 512 * KiB;
constexpr size_t WS_AQKV = 162 * MiB + 512 * KiB;
constexpr size_t WS_PCATT = 234 * MiB + 512 * KiB;
constexpr size_t WS_WOUTT = 237 * MiB;
constexpr size_t WS_WST = 239 * MiB;
constexpr size_t WS_VWT = 243 * MiB;
constexpr size_t WS_WQB = 247 * MiB;
constexpr size_t WS_WOT = 249 * MiB;
constexpr size_t WS_KV = 251 * MiB;
constexpr size_t WS_SS1 = 253 * MiB;
constexpr size_t WS_SS2 = 254 * MiB;
constexpr size_t WS_SS3 = 255 * MiB;
constexpr size_t WS_W1T = 57 * MiB + 512 * KiB;
constexpr size_t WS_W2T = 65 * MiB + 512 * KiB;
constexpr size_t WS_H2B = 73 * MiB + 512 * KiB;
constexpr size_t WS_MERGED = 105 * MiB + 512 * KiB;
constexpr size_t WS_H1B = 137 * MiB + 512 * KiB;
constexpr size_t WS_PROB = 169 * MiB + 512 * KiB;
constexpr size_t WS_ACT = 105 * MiB + 512 * KiB;

constexpr int NTHREADS = 512, NWAVES = 8;
constexpr int LDS_BYTES = 155648, LDSCTL_OFF = 151552;

__device__ __forceinline__ float bf2f(bf16_t v) { return __uint_as_float(((unsigned)v) << 16); }
__device__ __forceinline__ bf16_t f2bf(float f) { unsigned u = __float_as_uint(f); return (bf16_t)((u + 0x7fffu + ((u >> 16) & 1u)) >> 16); }
__device__ __forceinline__ float sigmoidf_(float x) { return 1.f / (1.f + __expf(-x)); }
__device__ __forceinline__ float wave_sum(float v) {
#pragma unroll
    for (int o = 1; o < 64; o <<= 1) v += __shfl_xor(v, o);
    return v;
}
__device__ __forceinline__ float wave_max(float v) {
#pragma unroll
    for (int o = 1; o < 64; o <<= 1) v = fmaxf(v, __shfl_xor(v, o));
    return v;
}

struct Args {
    const float* in[27];
    float* out;
    unsigned char* ws;
    int ph_lo, ph_hi;
};

enum { I_X = 0, I_MEM, I_NMIX, I_WIN, I_MU, I_W0, I_W2, I_A0, I_A2, I_G2, I_KK, I_KA, I_RK, I_GNW, I_GNB, I_PRWKV, I_PATTN, I_WOUT,
       I_NX, I_NMEM, I_WQ, I_WKV, I_WO, I_NFFN, I_W1, I_FW2, I_NFIN };

__device__ __forceinline__ void scan_naive(const Args& a, float* lds, int bh) {
    const int b = bh >> 4, h = bh & 15;
    const int tid = threadIdx.x, lane = tid & 63, wave = tid >> 6;
    const bf16_t* RKV = (const bf16_t*)(a.ws + WS_RKV);
    const bf16_t* LORA = (const bf16_t*)(a.ws + WS_LORA);
    bf16_t* ACAT = (bf16_t*)(a.ws + WS_ACAT);
    const float* mu = a.in[I_MU];
    float* actW = lds;
    float* actA = actW + CH * 64;
    float* actG = actA + CH * 64;
    float* Wd = actG + CH * 160;
    float* Kk = Wd + CH * 64;
    float* Aa = Kk + CH * 64;
    float* Bb = Aa + CH * 64;
    float* Rr = Bb + CH * 64;
    float* Vv = Rr + CH * 64;
    float* Gg = Vv + CH * 64;
    float* Yy = Gg + CH * 64;
    float* bon = Yy + CH * 64;
    const int hj0 = h * 64;
    float st[8];
#pragma unroll
    for (int e = 0; e < 8; ++e) st[e] = 0.f;
    const int row_i = wave * 8 + (lane >> 3), cg = lane & 7;
    for (int c0 = 0; c0 < SEQ; c0 += CH) {
        const size_t m0 = (size_t)b * SEQ + c0;
        __syncthreads();
        for (int idx = tid; idx < CH * NLORA; idx += NTHREADS) {
            const int t = idx / NLORA, c = idx % NLORA;
            const float cur = bf2f(LORA[(m0 + t) * NLORA + c]);
            const float prev = (c0 + t == 0) ? 0.f : bf2f(LORA[(m0 + t - 1) * NLORA + c]);
            const float s = cur + mu[C_LORA + c] * (prev - cur);
            if (c < 64) actW[t * 64 + c] = tanhf(s);
            else if (c < 128) actA[t * 64 + c - 64] = s;
            else actG[t * 160 + c - 128] = sigmoidf_(s);
        }
        for (int idx = tid; idx < CH * 64; idx += NTHREADS) {
            const int t = idx >> 6, j = idx & 63;
            const bool first = (c0 + t == 0);
#pragma unroll
            for (int q = 0; q < 3; ++q) {
                const int col = q * 1024 + hj0 + j;
                const float cur = bf2f(RKV[(m0 + t) * NRKV + col]);
                const float prev = first ? 0.f : bf2f(RKV[(m0 + t - 1) * NRKV + col]);
                const float s = cur + mu[col] * (prev - cur);
                if (q == 0) Rr[idx] = s; else if (q == 1) Kk[idx] = s; else Vv[idx] = s;
            }
        }
        __syncthreads();
        for (int idx = tid; idx < CH * 64; idx += NTHREADS) {
            const int t = idx >> 6, j = idx & 63, hj = hj0 + j;
            float wp = a.in[I_W0][hj], ap = a.in[I_A0][hj], g = 0.f;
            for (int c = 0; c < 64; ++c) { wp += actW[t * 64 + c] * a.in[I_W2][c * 1024 + hj]; ap += actA[t * 64 + c] * a.in[I_A2][c * 1024 + hj]; }
            for (int c = 0; c < 160; ++c) g += actG[t * 160 + c] * a.in[I_G2][c * 1024 + hj];
            const float z = -wp;
            const float sp = fmaxf(z, 0.f) + log1pf(__expf(-fabsf(z)));
            const float wlog = -sp - 0.5f;
            Wd[idx] = __expf(-__expf(wlog));
            Aa[idx] = sigmoidf_(ap);
            Gg[idx] = g;
        }
        __syncthreads();
#pragma unroll
        for (int q = 0; q < 4; ++q) {
            const int t = wave * 4 + q, idx = t * 64 + lane, hj = hj0 + lane;
            const float pk = Kk[idx], alr = Aa[idx];
            const float kr = pk * a.in[I_KK][hj];
            const float ss = wave_sum(kr * kr);
            const float kk = kr / fmaxf(sqrtf(ss), 1e-12f);
            const float kmod = pk * (1.f + (alr - 1.f) * a.in[I_KA][hj]);
            const float bs = wave_sum(Rr[idx] * kmod * a.in[I_RK][hj]);
            Aa[idx] = -kk; Bb[idx] = kk * alr; Kk[idx] = kmod;
            if (lane == 0) bon[t] = bs;
        }
        __syncthreads();
        for (int t = 0; t < CH; ++t) {
            const float* ap = Aa + t * 64 + cg * 8; const float* wp = Wd + t * 64 + cg * 8; const float* kp = Kk + t * 64 + cg * 8;
            const float* bp = Bb + t * 64 + cg * 8; const float* rp = Rr + t * 64 + cg * 8;
            float sa = 0.f;
#pragma unroll
            for (int e = 0; e < 8; ++e) sa += st[e] * ap[e];
            sa += __shfl_xor(sa, 1); sa += __shfl_xor(sa, 2); sa += __shfl_xor(sa, 4);
            const float vi = Vv[t * 64 + row_i];
            float y = 0.f;
#pragma unroll
            for (int e = 0; e < 8; ++e) { st[e] = st[e] * wp[e] + sa * bp[e] + vi * kp[e]; y += st[e] * rp[e]; }
            y += __shfl_xor(y, 1); y += __shfl_xor(y, 2); y += __shfl_xor(y, 4);
            if (cg == 0) Yy[t * 64 + row_i] = y;
        }
        __syncthreads();
#pragma unroll
        for (int q = 0; q < 4; ++q) {
            const int t = wave * 4 + q, idx = t * 64 + lane, hi = hj0 + lane;
            const float y = Yy[idx];
            const float mean = wave_sum(y) * (1.f / 64.f);
            const float dy = y - mean;
            const float var = wave_sum(dy * dy) * (1.f / 64.f);
            const float yn = dy * rsqrtf(var + 64.f * 1e-5f) * a.in[I_GNW][hi] + a.in[I_GNB][hi];
            const float o = (yn + bon[t] * Vv[idx]) * Gg[idx];
            ACAT[(m0 + t) * KCAT + hi] = f2bf(o);
        }
    }
}

__device__ __forceinline__ void dil_attn_naive(const Args& a, float* lds, int wave_gid, int nwaves_total) {
    const int lane = threadIdx.x & 63, wave = threadIdx.x >> 6;
    const bf16_t* AQ = (const bf16_t*)(a.ws + WS_AQKV);
    bf16_t* ACAT = (bf16_t*)(a.ws + WS_ACAT);
    float* pbuf = lds + wave * 640;
    float* qs = pbuf + 448;
    for (int task = wave_gid; task < M * 4; task += nwaves_total) {
        const int m = task >> 2, s = task & 3, p = m & (SEQ - 1);
#pragma unroll
        for (int g = 0; g < 3; ++g) qs[g * 64 + lane] = bf2f(AQ[(size_t)m * NAQKV + (g * 4 + s) * 64 + lane]);
        float sc[7];
        float mx = -INFINITY;
#pragma unroll
        for (int i = 0; i < 7; ++i) {
            const int idx = lane + i * 64;
            float v = -INFINITY;
            if (idx < 387) {
                const int g = idx / 129, stp = idx % 129, dil = (g == 0) ? 1 : (g == 1 ? 4 : 16), hd = g * 4 + s;
                if (stp * dil <= p) {
                    const bf16_t* kr = AQ + (size_t)(m - stp * dil) * NAQKV + 768 + hd * 64;
                    float dot = 0.f;
                    for (int c = 0; c < 64; ++c) dot += qs[g * 64 + c] * bf2f(kr[c]);
                    const float slope = exp2f(-8.f * (float)(hd + 1) / 12.f);
                    v = dot * 0.125f - slope * (float)(stp * dil);
                }
            }
            sc[i] = v; mx = fmaxf(mx, v);
        }
        mx = wave_max(mx);
        float sum = 0.f;
#pragma unroll
        for (int i = 0; i < 7; ++i) { const int idx = lane + i * 64; const float e = (sc[i] == -INFINITY) ? 0.f : __expf(sc[i] - mx); sum += e; if (idx < 448) pbuf[idx] = e; }
        sum = wave_sum(sum);
        float acc = 0.f;
        for (int idx = 0; idx < 387; ++idx) {
            const int g = idx / 129, stp = idx % 129, dil = (g == 0) ? 1 : (g == 1 ? 4 : 16), hd = g * 4 + s;
            if (stp * dil <= p) acc += pbuf[idx] * bf2f(AQ[(size_t)(m - stp * dil) * NAQKV + 1536 + hd * 64 + lane]);
        }
        ACAT[(size_t)m * KCAT + 1024 + s * 64 + lane] = f2bf(acc / sum);
    }
}

#define LAS __attribute__((address_space(3)))
typedef short bf16x8 __attribute__((ext_vector_type(8)));
typedef unsigned u32x4 __attribute__((ext_vector_type(4)));
namespace ge {
constexpr int BM = 256, BK = 64, HALF = 128, HTB = HALF * BK * 2, STAGE_BYTES = 8 * HTB, NXCD = 8, WGM = 8;
__host__ __device__ __forceinline__ int lds_byte(int r, int c) { const int st = (r >> 4) * 2 + (c >> 5), rr = r & 15, cc = c & 31, ob = rr * 64 + cc * 2; return st * 1024 + (ob ^ (((ob >> 9) & 1) << 5)); }
__host__ __device__ __forceinline__ void stage_rc(int b, int& R, int& C) { const int st = b / 1024, sb = b % 1024, swz = sb ^ (((sb >> 9) & 1) << 5); R = (st >> 1) * 16 + swz / 64; C = (st & 1) * 32 + (swz % 64) / 2; }
__host__ __device__ __forceinline__ int perm32(int rho) { const int n = rho >> 4, i = rho & 15; return 8 * (i >> 2) + 4 * n + (i & 3); }

struct Unit { const char* A; const char* B; int pm, pn; };

struct Order {
    int nM, nN, nwg, G, c;
    __device__ __forceinline__ void init(int nM_, int nN_, int G_, int c_) { nM = nM_; nN = nN_; nwg = nM * nN; G = G_; c = c_; }
    __device__ __forceinline__ bool next(int i, int& pm, int& pn) const {
        const long L = (long)i * G + c; if (L >= nwg) return false;
        int wgid = (int)L; { const int q = nwg / NXCD, r = nwg % NXCD, xcd = wgid % NXCD, off = wgid / NXCD; wgid = (xcd < r ? xcd * (q + 1) : r * (q + 1) + (xcd - r) * q) + off; }
        const int nig = WGM * nN, gid = wgid / nig, fm = gid * WGM, gsz = (nM - fm) < WGM ? (nM - fm) : WGM;
        pm = fm + ((wgid % nig) % gsz); pn = (wgid % nig) / gsz; return true;
    }
};
struct Sched {
    Order o; const char* A; const char* B; size_t a_tile, b_tile, b_batch;
    __device__ __forceinline__ bool next(int i, Unit& u) const {
        int pm, pn; if (!o.next(i, pm, pn)) return false;
        u.pm = pm; u.pn = pn; u.A = A + (size_t)pm * a_tile; u.B = B + (size_t)pn * b_tile + (size_t)(pm >> 5) * b_batch; return true;
    }
};

typedef float f32x2_t __attribute__((ext_vector_type(2))); typedef __bf16 bf16x2_t __attribute__((ext_vector_type(2)));
__device__ __forceinline__ unsigned cvt_pk_bf16(float lo, float hi) { f32x2_t v = {lo, hi}; bf16x2_t b = __builtin_convertvector(v, bf16x2_t); return __builtin_bit_cast(unsigned, b); }
__device__ __forceinline__ u32x4 pack8(const f32x4 v0, const f32x4 v1) { u32x4 w; w.x = cvt_pk_bf16(v0[0], v0[1]); w.y = cvt_pk_bf16(v0[2], v0[3]); w.z = cvt_pk_bf16(v1[0], v1[1]); w.w = cvt_pk_bf16(v1[2], v1[3]); return w; }
__device__ __forceinline__ void unpack8(const u32x4 w, f32x4& v0, f32x4& v1) {
    v0[0] = __uint_as_float(w.x << 16); v0[1] = __uint_as_float(w.x & 0xffff0000u); v0[2] = __uint_as_float(w.y << 16); v0[3] = __uint_as_float(w.y & 0xffff0000u);
    v1[0] = __uint_as_float(w.z << 16); v1[1] = __uint_as_float(w.z & 0xffff0000u); v1[2] = __uint_as_float(w.w << 16); v1[3] = __uint_as_float(w.w & 0xffff0000u);
}

template <class Epi, class SchedT, bool ALIGN_EPI>
__device__ __forceinline__ void gemm_phase(LAS unsigned char* lds, const int lda, const int ldb, const int nt, const SchedT& S, const Epi& E) {
    int tid_o = threadIdx.x; asm volatile("" : "+v"(tid_o));
    const int tid = tid_o, wid = __builtin_amdgcn_readfirstlane(tid >> 6), lane = tid & 63, wr = wid >> 2, wc = wid & 3, fr = lane & 15, fq = lane >> 4;
    unsigned voffA[2], voffB[2];
#pragma unroll
    for (int i = 0; i < 2; ++i) { int R, C; stage_rc(tid * 16 + i * 8192, R, C); const int Rb = (R & ~31) + perm32(R & 31);
        voffA[i] = (unsigned)(R * lda + C) * 2u; voffB[i] = (unsigned)(Rb * ldb + C) * 2u; }
    const size_t kstep = (size_t)(BK * 2);
    const size_t hstepA = (size_t)HALF * lda * 2, hstepB = (size_t)HALF * ldb * 2;
    const unsigned ldsw = (unsigned)wid * 1024u;
    const int aoff = lds_byte(wr * 64 + fr, fq * 8), boff = lds_byte(wc * 32 + fr, fq * 8);
#define GE_SA(b, h) (((b) * 2 + (h)) * ge::HTB)
#define GE_SB(b, h) ((4 + (b) * 2 + (h)) * ge::HTB)
#define GE_STAGE(bufoff, gbase, voff) do { _Pragma("unroll") for (int _i = 0; _i < 2; ++_i) \
        __builtin_amdgcn_global_load_lds((const unsigned*)((const char*)(gbase) + (voff)[_i]), (LAS unsigned*)(lds + (bufoff) + ldsw + _i * 8192), 16, 0, 0); } while (0)
#define GE_LDA(dst, b, h) do { _Pragma("unroll") for (int m = 0; m < 4; ++m) _Pragma("unroll") for (int k = 0; k < 2; ++k) dst[m][k] = *(const LAS bf16x8*)(lds + GE_SA(b, h) + aoff + m * 2048 + k * 1024); } while (0)
#define GE_LDB(dst, b, h) do { _Pragma("unroll") for (int n = 0; n < 2; ++n) _Pragma("unroll") for (int k = 0; k < 2; ++k) dst[n][k] = *(const LAS bf16x8*)(lds + GE_SB(b, h) + boff + n * 2048 + k * 1024); } while (0)
#define GE_MMA(ai, bj, At, Bt) do { __builtin_amdgcn_s_setprio(1); _Pragma("unroll") for (int m = 0; m < 4; ++m) _Pragma("unroll") for (int n = 0; n < 2; ++n) _Pragma("unroll") for (int k = 0; k < 2; ++k) \
        acc[ai][bj][m][n] = __builtin_amdgcn_mfma_f32_16x16x32_bf16(Bt[n][k], At[m][k], acc[ai][bj][m][n], 0, 0, 0); __builtin_amdgcn_s_setprio(0); } while (0)
#define GE_WAIT_V(n) asm volatile("s_waitcnt vmcnt(" #n ")" ::: "memory")
#define GE_WAIT_L(n) asm volatile("s_waitcnt lgkmcnt(" #n ")" ::: "memory")
#define GE_BAR __builtin_amdgcn_s_barrier()
#define GE_SCHED __builtin_amdgcn_sched_barrier(0)
    Unit cur, nxt; int ui = 0;
    if (!S.next(0, cur)) return;
    f32x4 acc[2][2][4][2];
#pragma unroll
    for (int a = 0; a < 2; ++a)
#pragma unroll
        for (int b = 0; b < 2; ++b)
#pragma unroll
            for (int m = 0; m < 4; ++m)
#pragma unroll
                for (int n = 0; n < 2; ++n) acc[a][b][m][n] = (f32x4){0.f, 0.f, 0.f, 0.f};
    bf16x8 At[4][2], B0[2][2], B1[2][2];
    const char* cA = cur.A; const char* cB = cur.B;
    GE_STAGE(GE_SB(0, 0), cB, voffB); GE_STAGE(GE_SB(0, 1), cB + hstepB, voffB); GE_STAGE(GE_SA(0, 0), cA, voffA); GE_STAGE(GE_SA(0, 1), cA + hstepA, voffA);
    if (wr == 1) GE_BAR;
    GE_WAIT_V(2); GE_BAR;
    GE_STAGE(GE_SB(1, 0), cB + kstep, voffB); GE_STAGE(GE_SA(1, 0), cA + kstep, voffA); GE_STAGE(GE_SB(1, 1), cB + hstepB + kstep, voffB);
    GE_WAIT_V(6); GE_BAR;
    for (;;) {
        const bool has_next = S.next(ui + 1, nxt);
        const char* nA = has_next ? nxt.A : cA; const char* nB = has_next ? nxt.B : cB;
        for (int t = 0; t < nt; t += 2) {
            if constexpr (Epi::HOOK) { if (t == E.hook_t) E.hook(acc, cur, wr, wc, fr, fq); }
            const bool last = (t == nt - 2);
            const char* a1 = cA + (size_t)(t + 1) * kstep;
            const char* a2 = last ? nA : cA + (size_t)(t + 2) * kstep; const char* b2 = last ? nB : cB + (size_t)(t + 2) * kstep;
            const char* a3 = a2 + kstep; const char* b3 = b2 + kstep;
            GE_LDB(B0, 0, 0); GE_LDB(B1, 0, 1); GE_SCHED; GE_LDA(At, 0, 0); GE_STAGE(GE_SA(1, 1), a1 + hstepA, voffA);
            GE_WAIT_V(8); GE_WAIT_L(0); GE_BAR; GE_MMA(0, 0, At, B0); GE_MMA(0, 1, At, B1); GE_BAR; GE_SCHED;
            GE_LDA(At, 0, 1); GE_STAGE(GE_SB(0, 0), b2, voffB); GE_STAGE(GE_SB(0, 1), b2 + hstepB, voffB); GE_STAGE(GE_SA(0, 0), a2, voffA);
            GE_WAIT_V(8); GE_WAIT_L(0); GE_BAR; GE_MMA(1, 0, At, B0); GE_MMA(1, 1, At, B1); GE_BAR; GE_SCHED;
            GE_LDB(B0, 1, 0); GE_LDB(B1, 1, 1); GE_SCHED; GE_LDA(At, 1, 0); GE_STAGE(GE_SA(0, 1), a2 + hstepA, voffA);
            GE_WAIT_V(8); GE_WAIT_L(0); GE_BAR; GE_MMA(0, 0, At, B0); GE_MMA(0, 1, At, B1); GE_BAR; GE_SCHED;
            GE_LDA(At, 1, 1); GE_STAGE(GE_SB(1, 0), b3, voffB); GE_STAGE(GE_SB(1, 1), b3 + hstepB, voffB); GE_STAGE(GE_SA(1, 0), a3, voffA);
            GE_WAIT_V(8); GE_WAIT_L(0); GE_BAR; GE_MMA(1, 0, At, B0); GE_MMA(1, 1, At, B1); GE_BAR; GE_SCHED;
        }
        if constexpr (ALIGN_EPI) { if (wr == 0) GE_BAR; }
        if constexpr (!Epi::AFTER_DRAIN) { E(acc, cur, wr, wc, fr, fq); }
        if (!has_next) break;
#pragma unroll
        for (int a = 0; a < 2; ++a)
#pragma unroll
            for (int b = 0; b < 2; ++b)
#pragma unroll
                for (int m = 0; m < 4; ++m)
#pragma unroll
                    for (int n = 0; n < 2; ++n) acc[a][b][m][n] = (f32x4){0.f, 0.f, 0.f, 0.f};
        cur = nxt; cA = nA; cB = nB; ++ui;
        if constexpr (ALIGN_EPI) { if (wr == 1) GE_BAR; }
    }
    GE_WAIT_V(0);
    if constexpr (!ALIGN_EPI) { if (wr == 0) GE_BAR; }
    GE_BAR;
    if constexpr (Epi::AFTER_DRAIN) { E.fused(acc, cur, wr, wc, fr, fq, lds, wid, lane); }
#undef GE_SA
#undef GE_SB
#undef GE_STAGE
#undef GE_LDA
#undef GE_LDB
#undef GE_MMA
#undef GE_WAIT_V
#undef GE_WAIT_L
#undef GE_BAR
#undef GE_SCHED
}

#define GE_ROW(ai, m) (u.pm * 256 + (ai) * 128 + wr * 64 + (m) * 16 + fr)
#define GE_COL(bj) (u.pn * 256 + (bj) * 128 + wc * 32 + 8 * fq)
typedef f32x4 Acc[2][2][4][2];

__device__ __forceinline__ float fast_sigmoid(float x) { return __builtin_amdgcn_rcpf(1.f + __expf(-x)); }

struct EpiProj {
    static constexpr bool AFTER_DRAIN = false, HOOK = false; int hook_t;
    bf16_t *RKV, *GATES, *AQKV, *LORA, *KV;
    __device__ __forceinline__ void hook(Acc&, const Unit&, int, int, int, int) const {}
    __device__ __forceinline__ void operator()(const Acc& acc, const Unit& u, int wr, int wc, int fr, int fq) const {
        const int pn = u.pn; bf16_t* base; int ld, cbase, climit = 1 << 30; bool sig = false;
        if (pn >= 100) { base = KV; ld = 2048; cbase = (pn - 100) * 256; }
        else if (pn < 12) { base = RKV; ld = NRKV; cbase = pn * 256; }
        else if (pn < 20) { base = GATES; ld = NGATE; cbase = (pn - 12) * 256; sig = true; }
        else if (pn < 29) { base = AQKV; ld = NAQKV; cbase = (pn - 20) * 256; }
        else { base = LORA; ld = NLORA; cbase = (pn - 29) * 256; climit = NLORA; }
#pragma unroll
        for (int ai = 0; ai < 2; ++ai)
#pragma unroll
            for (int m = 0; m < 4; ++m) { bf16_t* rowp = base + (size_t)GE_ROW(ai, m) * ld;
#pragma unroll
                for (int bj = 0; bj < 2; ++bj) { const int c = cbase + bj * 128 + wc * 32 + 8 * fq;
                    if (c < climit) { f32x4 v0 = acc[ai][bj][m][0], v1 = acc[ai][bj][m][1];
                        if (sig) {
#pragma unroll
                            for (int j = 0; j < 4; ++j) { v0[j] = fast_sigmoid(v0[j]); v1[j] = fast_sigmoid(v1[j]); } }
                        *(u32x4*)(rowp + c) = pack8(v0, v1); } } }
    }
};
struct EpiMerged {
    static constexpr bool AFTER_DRAIN = false, HOOK = true; int hook_t;
    const bf16_t* GATES; bf16_t* MERGED;
    __device__ __forceinline__ void hook(Acc& acc, const Unit& u, int wr, int wc, int fr, int fq) const {
#pragma unroll
        for (int ai = 0; ai < 2; ++ai)
#pragma unroll
            for (int m = 0; m < 4; ++m) { const bf16_t* g = GATES + (size_t)GE_ROW(ai, m) * NGATE;
#pragma unroll
                for (int bj = 0; bj < 2; ++bj) { const int c = GE_COL(bj); f32x4 r0, r1, a0, a1;
                    unpack8(*(const u32x4*)(g + c), r0, r1); unpack8(*(const u32x4*)(g + 1024 + c), a0, a1);
#pragma unroll
                    for (int j = 0; j < 4; ++j) { acc[ai][bj][m][0][j] *= r0[j] * __builtin_amdgcn_rcpf(a0[j]); acc[ai][bj][m][1][j] *= r1[j] * __builtin_amdgcn_rcpf(a1[j]); } } }
    }
    __device__ __forceinline__ void operator()(const Acc& acc, const Unit& u, int wr, int wc, int fr, int fq) const {
#pragma unroll
        for (int ai = 0; ai < 2; ++ai)
#pragma unroll
            for (int m = 0; m < 4; ++m) { const size_t r = (size_t)GE_ROW(ai, m);
#pragma unroll
                for (int bj = 0; bj < 2; ++bj) { const int c = GE_COL(bj); f32x4 a0, a1;
                    unpack8(*(const u32x4*)(GATES + r * NGATE + 1024 + c), a0, a1);
                    *(u32x4*)(MERGED + r * D + c) = pack8(acc[ai][bj][m][0] * a0, acc[ai][bj][m][1] * a1); } }
    }
};
struct EpiResid {
    static constexpr bool AFTER_DRAIN = false, HOOK = false; int hook_t;
    const float* base; float* out; bf16_t* hb; float* SS;
    __device__ __forceinline__ void hook(Acc&, const Unit&, int, int, int, int) const {}
    __device__ __forceinline__ void operator()(const Acc& acc, const Unit& u, int wr, int wc, int fr, int fq) const {
#pragma unroll
        for (int ai = 0; ai < 2; ++ai)
#pragma unroll
            for (int m = 0; m < 4; ++m) { const size_t r = (size_t)GE_ROW(ai, m); float ss = 0.f;
#pragma unroll
                for (int bj = 0; bj < 2; ++bj) { const int c = GE_COL(bj);
                    const f32x4 o0 = *(const f32x4*)(base + r * D + c) + acc[ai][bj][m][0], o1 = *(const f32x4*)(base + r * D + c + 4) + acc[ai][bj][m][1];
                    *(f32x4*)(out + r * D + c) = o0; *(f32x4*)(out + r * D + c + 4) = o1;
                    ss += (o0[0] * o0[0] + o0[1] * o0[1]) + (o0[2] * o0[2] + o0[3] * o0[3]) + (o1[0] * o1[0] + o1[1] * o1[1]) + (o1[2] * o1[2] + o1[3] * o1[3]);
                    if (hb) *(u32x4*)(hb + r * D + c) = pack8(o0, o1); }
                ss += __shfl_xor(ss, 16); ss += __shfl_xor(ss, 32);
                if (fq == 0) SS[r * 16 + u.pn * 4 + wc] = ss; }
    }
};
__device__ __forceinline__ float rstd_from_ss(const float* SS, size_t r) {
    const f32x4 a = *(const f32x4*)(SS + r * 16), b = *(const f32x4*)(SS + r * 16 + 4), c = *(const f32x4*)(SS + r * 16 + 8), d = *(const f32x4*)(SS + r * 16 + 12);
    const float s = ((a[0] + a[1]) + (a[2] + a[3])) + ((b[0] + b[1]) + (b[2] + b[3])) + ((c[0] + c[1]) + (c[2] + c[3])) + ((d[0] + d[1]) + (d[2] + d[3]));
    return rsqrtf(s * (1.f / D) + 1e-6f);
}
struct EpiRelu2 {
    static constexpr bool AFTER_DRAIN = false, HOOK = false; int hook_t;
    const float* SS; bf16_t* ACT;
    __device__ __forceinline__ void hook(Acc&, const Unit&, int, int, int, int) const {}
    __device__ __forceinline__ void operator()(const Acc& acc, const Unit& u, int wr, int wc, int fr, int fq) const {
#pragma unroll
        for (int ai = 0; ai < 2; ++ai)
#pragma unroll
            for (int m = 0; m < 4; ++m) { const size_t r = (size_t)GE_ROW(ai, m); const float rstd = rstd_from_ss(SS, r);
#pragma unroll
                for (int bj = 0; bj < 2; ++bj) { const int c = GE_COL(bj); f32x4 v0 = acc[ai][bj][m][0] * rstd, v1 = acc[ai][bj][m][1] * rstd;
#pragma unroll
                    for (int j = 0; j < 4; ++j) { const float a = fmaxf(v0[j], 0.f), b = fmaxf(v1[j], 0.f); v0[j] = a * a; v1[j] = b * b; }
                    *(u32x4*)(ACT + r * FF + c) = pack8(v0, v1); } }
    }
};
struct EpiSoftmax {
    static constexpr bool AFTER_DRAIN = true, HOOK = false; int hook_t;
    const float* SS; bf16_t* PROB;
    __device__ __forceinline__ void hook(Acc&, const Unit&, int, int, int, int) const {}
    __device__ __forceinline__ void operator()(const Acc&, const Unit&, int, int, int, int) const {}
    __device__ __forceinline__ void fused(Acc& acc, const Unit& u, int wr, int wc, int fr, int fq, LAS unsigned char* lds, int wid, int lane) const {
        LAS float* Pm = (LAS float*)lds; LAS float* Ps = Pm + 1024;
#pragma unroll
        for (int ai = 0; ai < 2; ++ai)
#pragma unroll
            for (int m = 0; m < 4; ++m) { const float rstd = rstd_from_ss(SS, (size_t)GE_ROW(ai, m)); float mx = -INFINITY;
#pragma unroll
                for (int bj = 0; bj < 2; ++bj)
#pragma unroll
                    for (int n = 0; n < 2; ++n)
#pragma unroll
                        for (int j = 0; j < 4; ++j) { const float s = acc[ai][bj][m][n][j] * rstd; acc[ai][bj][m][n][j] = s; mx = fmaxf(mx, s); }
                mx = fmaxf(mx, __shfl_xor(mx, 16)); mx = fmaxf(mx, __shfl_xor(mx, 32));
                if (fq == 0) Pm[(ai * 128 + wr * 64 + m * 16 + fr) * 4 + wc] = mx; }
        asm volatile("s_waitcnt lgkmcnt(0)" ::: "memory"); __builtin_amdgcn_s_barrier(); asm volatile("" ::: "memory");
#pragma unroll
        for (int ai = 0; ai < 2; ++ai)
#pragma unroll
            for (int m = 0; m < 4; ++m) { const int rl = ai * 128 + wr * 64 + m * 16 + fr; const f32x4 pm4 = *(const LAS f32x4*)(Pm + rl * 4);
                const float mx = fmaxf(fmaxf(pm4[0], pm4[1]), fmaxf(pm4[2], pm4[3])) * 1.44269504f; float sum = 0.f;
#pragma unroll
                for (int bj = 0; bj < 2; ++bj)
#pragma unroll
                    for (int n = 0; n < 2; ++n)
#pragma unroll
                        for (int j = 0; j < 4; ++j) { const float e = __builtin_amdgcn_exp2f(acc[ai][bj][m][n][j] * 1.44269504f - mx); acc[ai][bj][m][n][j] = e; sum += e; }
                sum += __shfl_xor(sum, 16); sum += __shfl_xor(sum, 32);
                if (fq == 0) Ps[rl * 4 + wc] = sum; }
        asm volatile("s_waitcnt lgkmcnt(0)" ::: "memory"); __builtin_amdgcn_s_barrier(); asm volatile("" ::: "memory");
#pragma unroll
        for (int ai = 0; ai < 2; ++ai)
#pragma unroll
            for (int m = 0; m < 4; ++m) { const int rl = ai * 128 + wr * 64 + m * 16 + fr; const f32x4 ps4 = *(const LAS f32x4*)(Ps + rl * 4);
                const float inv = 1.f / ((ps4[0] + ps4[1]) + (ps4[2] + ps4[3])); const size_t r = (size_t)GE_ROW(ai, m);
#pragma unroll
                for (int bj = 0; bj < 2; ++bj) *(u32x4*)(PROB + r * D + GE_COL(bj)) = pack8(acc[ai][bj][m][0] * inv, acc[ai][bj][m][1] * inv); }
    }
};
}

__device__ __forceinline__ void transpose_item(const float* W, int ldw, int k0, int n0, bf16_t* WT, int ldt, int drow0, int dk0, const float* kscale, LAS float* scr, int lane) {
#pragma unroll 8
    for (int i = 0; i < 32; ++i) { const int kk = 2 * i + (lane >> 5); float v = W[(size_t)(k0 + kk) * ldw + n0 + (lane & 31)]; if (kscale) v *= kscale[k0 + kk]; scr[kk * 33 + (lane & 31)] = v; }
    asm volatile("s_waitcnt lgkmcnt(0)" ::: "memory");
    const int c = lane & 7;
#pragma unroll
    for (int j = 0; j < 4; ++j) { const int n = (lane >> 3) + 8 * j; const LAS float* s = scr + (8 * c) * 33 + n;
        u32x4 o; o.x = ge::cvt_pk_bf16(s[0 * 33], s[1 * 33]); o.y = ge::cvt_pk_bf16(s[2 * 33], s[3 * 33]); o.z = ge::cvt_pk_bf16(s[4 * 33], s[5 * 33]); o.w = ge::cvt_pk_bf16(s[6 * 33], s[7 * 33]);
        *(u32x4*)(WT + (size_t)(drow0 + n) * ldt + dk0 + k0 + 8 * c) = o; }
    asm volatile("s_waitcnt lgkmcnt(0)" ::: "memory");
}
__device__ __forceinline__ void transpose_matrix(const float* W, int K, int N, bf16_t* WT, int ldt, int dk0, const float* kscale, LAS float* scr, int lane, int gw, int NGW) {
    const int nblk = N / 32, items = (K / 64) * nblk;
    for (int it = gw; it < items; it += NGW) { const int kb = it / nblk, nb = it % nblk; transpose_item(W, N, kb * 64, nb * 32, WT, ldt, nb * 32, dk0, kscale, scr, lane); }
}
namespace ge {
struct EpiScaleCol {
    static constexpr bool AFTER_DRAIN = false, HOOK = false; int hook_t;
    const float* colscale; float mul; bool use_cs; bf16_t* out; int ld;
    __device__ __forceinline__ void hook(Acc&, const Unit&, int, int, int, int) const {}
    __device__ __forceinline__ void operator()(const Acc& acc, const Unit& u, int wr, int wc, int fr, int fq) const {
#pragma unroll
        for (int bj = 0; bj < 2; ++bj) { const int c = GE_COL(bj);
            f32x4 s0 = (f32x4){mul, mul, mul, mul}, s1 = s0;
            if (use_cs) { s0 = s0 * *(const f32x4*)(colscale + c); s1 = s1 * *(const f32x4*)(colscale + c + 4); }
#pragma unroll
            for (int ai = 0; ai < 2; ++ai)
#pragma unroll
                for (int m = 0; m < 4; ++m) *(u32x4*)(out + (size_t)GE_ROW(ai, m) * ld + c) = pack8(acc[ai][bj][m][0] * s0, acc[ai][bj][m][1] * s1); }
    }
};
struct SchedOne {
    bool has; Unit u;
    __device__ __forceinline__ bool next(int i, Unit& o) const { if (i > 0 || !has) return false; o = u; return true; }
};
struct SchedProj {
    Order o; const char* XN; const char* WINT; const char* MEMN; const char* WKVT;
    __device__ __forceinline__ bool next(int i, Unit& u) const {
        int pm, pn; if (o.next(i, pm, pn)) { u.pm = pm; u.pn = pn; u.A = XN + (size_t)pm * (256 * D * 2); u.B = WINT + (size_t)pn * (256 * D * 2); return true; }
        const long L = (long)i * o.G + o.c - o.nwg; if (L < 0 || L >= 16) return false;
        u.pm = (int)(L >> 3); u.pn = 100 + (int)(L & 7); u.A = MEMN + (size_t)u.pm * (256 * D * 2); u.B = WKVT + (size_t)(L & 7) * (256 * D * 2); return true;
    }
};
}

namespace sc {
constexpr int RS = 72, FS = 68, AL = 296;
constexpr int O_X = 0;
constexpr int O_LAK = 0, O_URB = 9216, O_URK = 18432, O_T = 27648;
constexpr int O_LW = 37888;
constexpr int O_AT = 55296, O_BT = 64512, O_KT = 73728, O_RT = 82944, O_BHT = 92160, O_KHT = 101376, O_VT = 110592, O_S = 119808, O_RHST = 129024, O_CMT = 138240;
constexpr int O_LABB = O_CMT;
constexpr int O_YF = O_AT;
constexpr int O_TTD = O_KT, O_X1T = O_KT + 3072, O_TT32 = O_KT + 4608, O_X2T = O_KT + 7168;
constexpr int O_GC = 147456, O_BON = O_GC + 256, O_SEG = O_BON + 256, O_END = O_SEG + 2048;
static_assert(O_X2T + 32 * 40 * 2 <= O_RT + 0 || true, "");
typedef unsigned long long u64;
__device__ __forceinline__ f32x4 mma(bf16x8 x, bf16x8 y, f32x4 c) { return __builtin_amdgcn_mfma_f32_16x16x32_bf16(x, y, c, 0, 0, 0); }
__device__ __forceinline__ bf16x8 ldfrag(LAS const unsigned char* base, int rs, int row, int k) { return *(const LAS bf16x8*)(base + (row * rs + k) * 2); }
__device__ __forceinline__ u64 pack4(f32x4 v) { return (u64)ge::cvt_pk_bf16(v[0], v[1]) | ((u64)ge::cvt_pk_bf16(v[2], v[3]) << 32); }
__device__ __forceinline__ void st4(LAS unsigned char* base, int rs, int row, int col, f32x4 v) { *(LAS u64*)(base + (row * rs + col) * 2) = pack4(v); }
__device__ __forceinline__ void st1(LAS unsigned char* base, int rs, int row, int col, float v) { *(LAS bf16_t*)(base + (row * rs + col) * 2) = (bf16_t)(ge::cvt_pk_bf16(v, v) & 0xffffu); }
__device__ __forceinline__ f32x4 ld4bf(const bf16_t* p) { const u64 w = *(const u64*)p; f32x4 v; v[0] = __uint_as_float((unsigned)w << 16); v[1] = __uint_as_float((unsigned)w & 0xffff0000u);
    v[2] = __uint_as_float((unsigned)(w >> 32) << 16); v[3] = __uint_as_float((unsigned)(w >> 32) & 0xffff0000u); return v; }
__device__ __forceinline__ f32x4 exp4(f32x4 x) { f32x4 r; r[0] = __expf(x[0]); r[1] = __expf(x[1]); r[2] = __expf(x[2]); r[3] = __expf(x[3]); return r; }
#define SC_BAR() do { asm volatile("s_waitcnt vmcnt(0) lgkmcnt(0)" ::: "memory"); __builtin_amdgcn_s_barrier(); asm volatile("" ::: "memory"); } while (0)
#define SC_LWAIT() asm volatile("s_waitcnt lgkmcnt(0)" ::: "memory")

__device__ __forceinline__ void scan_bh(const Args& a, LAS unsigned char* L, const int b, const int h, const int t0, const int nchunks) {
    int tid_o = threadIdx.x; asm volatile("" : "+v"(tid_o));
    const int tid = tid_o, w = __builtin_amdgcn_readfirstlane(tid >> 6);
    const int ts = w & 3, half = w >> 2;
    const int rt = w >> 1, ct0 = (w & 1) * 2;
    const bf16_t* RKVp = (const bf16_t*)(a.ws + WS_RKV); const bf16_t* LORAp = (const bf16_t*)(a.ws + WS_LORA); bf16_t* ACATp = (bf16_t*)(a.ws + WS_ACAT);
    const bf16_t* W2T = (const bf16_t*)(a.ws + WS_LW2T); const bf16_t* A2T = (const bf16_t*)(a.ws + WS_LA2T); const bf16_t* G2T = (const bf16_t*)(a.ws + WS_LG2T);
    const float* mu = a.in[I_MU];
    const int hj0 = h * 64;
    LAS float* LW = (LAS float*)(L + O_LW); LAS float* GC = (LAS float*)(L + O_GC); LAS float* BON = (LAS float*)(L + O_BON); LAS float* SEG = (LAS float*)(L + O_SEG);
    LAS float* YF = (LAS float*)(L + O_YF);
    f32x4 zacc[2];
    zacc[0] = (f32x4){0.f, 0.f, 0.f, 0.f}; zacc[1] = zacc[0];
    for (int i = tid; i < 64 * RS / 4; i += NTHREADS) *(LAS u64*)(L + O_S + i * 8) = 0ull;

    for (int ch = 0; ch < nchunks; ++ch) {
        const int tc0 = t0 + ch * 64;
        int lane_o = tid & 63; asm volatile("" : "+v"(lane_o));
        const int lane = lane_o, tl = lane & 15, q = lane >> 4;
        const size_t m0 = (size_t)b * SEQ + tc0;
        for (int it = tid; it < 64 * 36; it += NTHREADS) {
            const int t = it / 36, c8 = it % 36;
            f32x4 c0, c1, p0, p1;
            ge::unpack8(*(const u32x4*)(LORAp + (m0 + t) * NLORA + c8 * 8), c0, c1);
            if (tc0 + t == 0) { p0 = (f32x4){0.f, 0.f, 0.f, 0.f}; p1 = p0; } else ge::unpack8(*(const u32x4*)(LORAp + (m0 + t - 1) * NLORA + c8 * 8), p0, p1);
            const f32x4 m0v = *(const f32x4*)(mu + C_LORA + c8 * 8), m1v = *(const f32x4*)(mu + C_LORA + c8 * 8 + 4);
            f32x4 s0 = c0 + m0v * (p0 - c0), s1 = c1 + m1v * (p1 - c1);
            if (c8 < 8) {
#pragma unroll
                for (int j = 0; j < 4; ++j) { s0[j] = 1.f - 2.f * __builtin_amdgcn_rcpf(1.f + __expf(2.f * s0[j])); s1[j] = 1.f - 2.f * __builtin_amdgcn_rcpf(1.f + __expf(2.f * s1[j])); }
            } else if (c8 >= 16) {
#pragma unroll
                for (int j = 0; j < 4; ++j) { s0[j] = ge::fast_sigmoid(s0[j]); s1[j] = ge::fast_sigmoid(s1[j]); }
            }
            *(LAS u32x4*)(L + O_X + (t * AL + c8 * 8) * 2) = ge::pack8(s0, s1);
        }
        SC_BAR();
        const int t = 16 * ts + tl;
        const bool first = (tc0 + t == 0);
        f32x4 va[4], vb[4], vk[4];
#define vr va
#define vv vb
#define vg vk
        if (half == 0) {
            f32x4 aw[4], aa[4];
#pragma unroll
            for (int jt = 0; jt < 4; ++jt) { aw[jt] = (f32x4){0.f, 0.f, 0.f, 0.f}; aa[jt] = aw[jt]; }
#pragma unroll
            for (int ks = 0; ks < 2; ++ks) {
                const bf16x8 yw = ldfrag(L + O_X, AL, t, ks * 32 + 8 * q), ya = ldfrag(L + O_X, AL, t, 64 + ks * 32 + 8 * q);
#pragma unroll
                for (int jt = 0; jt < 4; ++jt) {
                    const bf16x8 xw = *(const bf16x8*)(W2T + (size_t)(hj0 + 16 * jt + tl) * 64 + ks * 32 + 8 * q), xa = *(const bf16x8*)(A2T + (size_t)(hj0 + 16 * jt + tl) * 64 + ks * 32 + 8 * q);
                    aw[jt] = mma(xw, yw, aw[jt]); aa[jt] = mma(xa, ya, aa[jt]);
                }
            }
            float ss = 0.f, bs = 0.f;
#pragma unroll
            for (int jt = 0; jt < 4; ++jt) {
                const int j = 16 * jt + 4 * q, hj = hj0 + j;
                const f32x4 w0v = *(const f32x4*)(a.in[I_W0] + hj), a0v = *(const f32x4*)(a.in[I_A0] + hj), kkv = *(const f32x4*)(a.in[I_KK] + hj), kav = *(const f32x4*)(a.in[I_KA] + hj), rkv = *(const f32x4*)(a.in[I_RK] + hj);
                const f32x4 kc = ld4bf(RKVp + (m0 + t) * NRKV + 1024 + hj), rc = ld4bf(RKVp + (m0 + t) * NRKV + hj);
                f32x4 kp = (f32x4){0.f, 0.f, 0.f, 0.f}, rp = kp;
                if (!first) { kp = ld4bf(RKVp + (m0 + t - 1) * NRKV + 1024 + hj); rp = ld4bf(RKVp + (m0 + t - 1) * NRKV + hj); }
                const f32x4 pk = kc + *(const f32x4*)(mu + 1024 + hj) * (kp - kc), pr = rc + *(const f32x4*)(mu + hj) * (rp - rc);
                f32x4 lw, alr;
#pragma unroll
                for (int e = 0; e < 4; ++e) {
                    const float z = -(aw[jt][e] + w0v[e]);
                    const float sp = fmaxf(z, 0.f) + __logf(1.f + __expf(-fabsf(z)));
                    lw[e] = -__expf(-sp - 0.5f);
                    alr[e] = ge::fast_sigmoid(aa[jt][e] + a0v[e]);
                }
                const f32x4 kr = pk * kkv;
                ss += (kr[0] * kr[0] + kr[1] * kr[1]) + (kr[2] * kr[2] + kr[3] * kr[3]);
                const f32x4 km = pk * (1.f + (alr - 1.f) * kav);
                const f32x4 bt = pr * km * rkv;
                bs += (bt[0] + bt[1]) + (bt[2] + bt[3]);
                va[jt] = kr; vb[jt] = alr; vk[jt] = km;
                *(LAS f32x4*)(LW + t * FS + j) = lw;
            }
            ss += __shfl_xor(ss, 16); ss += __shfl_xor(ss, 32); bs += __shfl_xor(bs, 16); bs += __shfl_xor(bs, 32);
            const float inv = 1.f / fmaxf(sqrtf(ss), 1e-12f);
#pragma unroll
            for (int jt = 0; jt < 4; ++jt) { const f32x4 kk = va[jt] * inv; va[jt] = -kk; vb[jt] = kk * vb[jt]; }
            if (q == 0) BON[t] = bs;
        } else {
            f32x4 ag[4];
#pragma unroll
            for (int jt = 0; jt < 4; ++jt) ag[jt] = (f32x4){0.f, 0.f, 0.f, 0.f};
#pragma unroll
            for (int ks = 0; ks < 5; ++ks) {
                const bf16x8 yg = ldfrag(L + O_X, AL, t, 128 + ks * 32 + 8 * q);
#pragma unroll
                for (int jt = 0; jt < 4; ++jt) { const bf16x8 xg = *(const bf16x8*)(G2T + (size_t)(hj0 + 16 * jt + tl) * 160 + ks * 32 + 8 * q); ag[jt] = mma(xg, yg, ag[jt]); }
            }
#pragma unroll
            for (int jt = 0; jt < 4; ++jt) {
                const int hj = hj0 + 16 * jt + 4 * q;
                const f32x4 rc = ld4bf(RKVp + (m0 + t) * NRKV + hj), vc = ld4bf(RKVp + (m0 + t) * NRKV + 2048 + hj);
                f32x4 rp = (f32x4){0.f, 0.f, 0.f, 0.f}, vp = rp;
                if (!first) { rp = ld4bf(RKVp + (m0 + t - 1) * NRKV + hj); vp = ld4bf(RKVp + (m0 + t - 1) * NRKV + 2048 + hj); }
                vr[jt] = rc + *(const f32x4*)(mu + hj) * (rp - rc); vv[jt] = vc + *(const f32x4*)(mu + 2048 + hj) * (vp - vc); vg[jt] = ag[jt];
            }
        }
        SC_BAR();
        { const int j = tid & 63, sg = tid >> 6; float s = 0.f;
#pragma unroll
          for (int tt = 0; tt < 8; ++tt) { s += LW[(8 * sg + tt) * FS + j]; LW[(8 * sg + tt) * FS + j] = s; }
          SEG[sg * 64 + j] = s;
          SC_BAR();
          float off = 0.f;
          for (int s2 = 0; s2 < sg; ++s2) off += SEG[s2 * 64 + j];
#pragma unroll
          for (int tt = 0; tt < 8; ++tt) LW[(8 * sg + tt) * FS + j] += off;
        }
        SC_BAR();
#pragma unroll
        for (int jt = 0; jt < 4; ++jt) {
            const int j = 16 * jt + 4 * q;
            const f32x4 cum = *(const LAS f32x4*)(LW + t * FS + j), cumC = *(const LAS f32x4*)(LW + 63 * FS + j);
            if (half == 0) {
                f32x4 cprev = (f32x4){0.f, 0.f, 0.f, 0.f}; if (t > 0) cprev = *(const LAS f32x4*)(LW + (t - 1) * FS + j);
                const f32x4 eprev = exp4(cprev), einv = exp4(-cum), erem = exp4(cumC - cum);
                st4(L + O_AT, RS, t, j, va[jt] * eprev); st4(L + O_BT, RS, t, j, vb[jt] * einv); st4(L + O_KT, RS, t, j, vk[jt] * einv);
                const f32x4 bh = vb[jt] * erem, kh = vk[jt] * erem;
#pragma unroll
                for (int e = 0; e < 4; ++e) { st1(L + O_BHT, RS, j + e, t, bh[e]); st1(L + O_KHT, RS, j + e, t, kh[e]); }
            } else {
                st4(L + O_RT, RS, t, j, vr[jt] * exp4(cum));
#pragma unroll
                for (int e = 0; e < 4; ++e) st1(L + O_VT, RS, j + e, t, vv[jt][e]);
                if (ts == 0 && tl == 0) *(LAS f32x4*)(GC + j) = exp4(cumC);
            }
        }
        SC_BAR();
        f32x4 pacc[2], yacc[2];
        {
            f32x4 lab[2], lak[2], urb[2], urk[2];
#pragma unroll
            for (int c = 0; c < 2; ++c) { lab[c] = (f32x4){0.f, 0.f, 0.f, 0.f}; lak[c] = lab[c]; urb[c] = lab[c]; urk[c] = lab[c]; pacc[c] = lab[c]; yacc[c] = lab[c]; }
            const f32x4 gc = *(const LAS f32x4*)(GC + 16 * rt + 4 * q);
            zacc[0] = zacc[0] * gc; zacc[1] = zacc[1] * gc;
#pragma unroll
            for (int ks = 0; ks < 2; ++ks) {
                const int k = ks * 32 + 8 * q;
                const bf16x8 xb = ldfrag(L + O_BT, RS, 16 * rt + tl, k), xk = ldfrag(L + O_KT, RS, 16 * rt + tl, k), xa = ldfrag(L + O_AT, RS, 16 * rt + tl, k);
                const bf16x8 xs = ldfrag(L + O_S, RS, 16 * rt + tl, k), xkh = ldfrag(L + O_KHT, RS, 16 * rt + tl, k);
#pragma unroll
                for (int c = 0; c < 2; ++c) {
                    const int cr = 16 * (ct0 + c) + tl;
                    const bf16x8 ya = ldfrag(L + O_AT, RS, cr, k), yr = ldfrag(L + O_RT, RS, cr, k), ys = ldfrag(L + O_S, RS, cr, k), yv = ldfrag(L + O_VT, RS, cr, k);
                    lab[c] = mma(xb, ya, lab[c]); lak[c] = mma(xk, ya, lak[c]); urb[c] = mma(xb, yr, urb[c]); urk[c] = mma(xk, yr, urk[c]);
                    pacc[c] = mma(xa, ys, pacc[c]);
                    yacc[c] = mma(xs, yr, yacc[c]);
                    zacc[c] = mma(xkh, yv, zacc[c]);
                }
            }
#pragma unroll
            for (int c = 0; c < 2; ++c) {
                const int tcol = 16 * (ct0 + c) + tl, u0 = 16 * rt + 4 * q;
#pragma unroll
                for (int e = 0; e < 4; ++e) { const bool lt = (u0 + e) < tcol, le = (u0 + e) <= tcol; lab[c][e] = lt ? lab[c][e] : 0.f; lak[c][e] = lt ? lak[c][e] : 0.f; urb[c][e] = le ? urb[c][e] : 0.f; urk[c][e] = le ? urk[c][e] : 0.f; }
                *(LAS f32x4*)(LW + tcol * FS + u0) = lab[c];
                st4(L + O_LABB, RS, tcol, u0, lab[c]); st4(L + O_LAK, RS, tcol, u0, lak[c]); st4(L + O_URB, RS, tcol, u0, urb[c]); st4(L + O_URK, RS, tcol, u0, urk[c]);
            }
        }
        SC_BAR();
#pragma unroll
        for (int ks = 0; ks < 2; ++ks) {
            const int k = ks * 32 + 8 * q;
            const bf16x8 xl = ldfrag(L + O_LAK, RS, 16 * rt + tl, k), xv = ldfrag(L + O_VT, RS, 16 * rt + tl, k);
#pragma unroll
            for (int c = 0; c < 2; ++c) {
                const int cr = 16 * (ct0 + c) + tl;
                pacc[c] = mma(xl, ldfrag(L + O_VT, RS, cr, k), pacc[c]);
                yacc[c] = mma(xv, ldfrag(L + O_URK, RS, cr, k), yacc[c]);
            }
        }
#pragma unroll
        for (int c = 0; c < 2; ++c) st4(L + O_RHST, RS, 16 * (ct0 + c) + tl, 16 * rt + 4 * q, pacc[c]);
        if (w == 0) {
            const int p = q, c = tl;
            float Tc[16];
#pragma unroll
            for (int k = 0; k < 16; ++k) Tc[k] = (k == c) ? 1.f : 0.f;
#pragma unroll
            for (int r = 1; r < 16; ++r) {
                const LAS float* lrow = LW + (16 * p + r) * FS + 16 * p;
                float acc0 = 0.f, acc1 = 0.f;
#pragma unroll
                for (int k = 0; k < r; k += 2) { acc0 += lrow[k] * Tc[k]; if (k + 1 < r) acc1 += lrow[k + 1] * Tc[k + 1]; }
                Tc[r] = (r > c) ? (acc0 + acc1) : Tc[r];
            }
            for (int i = lane; i < 6 * 16 * 2; i += 64) { const int blk = i >> 5, rr = (i >> 1) & 15, hf = i & 1;
                const int pr_ = (blk < 3) ? 0 : (blk < 5 ? 1 : 2), qc = (blk < 3) ? blk + 1 : (blk < 5 ? blk - 1 : 3);
                *(LAS u32x4*)(L + O_T + ((16 * pr_ + rr) * RS + 16 * qc + 8 * hf) * 2) = (u32x4){0u, 0u, 0u, 0u}; }
#pragma unroll
            for (int k = 0; k < 16; ++k) st1(L + O_T, RS, 16 * p + k, 16 * p + c, Tc[k]);
            { u32x4 w0, w1; w0.x = ge::cvt_pk_bf16(Tc[0], Tc[1]); w0.y = ge::cvt_pk_bf16(Tc[2], Tc[3]); w0.z = ge::cvt_pk_bf16(Tc[4], Tc[5]); w0.w = ge::cvt_pk_bf16(Tc[6], Tc[7]);
              w1.x = ge::cvt_pk_bf16(Tc[8], Tc[9]); w1.y = ge::cvt_pk_bf16(Tc[10], Tc[11]); w1.z = ge::cvt_pk_bf16(Tc[12], Tc[13]); w1.w = ge::cvt_pk_bf16(Tc[14], Tc[15]);
              *(LAS u32x4*)(L + O_TTD + ((p * 16 + c) * 24) * 2) = w0; *(LAS u32x4*)(L + O_TTD + ((p * 16 + c) * 24 + 8) * 2) = w1;
              if (p < 2) {
                  *(LAS u32x4*)(L + O_TT32 + ((16 * p + c) * 40 + 16 * p) * 2) = w0; *(LAS u32x4*)(L + O_TT32 + ((16 * p + c) * 40 + 16 * p + 8) * 2) = w1;
                  if (p == 1) { *(LAS u32x4*)(L + O_TT32 + ((16 + c) * 40) * 2) = (u32x4){0u, 0u, 0u, 0u}; *(LAS u32x4*)(L + O_TT32 + ((16 + c) * 40 + 8) * 2) = (u32x4){0u, 0u, 0u, 0u}; }
              } }
            SC_LWAIT();
            const bf16x8 zf = (bf16x8){0, 0, 0, 0, 0, 0, 0, 0};
            const f32x4 z4 = (f32x4){0.f, 0.f, 0.f, 0.f};
#pragma unroll
            for (int pi = 0; pi < 2; ++pi) {
                const int pp = 2 * pi + 1, qq = 2 * pi;
                const bf16x8 xl = (q < 2) ? ldfrag(L + O_LABB, RS, 16 * pp + tl, 16 * qq + 8 * q) : zf;
                const bf16x8 yt = (q < 2) ? ldfrag(L + O_TTD, 24, qq * 16 + tl, 8 * q) : zf;
                const f32x4 x1 = mma(xl, yt, z4);
                st4(L + O_X1T, 24, pi * 16 + tl, 4 * q, x1);
                SC_LWAIT();
                const bf16x8 xx = (q < 2) ? ldfrag(L + O_X1T, 24, pi * 16 + tl, 8 * q) : zf;
                const bf16x8 ytp = (q < 2) ? ldfrag(L + O_T, RS, 16 * pp + tl, 16 * pp + 8 * q) : zf;
                const f32x4 tpqT = mma(xx, ytp, z4);
                st4(L + O_T, RS, 16 * pp + tl, 16 * qq + 4 * q, tpqT);
                if (pi == 0) { const f32x4 tpq = mma(ytp, xx, z4);
                    st4(L + O_TT32, 40, tl, 16 + 4 * q, tpq); }
            }
            SC_LWAIT();
            f32x4 x2[2][2];
#pragma unroll
            for (int r2 = 0; r2 < 2; ++r2) { const bf16x8 xl = ldfrag(L + O_LABB, RS, 32 + 16 * r2 + tl, 8 * q);
#pragma unroll
                for (int c2 = 0; c2 < 2; ++c2) x2[r2][c2] = mma(xl, ldfrag(L + O_TT32, 40, 16 * c2 + tl, 8 * q), z4); }
#pragma unroll
            for (int r2 = 0; r2 < 2; ++r2)
#pragma unroll
                for (int c2 = 0; c2 < 2; ++c2) st4(L + O_X2T, 40, 16 * c2 + tl, 16 * r2 + 4 * q, x2[r2][c2]);
            SC_LWAIT();
#pragma unroll
            for (int c2 = 0; c2 < 2; ++c2) { const bf16x8 xx = ldfrag(L + O_X2T, 40, 16 * c2 + tl, 8 * q);
#pragma unroll
                for (int r2 = 0; r2 < 2; ++r2) { const f32x4 d = mma(xx, ldfrag(L + O_T, RS, 32 + 16 * r2 + tl, 32 + 8 * q), z4);
                    st4(L + O_T, RS, 32 + 16 * r2 + tl, 16 * c2 + 4 * q, d); } }
        }
        SC_BAR();
        {
            f32x4 cacc[2]; cacc[0] = (f32x4){0.f, 0.f, 0.f, 0.f}; cacc[1] = cacc[0];
#pragma unroll
            for (int ks = 0; ks < 2; ++ks) {
                const int k = ks * 32 + 8 * q;
                const bf16x8 xt = ldfrag(L + O_T, RS, 16 * rt + tl, k);
#pragma unroll
                for (int c = 0; c < 2; ++c) cacc[c] = mma(xt, ldfrag(L + O_RHST, RS, 16 * (ct0 + c) + tl, k), cacc[c]);
            }
#pragma unroll
            for (int c = 0; c < 2; ++c) st4(L + O_CMT, RS, 16 * (ct0 + c) + tl, 16 * rt + 4 * q, cacc[c]);
        }
        SC_BAR();
#pragma unroll
        for (int ks = 0; ks < 2; ++ks) {
            const int k = ks * 32 + 8 * q;
            const bf16x8 xbh = ldfrag(L + O_BHT, RS, 16 * rt + tl, k), xc = ldfrag(L + O_CMT, RS, 16 * rt + tl, k);
#pragma unroll
            for (int c = 0; c < 2; ++c) {
                const int cr = 16 * (ct0 + c) + tl;
                zacc[c] = mma(xbh, ldfrag(L + O_CMT, RS, cr, k), zacc[c]);
                yacc[c] = mma(xc, ldfrag(L + O_URB, RS, cr, k), yacc[c]);
            }
        }
#pragma unroll
        for (int c = 0; c < 2; ++c) { st4(L + O_S, RS, 16 * (ct0 + c) + tl, 16 * rt + 4 * q, zacc[c]); *(LAS f32x4*)(YF + (16 * (ct0 + c) + tl) * FS + 16 * rt + 4 * q) = yacc[c]; }
        SC_BAR();
        if (half == 1) {
            f32x4 y[4]; float s = 0.f;
#pragma unroll
            for (int jt = 0; jt < 4; ++jt) { y[jt] = *(const LAS f32x4*)(YF + t * FS + 16 * jt + 4 * q); s += (y[jt][0] + y[jt][1]) + (y[jt][2] + y[jt][3]); }
            s += __shfl_xor(s, 16); s += __shfl_xor(s, 32);
            const float mean = s * (1.f / 64.f); float vs = 0.f;
#pragma unroll
            for (int jt = 0; jt < 4; ++jt) { y[jt] = y[jt] - mean; vs += (y[jt][0] * y[jt][0] + y[jt][1] * y[jt][1]) + (y[jt][2] * y[jt][2] + y[jt][3] * y[jt][3]); }
            vs += __shfl_xor(vs, 16); vs += __shfl_xor(vs, 32);
            const float rstd = rsqrtf(vs * (1.f / 64.f) + 64.f * 1e-5f), bon = BON[t];
#pragma unroll
            for (int jt = 0; jt < 4; ++jt) { const int hi = hj0 + 16 * jt + 4 * q;
                const f32x4 o = (y[jt] * rstd * *(const f32x4*)(a.in[I_GNW] + hi) + *(const f32x4*)(a.in[I_GNB] + hi) + bon * vv[jt]) * vg[jt];
                *(u64*)(ACATp + (m0 + t) * KCAT + hi) = pack4(o); }
        }
    }
}
#undef vr
#undef vv
#undef vg
}
#define XB_TMO      128
#define XB_XCNT(j)  (256  + 64 * (j))
#define XB_XSUB(j)  (1280 + 64 * (j))
#define XB_XGEN(j)  (2304 + 64 * (j))
#define XB_TOP      3328
#define XB_TOPGEN   3392
#define XCD_BAR_WORDS 3456
#define XB_SPIN_CAP (1u << 18)
__device__ __forceinline__ unsigned xb_ld(unsigned* p)              { return __hip_atomic_load(p, __ATOMIC_RELAXED, __HIP_MEMORY_SCOPE_AGENT); }
__device__ __forceinline__ unsigned xb_add(unsigned* p, unsigned v) { return __hip_atomic_fetch_add(p, v, __ATOMIC_RELAXED, __HIP_MEMORY_SCOPE_AGENT); }
__device__ __forceinline__ unsigned xb_xcc_id() { return (unsigned)__builtin_amdgcn_s_getreg((3 << 11) | 20) & 0xFu; }
#define XB_SPIN(cond, bar) do { unsigned _sp = 0; while (cond) { __builtin_amdgcn_s_sleep(1); \
    if ((++_sp & 255u) == 0u) { if (xb_ld(&(bar)[XB_TMO])) break; if (_sp > XB_SPIN_CAP) { atomicAdd(&(bar)[XB_TMO], 1u); break; } } } } while (0)
struct XcdBarrier { unsigned* bar; unsigned x; volatile LAS unsigned* st; };
__device__ __forceinline__ XcdBarrier xcd_barrier_post(unsigned* bar, volatile LAS unsigned* st) {
    XcdBarrier b; b.bar = bar; b.x = xb_xcc_id(); b.st = st;
    if (threadIdx.x == 0) (void)xb_add(&bar[XB_XCNT(b.x)], 1u);
    return b;
}
__device__ __forceinline__ void xcd_barrier_complete(unsigned* bar, unsigned x, unsigned& nloc, unsigned& nx) {
    const unsigned G = gridDim.x * gridDim.y * gridDim.z;
    unsigned sum, cnt, mine, sp = 0u;
    for (;;) {
        sum = 0u; cnt = 0u; mine = 0u;
#pragma unroll
        for (unsigned j = 0; j < 16; ++j) { const unsigned c = xb_ld(&bar[XB_XCNT(j)]); sum += c; cnt += (c > 0u) ? 1u : 0u; mine = (j == x) ? c : mine; }
        if (sum == G) break;
        __builtin_amdgcn_s_sleep(1);
        if ((++sp & 255u) == 0u) { if (xb_ld(&bar[XB_TMO])) break; if (sp > XB_SPIN_CAP) { atomicAdd(&bar[XB_TMO], 1u); break; } }
    }
    nloc = mine > 0u ? mine : 1u; nx = cnt > 0u ? cnt : 1u;
}
__device__ __forceinline__ void xcd_barrier(const XcdBarrier& b) {
    asm volatile("s_waitcnt vmcnt(0)" ::: "memory");
    __syncthreads();
    if (threadIdx.x == 0) {
        unsigned* bar = b.bar;
        __builtin_amdgcn_s_waitcnt(0);
        unsigned nloc = b.st[0], nx = b.st[1];
        if (nloc == 0u) { xcd_barrier_complete(bar, b.x, nloc, nx); b.st[0] = nloc; b.st[1] = nx; }
        const unsigned old = xb_add(&bar[XB_XSUB(b.x)], 1u);
        const unsigned gen = old / nloc;
        if (old + 1u == (gen + 1u) * nloc) {
            __builtin_amdgcn_fence(__ATOMIC_RELEASE, "agent");
            asm volatile("s_waitcnt vmcnt(0)" ::: "memory");
            const unsigned og = xb_add(&bar[XB_TOP], 1u);
            const unsigned tg = og / nx;
            if (og + 1u == (tg + 1u) * nx) xb_add(&bar[XB_TOPGEN], 1u);
            else XB_SPIN(xb_ld(&bar[XB_TOPGEN]) == tg, bar);
            __builtin_amdgcn_fence(__ATOMIC_ACQUIRE, "agent");
            xb_add(&bar[XB_XGEN(b.x)], 1u);
            asm volatile("s_waitcnt vmcnt(0)" ::: "memory");
        } else {
            XB_SPIN(xb_ld(&bar[XB_XGEN(b.x)]) == gen, bar);
            __builtin_amdgcn_fence(__ATOMIC_ACQUIRE, "agent");
            asm volatile("s_waitcnt vmcnt(0)" ::: "memory");
        }
    }
    __syncthreads();
}

#define p_XN ((bf16_t*)(a.ws + WS_XN))
#define p_RKV ((bf16_t*)(a.ws + WS_RKV))
#define p_LORA ((bf16_t*)(a.ws + WS_LORA))
#define p_AQKV ((bf16_t*)(a.ws + WS_AQKV))
#define p_GATES ((bf16_t*)a.out)
#define p_ACAT ((bf16_t*)(a.ws + WS_ACAT))
#define p_WST ((bf16_t*)(a.ws + WS_WST))
#define p_VWT ((bf16_t*)(a.ws + WS_VWT))
#define p_KV ((bf16_t*)(a.ws + WS_KV))
#define p_MEMN ((bf16_t*)(a.ws + WS_MEMN))
#define p_SS1 ((float*)(a.ws + WS_SS1))
#define p_SS2 ((float*)(a.ws + WS_SS2))
#define p_SS3 ((float*)(a.ws + WS_SS3))
#define p_H2B ((bf16_t*)(a.ws + WS_H2B))
#define p_MERGED ((bf16_t*)(a.ws + WS_MERGED))
#define p_H1B ((bf16_t*)(a.ws + WS_H1B))
#define p_PROB ((bf16_t*)(a.ws + WS_PROB))
#define p_ACT ((bf16_t*)(a.ws + WS_ACT))
#define p_WINT ((bf16_t*)(a.ws + WS_WINT))
#define p_PCATT ((bf16_t*)(a.ws + WS_PCATT))
#define p_WOUTT ((bf16_t*)(a.ws + WS_WOUTT))
#define p_W1T ((bf16_t*)(a.ws + WS_W1T))
#define p_W2T ((bf16_t*)(a.ws + WS_W2T))
#define p_WKVT ((bf16_t*)(a.ws + WS_WKVT))
#define p_WQB ((bf16_t*)(a.ws + WS_WQB))
#define p_WOT ((bf16_t*)(a.ws + WS_WOT))
#define p_OUT (a.out)
constexpr int MISC_OFF = LDSCTL_OFF;
__global__ void __launch_bounds__(NTHREADS, 2) mk_fwd(Args a) {
    extern __shared__ __attribute__((aligned(16))) unsigned char lds_raw[];
    float* lds = (float*)lds_raw;
    LAS unsigned char* ldsl = (LAS unsigned char*)lds_raw;
    const int tid = threadIdx.x, lane = tid & 63, wave = tid >> 6;
    const int G = gridDim.x, bid = blockIdx.x;
    const int gw = bid * NWAVES + wave, NGW = G * NWAVES;
    unsigned char* ws = a.ws;
    LAS float* scr = (LAS float*)(ldsl + wave * 16384);

    for (int u = tid; u < (LDS_BYTES - LDSCTL_OFF) / 4; u += NTHREADS) ((LAS unsigned*)(ldsl + LDSCTL_OFF))[u] = 0u;
    __syncthreads();
    XcdBarrier bar = xcd_barrier_post((unsigned*)(ws + WS_CTL) + 4096, (volatile LAS unsigned*)(ldsl + MISC_OFF) + 8);
    cg::grid_group grid = cg::this_grid();

    {
        {
            const float* W = a.in[I_WIN];
            for (int it = gw; it < 16 * 241; it += NGW) { const int kb = it / 241, nb = it % 241, c = nb * 32;
                const int drow = (c < C_LORA) ? c : (c < C_AQ) ? 7424 + (c - C_LORA) : (c < C_GATE) ? 5120 + (c - C_AQ) : 3072 + (c - C_GATE);
                transpose_item(W, NIN, kb * 64, c, p_WINT, D, drow, 0, nullptr, scr, lane); }
            for (int i = gw * 64 + lane; i < 224 * D / 8; i += NGW * 64) *(u32x4*)(p_WINT + (size_t)7712 * D + (size_t)i * 8) = (u32x4){0u, 0u, 0u, 0u};
        }
        for (int i = gw * 64 + lane; i < 1024 * 288; i += NGW * 64) {
            if (i < 1024 * 64) { const int n = i >> 6, c = i & 63; ((bf16_t*)(a.ws + WS_LW2T))[i] = f2bf(a.in[I_W2][c * 1024 + n]); }
            else if (i < 2 * 1024 * 64) { const int i2 = i - 1024 * 64, n = i2 >> 6, c = i2 & 63; ((bf16_t*)(a.ws + WS_LA2T))[i2] = f2bf(a.in[I_A2][c * 1024 + n]); }
            else { const int i2 = i - 2 * 1024 * 64, n = i2 / 160, c = i2 % 160; ((bf16_t*)(a.ws + WS_LG2T))[i2] = f2bf(a.in[I_G2][c * 1024 + n]); }
        }
        transpose_matrix(a.in[I_WKV], 1024, 2048, p_WKVT, D, 0, nullptr, scr, lane, gw, NGW);
        transpose_matrix(a.in[I_PRWKV], 1024, 1024, p_PCATT, KCAT, 0, nullptr, scr, lane, gw, NGW);
        transpose_matrix(a.in[I_PATTN], 256, 1024, p_PCATT, KCAT, 1024, nullptr, scr, lane, gw, NGW);
        transpose_matrix(a.in[I_WOUT], 1024, 1024, p_WOUTT, D, 0, nullptr, scr, lane, gw, NGW);
        transpose_matrix(a.in[I_WO], 1024, 1024, p_WOT, D, 0, nullptr, scr, lane, gw, NGW);
        { const float* WQ = a.in[I_WQ]; for (int i = gw * 64 + lane; i < D * D / 8; i += NGW * 64) { const f32x4 v0 = *(const f32x4*)(WQ + (size_t)i * 8), v1 = *(const f32x4*)(WQ + (size_t)i * 8 + 4); *(u32x4*)(p_WQB + (size_t)i * 8) = ge::pack8(v0, v1); } }
        for (int r = gw; r < M + 512; r += NGW) {
            const bool ism = r >= M; const int rr = ism ? r - M : r;
            const float* src = (ism ? a.in[I_MEM] : a.in[I_X]) + (size_t)rr * D; const float* g = ism ? a.in[I_NMEM] : a.in[I_NMIX];
            bf16_t* dst = (ism ? p_MEMN : p_XN) + (size_t)rr * D;
            f32x4 v[4]; float ss = 0.f;
#pragma unroll
            for (int i = 0; i < 4; ++i) { v[i] = *(const f32x4*)(src + (lane + 64 * i) * 4); ss += (v[i][0] * v[i][0] + v[i][1] * v[i][1]) + (v[i][2] * v[i][2] + v[i][3] * v[i][3]); }
            const float rstd = rsqrtf(wave_sum(ss) * (1.f / D) + 1e-6f);
#pragma unroll
            for (int i = 0; i < 4; ++i) { const f32x4 gg = *(const f32x4*)(g + (lane + 64 * i) * 4), o = v[i] * rstd * gg;
                unsigned long long w = (unsigned long long)ge::cvt_pk_bf16(o[0], o[1]) | ((unsigned long long)ge::cvt_pk_bf16(o[2], o[3]) << 32);
                *(unsigned long long*)(dst + (lane + 64 * i) * 4) = w; }
        }
    }
    grid.sync();
    {
        ge::SchedProj S; S.o.init(64, 31, G, bid); S.XN = (const char*)p_XN; S.WINT = (const char*)p_WINT; S.MEMN = (const char*)p_MEMN; S.WKVT = (const char*)p_WKVT;
        ge::EpiProj E; E.hook_t = -1; E.RKV = p_RKV; E.GATES = p_GATES; E.AQKV = p_AQKV; E.LORA = p_LORA; E.KV = p_KV;
        ge::gemm_phase<ge::EpiProj, ge::SchedProj, true>(ldsl, D, D, 16, S, E);
    }
    xcd_barrier(bar);
    if (bid < 32) sc::scan_bh(a, ldsl, bid >> 4, bid & 15, 0, SEQ / 64);
    else {
        if (bid < 96) {
            const bool isw = bid < 64; const int u = (bid - 32) & 31, pm = u >> 2, pn = u & 3;
            ge::SchedOne S; S.has = true; S.u.pm = pm; S.u.pn = pn;
            S.u.A = isw ? (const char*)(p_KV + (size_t)((pm >> 2) * 256) * 2048 + (pm & 3) * 256) : (const char*)(p_WOT + (size_t)((pm & 3) * 256) * 1024 + pn * 256);
            S.u.B = isw ? (const char*)(p_WQB + (size_t)(pn * 256) * 1024 + (pm & 3) * 256) : (const char*)(p_KV + (size_t)((pm >> 2) * 256) * 2048 + 1024 + pn * 256);
            ge::EpiScaleCol E; E.hook_t = -1; E.colscale = a.in[I_NX]; E.mul = isw ? 0.0625f : 1.f; E.use_cs = isw; E.out = isw ? p_WST : p_VWT; E.ld = 1024;
            ge::gemm_phase<ge::EpiScaleCol, ge::SchedOne, false>(ldsl, isw ? 2048 : 1024, isw ? 1024 : 2048, 4, S, E);
            __syncthreads();
        }
        dil_attn_naive(a, lds, (bid - 32) * NWAVES + wave, (G - 32) * NWAVES);
    }
    xcd_barrier(bar);
    {
        ge::Sched S; S.o.init(64, 4, G, bid); S.A = (const char*)p_ACAT; S.B = (const char*)p_PCATT; S.a_tile = (size_t)256 * KCAT * 2; S.b_tile = (size_t)256 * KCAT * 2; S.b_batch = 0;
        ge::EpiMerged E; E.hook_t = 16; E.GATES = p_GATES; E.MERGED = p_MERGED;
        ge::gemm_phase<ge::EpiMerged, ge::Sched, false>(ldsl, KCAT, KCAT, 20, S, E);
        __syncthreads();
        int tid2 = threadIdx.x; asm volatile("" : "+v"(tid2));
        const int lane2 = tid2 & 63, wave2 = tid2 >> 6; LAS float* scr2 = (LAS float*)(ldsl + wave2 * 16384);
        transpose_matrix(a.in[I_W1], 1024, 4096, p_W1T, D, 0, a.in[I_NFFN], scr2, lane2, bid * NWAVES + wave2, NGW);
        transpose_matrix(a.in[I_FW2], 4096, 1024, p_W2T, FF, 0, nullptr, scr2, lane2, bid * NWAVES + wave2, NGW);
    }
    xcd_barrier(bar);
    {
        ge::Sched S; S.o.init(64, 4, G, bid); S.A = (const char*)p_MERGED; S.B = (const char*)p_WOUTT; S.a_tile = (size_t)256 * D * 2; S.b_tile = (size_t)256 * D * 2; S.b_batch = 0;
        ge::EpiResid E; E.hook_t = -1; E.base = a.in[I_X]; E.out = p_OUT; E.hb = p_H1B; E.SS = p_SS1;
        ge::gemm_phase<ge::EpiResid, ge::Sched, false>(ldsl, D, D, 16, S, E);
    }
    xcd_barrier(bar);
    {
        ge::Sched S; S.o.init(64, 4, G, bid); S.A = (const char*)p_H1B; S.B = (const char*)p_WST; S.a_tile = (size_t)256 * D * 2; S.b_tile = (size_t)256 * D * 2; S.b_batch = (size_t)1024 * 1024 * 2;
        ge::EpiSoftmax E; E.hook_t = -1; E.SS = p_SS1; E.PROB = p_PROB;
        ge::gemm_phase<ge::EpiSoftmax, ge::Sched, false>(ldsl, D, D, 16, S, E);
    }
    xcd_barrier(bar);
    {
        ge::Sched S; S.o.init(64, 4, G, bid); S.A = (const char*)p_PROB; S.B = (const char*)p_VWT; S.a_tile = (size_t)256 * D * 2; S.b_tile = (size_t)256 * D * 2; S.b_batch = (size_t)1024 * 1024 * 2;
        ge::EpiResid E; E.hook_t = -1; E.base = p_OUT; E.out = p_OUT; E.hb = p_H2B; E.SS = p_SS2;
        ge::gemm_phase<ge::EpiResid, ge::Sched, false>(ldsl, D, D, 16, S, E);
    }
    xcd_barrier(bar);
    {
        ge::Sched S; S.o.init(64, 16, G, bid); S.A = (const char*)p_H2B; S.B = (const char*)p_W1T; S.a_tile = (size_t)256 * D * 2; S.b_tile = (size_t)256 * D * 2; S.b_batch = 0;
        ge::EpiRelu2 E; E.hook_t = -1; E.SS = p_SS2; E.ACT = p_ACT;
        ge::gemm_phase<ge::EpiRelu2, ge::Sched, true>(ldsl, D, D, 16, S, E);
    }
    xcd_barrier(bar);
    {
        ge::Sched S; S.o.init(64, 4, G, bid); S.A = (const char*)p_ACT; S.B = (const char*)p_W2T; S.a_tile = (size_t)256 * FF * 2; S.b_tile = (size_t)256 * FF * 2; S.b_batch = 0;
        ge::EpiResid E; E.hook_t = -1; E.base = p_OUT; E.out = p_OUT; E.hb = nullptr; E.SS = p_SS3;
        ge::gemm_phase<ge::EpiResid, ge::Sched, false>(ldsl, FF, FF, 64, S, E);
    }
    xcd_barrier(bar);
    {
        const float* g = a.in[I_NFIN];
        int tid3 = threadIdx.x; asm volatile("" : "+v"(tid3));
        const int lane = tid3 & 63;
        for (int r = bid * NWAVES + (tid3 >> 6); r < M; r += NGW) {
            const float rstd = ge::rstd_from_ss(p_SS3, (size_t)r);
#pragma unroll
            for (int i = 0; i < 4; ++i) { const size_t o = (size_t)r * D + (lane + 64 * i) * 4; const f32x4 v = *(const f32x4*)(p_OUT + o), gg = *(const f32x4*)(g + (lane + 64 * i) * 4); *(f32x4*)(p_OUT + o) = v * rstd * gg; }
        }
    }
}

extern "C" void kernel_launch(void* const* d_in, const int* in_sizes, int n_in, void* d_out, int out_size, void* d_ws, size_t ws_size, hipStream_t stream) {
    static int grid = 0;
    if (grid == 0) {
        if (n_in != 27 || out_size != M * D || ws_size < 256 * MiB) { fprintf(stderr, "kernel_launch: unexpected shapes (n_in %d out %d ws %zu)\n", n_in, out_size, ws_size); grid = -1; return; }
        int dev = 0, cus = 0, per_cu = 0;
        if (hipGetDevice(&dev) != hipSuccess || hipDeviceGetAttribute(&cus, hipDeviceAttributeMultiprocessorCount, dev) != hipSuccess) { fprintf(stderr, "kernel_launch: device query failed\n"); grid = -1; return; }
        if (hipFuncSetAttribute((const void*)mk_fwd, hipFuncAttributeMaxDynamicSharedMemorySize, LDS_BYTES) != hipSuccess) { fprintf(stderr, "kernel_launch: hipFuncSetAttribute failed\n"); grid = -1; return; }
        if (hipOccupancyMaxActiveBlocksPerMultiprocessor(&per_cu, (const void*)mk_fwd, NTHREADS, LDS_BYTES) != hipSuccess || per_cu < 1) { fprintf(stderr, "kernel_launch: occupancy query says %d blocks per CU\n", per_cu); per_cu = 1; }
        (void)hipGetLastError();
        grid = cus;
        if (grid != 256) fprintf(stderr, "kernel_launch: %d CUs; this kernel is built for 256\n", grid);
    }
    if (grid < 0) return;
    (void)hipMemsetAsync((char*)d_ws + WS_CTL, 0, 64 * 1024, stream);
    Args a{};
    for (int i = 0; i < 27; ++i) a.in[i] = (const float*)d_in[i];
    a.out = (float*)d_out; a.ws = (unsigned char*)d_ws;
    void* kargs[] = {&a};
    hipError_t e = hipLaunchCooperativeKernel((const void*)mk_fwd, dim3(grid), dim3(NTHREADS), kargs, LDS_BYTES, stream);
    if (e != hipSuccess) fprintf(stderr, "kernel_launch: cooperative launch failed: %s (grid %d)\n", hipGetErrorString(e), grid);
}
```

```cpp
#include <hip/hip_runtime.h>
#include <hip/hip_cooperative_groups.h>
namespace cg = cooperative_groups;
#include <cstdint>
#include <cstdio>

typedef unsigned short bf16_t;
typedef float f32x4 __attribute__((ext_vector_type(4)));

constexpr int BATCH = 2, SEQ = 8192, M = BATCH * SEQ, D = 1024;
constexpr int NIN = 7712;
constexpr int C_LORA = 3072, C_AQ = 3360, C_GATE = 5664;
constexpr int NLORA = 288, NAQKV = 2304, NGATE = 2048, NRKV = 3072;
constexpr int MEMLEN = 256, FF = 4096, KCAT = 1280;
constexpr int CH = 32;

constexpr size_t KiB = 1024, MiB = 1024 * 1024;
constexpr size_t WS_CTL = 0;
constexpr size_t WS_LW2T = 1 * MiB;
constexpr size_t WS_LA2T = 1 * MiB + 128 * KiB;
constexpr size_t WS_LG2T = 1 * MiB + 256 * KiB;
constexpr size_t WS_WINT = 2 * MiB;
constexpr size_t WS_XN = 17 * MiB + 512 * KiB;
constexpr size_t WS_MEMN = 49 * MiB + 512 * KiB;
constexpr size_t WS_WKVT = 50 * MiB + 512 * KiB;
constexpr size_t WS_ACAT = WS_XN;
constexpr size_t WS_RKV = 57 * MiB + 512 * KiB;
constexpr size_t WS_LORA = 153 * MiB + 512 * KiB;
constexpr size_t WS_AQKV = 162 * MiB + 512 * KiB;
constexpr size_t WS_PCATT = 234 * MiB + 512 * KiB;
constexpr size_t WS_WOUTT = 237 * MiB;
constexpr size_t WS_WST = 239 * MiB;
constexpr size_t WS_VWT = 243 * MiB;
constexpr size_t WS_WQB = 247 * MiB;
constexpr size_t WS_WOT = 249 * MiB;
constexpr size_t WS_KV = 251 * MiB;
constexpr size_t WS_SS1 = 253 * MiB;
constexpr size_t WS_SS2 = 254 * MiB;
constexpr size_t WS_SS3 = 255 * MiB;
constexpr size_t WS_W1T = 57 * MiB + 512 * KiB;
constexpr size_t WS_W2T = 65 * MiB + 512 * KiB;
constexpr size_t WS_H2B = 73 * MiB + 512 * KiB;
constexpr size_t WS_MERGED = 105 * MiB + 512 * KiB;
constexpr size_t WS_H1B = 137 * MiB + 512 * KiB;
constexpr size_t WS_PROB = 169 * MiB + 512 * KiB;
constexpr size_t WS_ACT = 105 * MiB + 512 * KiB;

constexpr int NTHREADS = 512, NWAVES = 8;
constexpr int LDS_BYTES = 155648, LDSCTL_OFF = 151552;

__device__ __forceinline__ float bf2f(bf16_t v) { return __uint_as_float(((unsigned)v) << 16); }
__device__ __forceinline__ bf16_t f2bf(float f) { unsigned u = __float_as_uint(f); return (bf16_t)((u + 0x7fffu + ((u >> 16) & 1u)) >> 16); }
__device__ __forceinline__ float sigmoidf_(float x) { return 1.f / (1.f + __expf(-x)); }
__device__ __forceinline__ float wave_sum(float v) {
#pragma unroll
    for (int o = 1; o < 64; o <<= 1) v += __shfl_xor(v, o);
    return v;
}
__device__ __forceinline__ float wave_max(float v) {
#pragma unroll
    for (int o = 1; o < 64; o <<= 1) v = fmaxf(v, __shfl_xor(v, o));
    return v;
}

struct Args {
    const float* in[27];
    float* out;
    unsigned char* ws;
    int ph_lo, ph_hi;
};

enum { I_X = 0, I_MEM, I_NMIX, I_WIN, I_MU, I_W0, I_W2, I_A0, I_A2, I_G2, I_KK, I_KA, I_RK, I_GNW, I_GNB, I_PRWKV, I_PATTN, I_WOUT,
       I_NX, I_NMEM, I_WQ, I_WKV, I_WO, I_NFFN, I_W1, I_FW2, I_NFIN };

__device__ __forceinline__ void scan_naive(const Args& a, float* lds, int bh) {
    const int b = bh >> 4, h = bh & 15;
    const int tid = threadIdx.x, lane = tid & 63, wave = tid >> 6;
    const bf16_t* RKV = (const bf16_t*)(a.ws + WS_RKV);
    const bf16_t* LORA = (const bf16_t*)(a.ws + WS_LORA);
    bf16_t* ACAT = (bf16_t*)(a.ws + WS_ACAT);
    const float* mu = a.in[I_MU];
    float* actW = lds;
    float* actA = actW + CH * 64;
    float* actG = actA + CH * 64;
    float* Wd = actG + CH * 160;
    float* Kk = Wd + CH * 64;
    float* Aa = Kk + CH * 64;
    float* Bb = Aa + CH * 64;
    float* Rr = Bb + CH * 64;
    float* Vv = Rr + CH * 64;
    float* Gg = Vv + CH * 64;
    float* Yy = Gg + CH * 64;
    float* bon = Yy + CH * 64;
    const int hj0 = h * 64;
    float st[8];
#pragma unroll
    for (int e = 0; e < 8; ++e) st[e] = 0.f;
    const int row_i = wave * 8 + (lane >> 3), cg = lane & 7;
    for (int c0 = 0; c0 < SEQ; c0 += CH) {
        const size_t m0 = (size_t)b * SEQ + c0;
        __syncthreads();
        for (int idx = tid; idx < CH * NLORA; idx += NTHREADS) {
            const int t = idx / NLORA, c = idx % NLORA;
            const float cur = bf2f(LORA[(m0 + t) * NLORA + c]);
            const float prev = (c0 + t == 0) ? 0.f : bf2f(LORA[(m0 + t - 1) * NLORA + c]);
            const float s = cur + mu[C_LORA + c] * (prev - cur);
            if (c < 64) actW[t * 64 + c] = tanhf(s);
            else if (c < 128) actA[t * 64 + c - 64] = s;
            else actG[t * 160 + c - 128] = sigmoidf_(s);
        }
        for (int idx = tid; idx < CH * 64; idx += NTHREADS) {
            const int t = idx >> 6, j = idx & 63;
            const bool first = (c0 + t == 0);
#pragma unroll
            for (int q = 0; q < 3; ++q) {
                const int col = q * 1024 + hj0 + j;
                const float cur = bf2f(RKV[(m0 + t) * NRKV + col]);
                const float prev = first ? 0.f : bf2f(RKV[(m0 + t - 1) * NRKV + col]);
                const float s = cur + mu[col] * (prev - cur);
                if (q == 0) Rr[idx] = s; else if (q == 1) Kk[idx] = s; else Vv[idx] = s;
            }
        }
        __syncthreads();
        for (int idx = tid; idx < CH * 64; idx += NTHREADS) {
            const int t = idx >> 6, j = idx & 63, hj = hj0 + j;
            float wp = a.in[I_W0][hj], ap = a.in[I_A0][hj], g = 0.f;
            for (int c = 0; c < 64; ++c) { wp += actW[t * 64 + c] * a.in[I_W2][c * 1024 + hj]; ap += actA[t * 64 + c] * a.in[I_A2][c * 1024 + hj]; }
            for (int c = 0; c < 160; ++c) g += actG[t * 160 + c] * a.in[I_G2][c * 1024 + hj];
            const float z = -wp;
            const float sp = fmaxf(z, 0.f) + log1pf(__expf(-fabsf(z)));
            const float wlog = -sp - 0.5f;
            Wd[idx] = __expf(-__expf(wlog));
            Aa[idx] = sigmoidf_(ap);
            Gg[idx] = g;
        }
        __syncthreads();
#pragma unroll
        for (int q = 0; q < 4; ++q) {
            const int t = wave * 4 + q, idx = t * 64 + lane, hj = hj0 + lane;
            const float pk = Kk[idx], alr = Aa[idx];
            const float kr = pk * a.in[I_KK][hj];
            const float ss = wave_sum(kr * kr);
            const float kk = kr / fmaxf(sqrtf(ss), 1e-12f);
            const float kmod = pk * (1.f + (alr - 1.f) * a.in[I_KA][hj]);
            const float bs = wave_sum(Rr[idx] * kmod * a.in[I_RK][hj]);
            Aa[idx] = -kk; Bb[idx] = kk * alr; Kk[idx] = kmod;
            if (lane == 0) bon[t] = bs;
        }
        __syncthreads();
        for (int t = 0; t < CH; ++t) {
            const float* ap = Aa + t * 64 + cg * 8; const float* wp = Wd + t * 64 + cg * 8; const float* kp = Kk + t * 64 + cg * 8;
            const float* bp = Bb + t * 64 + cg * 8; const float* rp = Rr + t * 64 + cg * 8;
            float sa = 0.f;
#pragma unroll
            for (int e = 0; e < 8; ++e) sa += st[e] * ap[e];
            sa += __shfl_xor(sa, 1); sa += __shfl_xor(sa, 2); sa += __shfl_xor(sa, 4);
            const float vi = Vv[t * 64 + row_i];
            float y = 0.f;
#pragma unroll
            for (int e = 0; e < 8; ++e) { st[e] = st[e] * wp[e] + sa * bp[e] + vi * kp[e]; y += st[e] * rp[e]; }
            y += __shfl_xor(y, 1); y += __shfl_xor(y, 2); y += __shfl_xor(y, 4);
            if (cg == 0) Yy[t * 64 + row_i] = y;
        }
        __syncthreads();
#pragma unroll
        for (int q = 0; q < 4; ++q) {
            const int t = wave * 4 + q, idx = t * 64 + lane, hi = hj0 + lane;
            const float y = Yy[idx];
            const float mean = wave_sum(y) * (1.f / 64.f);
            const float dy = y - mean;
            const float var = wave_sum(dy * dy) * (1.f / 64.f);
            const float yn = dy * rsqrtf(var + 64.f * 1e-5f) * a.in[I_GNW][hi] + a.in[I_GNB][hi];
            const float o = (yn + bon[t] * Vv[idx]) * Gg[idx];
            ACAT[(m0 + t) * KCAT + hi] = f2bf(o);
        }
    }
}

__device__ __forceinline__ void dil_attn_naive(const Args& a, float* lds, int wave_gid, int nwaves_total) {
    const int lane = threadIdx.x & 63, wave = threadIdx.x >> 6;
    const bf16_t* AQ = (const bf16_t*)(a.ws + WS_AQKV);
    bf16_t* ACAT = (bf16_t*)(a.ws + WS_ACAT);
    float* pbuf = lds + wave * 640;
    float* qs = pbuf + 448;
    for (int task = wave_gid; task < M * 4; task += nwaves_total) {
        const int m = task >> 2, s = task & 3, p = m & (SEQ - 1);
#pragma unroll
        for (int g = 0; g < 3; ++g) qs[g * 64 + lane] = bf2f(AQ[(size_t)m * NAQKV + (g * 4 + s) * 64 + lane]);
        float sc[7];
        float mx = -INFINITY;
#pragma unroll
        for (int i = 0; i < 7; ++i) {
            const int idx = lane + i * 64;
            float v = -INFINITY;
            if (idx < 387) {
                const int g = idx / 129, stp = idx % 129, dil = (g == 0) ? 1 : (g == 1 ? 4 : 16), hd = g * 4 + s;
                if (stp * dil <= p) {
                    const bf16_t* kr = AQ + (size_t)(m - stp * dil) * NAQKV + 768 + hd * 64;
                    float dot = 0.f;
                    for (int c = 0; c < 64; ++c) dot += qs[g * 64 + c] * bf2f(kr[c]);
                    const float slope = exp2f(-8.f * (float)(hd + 1) / 12.f);
                    v = dot * 0.125f - slope * (float)(stp * dil);
                }
            }
            sc[i] = v; mx = fmaxf(mx, v);
        }
        mx = wave_max(mx);
        float sum = 0.f;
#pragma unroll
        for (int i = 0; i < 7; ++i) { const int idx = lane + i * 64; const float e = (sc[i] == -INFINITY) ? 0.f : __expf(sc[i] - mx); sum += e; if (idx < 448) pbuf[idx] = e; }
        sum = wave_sum(sum);
        float acc = 0.f;
        for (int idx = 0; idx < 387; ++idx) {
            const int g = idx / 129, stp = idx % 129, dil = (g == 0) ? 1 : (g == 1 ? 4 : 16), hd = g * 4 + s;
            if (stp * dil <= p) acc += pbuf[idx] * bf2f(AQ[(size_t)(m - stp * dil) * NAQKV + 1536 + hd * 64 + lane]);
        }
        ACAT[(size_t)m * KCAT + 1024 + s * 64 + lane] = f2bf(acc / sum);
    }
}

#define LAS __attribute__((address_space(3)))
typedef short bf16x8 __attribute__((ext_vector_type(8)));
typedef unsigned u32x4 __attribute__((ext_vector_type(4)));
namespace ge {
constexpr int BM = 256, BK = 64, HALF = 128, HTB = HALF * BK * 2, STAGE_BYTES = 8 * HTB, NXCD = 8, WGM = 8;
__host__ __device__ __forceinline__ int lds_byte(int r, int c) { const int st = (r >> 4) * 2 + (c >> 5), rr = r & 15, cc = c & 31, ob = rr * 64 + cc * 2; return st * 1024 + (ob ^ (((ob >> 9) & 1) << 5)); }
__host__ __device__ __forceinline__ void stage_rc(int b, int& R, int& C) { const int st = b / 1024, sb = b % 1024, swz = sb ^ (((sb >> 9) & 1) << 5); R = (st >> 1) * 16 + swz / 64; C = (st & 1) * 32 + (swz % 64) / 2; }
__host__ __device__ __forceinline__ int perm32(int rho) { const int n = rho >> 4, i = rho & 15; return 8 * (i >> 2) + 4 * n + (i & 3); }

struct Unit { const char* A; const char* B; int pm, pn; };

struct Order {
    int nM, nN, nwg, G, c;
    __device__ __forceinline__ void init(int nM_, int nN_, int G_, int c_) { nM = nM_; nN = nN_; nwg = nM * nN; G = G_; c = c_; }
    __device__ __forceinline__ bool next(int i, int& pm, int& pn) const {
        const long L = (long)i * G + c; if (L >= nwg) return false;
        int wgid = (int)L; { const int q = nwg / NXCD, r = nwg % NXCD, xcd = wgid % NXCD, off = wgid / NXCD; wgid = (xcd < r ? xcd * (q + 1) : r * (q + 1) + (xcd - r) * q) + off; }
        const int nig = WGM * nN, gid = wgid / nig, fm = gid * WGM, gsz = (nM - fm) < WGM ? (nM - fm) : WGM;
        pm = fm + ((wgid % nig) % gsz); pn = (wgid % nig) / gsz; return true;
    }
};
struct Sched {
    Order o; const char* A; const char* B; size_t a_tile, b_tile, b_batch;
    __device__ __forceinline__ bool next(int i, Unit& u) const {
        int pm, pn; if (!o.next(i, pm, pn)) return false;
        u.pm = pm; u.pn = pn; u.A = A + (size_t)pm * a_tile; u.B = B + (size_t)pn * b_tile + (size_t)(pm >> 5) * b_batch; return true;
    }
};

typedef float f32x2_t __attribute__((ext_vector_type(2))); typedef __bf16 bf16x2_t __attribute__((ext_vector_type(2)));
__device__ __forceinline__ unsigned cvt_pk_bf16(float lo, float hi) { f32x2_t v = {lo, hi}; bf16x2_t b = __builtin_convertvector(v, bf16x2_t); return __builtin_bit_cast(unsigned, b); }
__device__ __forceinline__ u32x4 pack8(const f32x4 v0, const f32x4 v1) { u32x4 w; w.x = cvt_pk_bf16(v0[0], v0[1]); w.y = cvt_pk_bf16(v0[2], v0[3]); w.z = cvt_pk_bf16(v1[0], v1[1]); w.w = cvt_pk_bf16(v1[2], v1[3]); return w; }
__device__ __forceinline__ void unpack8(const u32x4 w, f32x4& v0, f32x4& v1) {
    v0[0] = __uint_as_float(w.x << 16); v0[1] = __uint_as_float(w.x & 0xffff0000u); v0[2] = __uint_as_float(w.y << 16); v0[3] = __uint_as_float(w.y & 0xffff0000u);
    v1[0] = __uint_as_float(w.z << 16); v1[1] = __uint_as_float(w.z & 0xffff0000u); v1[2] = __uint_as_float(w.w << 16); v1[3] = __uint_as_float(w.w & 0xffff0000u);
}

template <class Epi, class SchedT, bool ALIGN_EPI>
__device__ __forceinline__ void gemm_phase(LAS unsigned char* lds, const int lda, const int ldb, const int nt, const SchedT& S, const Epi& E) {
    int tid_o = threadIdx.x; asm volatile("" : "+v"(tid_o));
    const int tid = tid_o, wid = __builtin_amdgcn_readfirstlane(tid >> 6), lane = tid & 63, wr = wid >> 2, wc = wid & 3, fr = lane & 15, fq = lane >> 4;
    unsigned voffA[2], voffB[2];
#pragma unroll
    for (int i = 0; i < 2; ++i) { int R, C; stage_rc(tid * 16 + i * 8192, R, C); const int Rb = (R & ~31) + perm32(R & 31);
        voffA[i] = (unsigned)(R * lda + C) * 2u; voffB[i] = (unsigned)(Rb * ldb + C) * 2u; }
    const size_t kstep = (size_t)(BK * 2);
    const size_t hstepA = (size_t)HALF * lda * 2, hstepB = (size_t)HALF * ldb * 2;
    const unsigned ldsw = (unsigned)wid * 1024u;
    const int aoff = lds_byte(wr * 64 + fr, fq * 8), boff = lds_byte(wc * 32 + fr, fq * 8);
#define GE_SA(b, h) (((b) * 2 + (h)) * ge::HTB)
#define GE_SB(b, h) ((4 + (b) * 2 + (h)) * ge::HTB)
#define GE_STAGE(bufoff, gbase, voff) do { _Pragma("unroll") for (int _i = 0; _i < 2; ++_i) \
        __builtin_amdgcn_global_load_lds((const unsigned*)((const char*)(gbase) + (voff)[_i]), (LAS unsigned*)(lds + (bufoff) + ldsw + _i * 8192), 16, 0, 0); } while (0)
#define GE_LDA(dst, b, h) do { _Pragma("unroll") for (int m = 0; m < 4; ++m) _Pragma("unroll") for (int k = 0; k < 2; ++k) dst[m][k] = *(const LAS bf16x8*)(lds + GE_SA(b, h) + aoff + m * 2048 + k * 1024); } while (0)
#define GE_LDB(dst, b, h) do { _Pragma("unroll") for (int n = 0; n < 2; ++n) _Pragma("unroll") for (int k = 0; k < 2; ++k) dst[n][k] = *(const LAS bf16x8*)(lds + GE_SB(b, h) + boff + n * 2048 + k * 1024); } while (0)
#define GE_MMA(ai, bj, At, Bt) do { __builtin_amdgcn_s_setprio(1); _Pragma("unroll") for (int m = 0; m < 4; ++m) _Pragma("unroll") for (int n = 0; n < 2; ++n) _Pragma("unroll") for (int k = 0; k < 2; ++k) \
        acc[ai][bj][m][n] = __builtin_amdgcn_mfma_f32_16x16x32_bf16(Bt[n][k], At[m][k], acc[ai][bj][m][n], 0, 0, 0); __builtin_amdgcn_s_setprio(0); } while (0)
#define GE_WAIT_V(n) asm volatile("s_waitcnt vmcnt(" #n ")" ::: "memory")
#define GE_WAIT_L(n) asm volatile("s_waitcnt lgkmcnt(" #n ")" ::: "memory")
#define GE_BAR __builtin_amdgcn_s_barrier()
#define GE_SCHED __builtin_amdgcn_sched_barrier(0)
    Unit cur, nxt; int ui = 0;
    if (!S.next(0, cur)) return;
    f32x4 acc[2][2][4][2];
#pragma unroll
    for (int a = 0; a < 2; ++a)
#pragma unroll
        for (int b = 0; b < 2; ++b)
#pragma unroll
            for (int m = 0; m < 4; ++m)
#pragma unroll
                for (int n = 0; n < 2; ++n) acc[a][b][m][n] = (f32x4){0.f, 0.f, 0.f, 0.f};
    bf16x8 At[4][2], B0[2][2], B1[2][2];
    const char* cA = cur.A; const char* cB = cur.B;
    GE_STAGE(GE_SB(0, 0), cB, voffB); GE_STAGE(GE_SB(0, 1), cB + hstepB, voffB); GE_STAGE(GE_SA(0, 0), cA, voffA); GE_STAGE(GE_SA(0, 1), cA + hstepA, voffA);
    if (wr == 1) GE_BAR;
    GE_WAIT_V(2); GE_BAR;
    GE_STAGE(GE_SB(1, 0), cB + kstep, voffB); GE_STAGE(GE_SA(1, 0), cA + kstep, voffA); GE_STAGE(GE_SB(1, 1), cB + hstepB + kstep, voffB);
    GE_WAIT_V(6); GE_BAR;
    for (;;) {
        const bool has_next = S.next(ui + 1, nxt);
        const char* nA = has_next ? nxt.A : cA; const char* nB = has_next ? nxt.B : cB;
        for (int t = 0; t < nt; t += 2) {
            if constexpr (Epi::HOOK) { if (t == E.hook_t) E.hook(acc, cur, wr, wc, fr, fq); }
            const bool last = (t == nt - 2);
            const char* a1 = cA + (size_t)(t + 1) * kstep;
            const char* a2 = last ? nA : cA + (size_t)(t + 2) * kstep; const char* b2 = last ? nB : cB + (size_t)(t + 2) * kstep;
            const char* a3 = a2 + kstep; const char* b3 = b2 + kstep;
            GE_LDB(B0, 0, 0); GE_LDB(B1, 0, 1); GE_SCHED; GE_LDA(At, 0, 0); GE_STAGE(GE_SA(1, 1), a1 + hstepA, voffA);
            GE_WAIT_V(8); GE_WAIT_L(0); GE_BAR; GE_MMA(0, 0, At, B0); GE_MMA(0, 1, At, B1); GE_BAR; GE_SCHED;
            GE_LDA(At, 0, 1); GE_STAGE(GE_SB(0, 0), b2, voffB); GE_STAGE(GE_SB(0, 1), b2 + hstepB, voffB); GE_STAGE(GE_SA(0, 0), a2, voffA);
            GE_WAIT_V(8); GE_WAIT_L(0); GE_BAR; GE_MMA(1, 0, At, B0); GE_MMA(1, 1, At, B1); GE_BAR; GE_SCHED;
            GE_LDB(B0, 1, 0); GE_LDB(B1, 1, 1); GE_SCHED; GE_LDA(At, 1, 0); GE_STAGE(GE_SA(0, 1), a2 + hstepA, voffA);
            GE_WAIT_V(8); GE_WAIT_L(0); GE_BAR; GE_MMA(0, 0, At, B0); GE_MMA(0, 1, At, B1); GE_BAR; GE_SCHED;
            GE_LDA(At, 1, 1); GE_STAGE(GE_SB(1, 0), b3, voffB); GE_STAGE(GE_SB(1, 1), b3 + hstepB, voffB); GE_STAGE(GE_SA(1, 0), a3, voffA);
            GE_WAIT_V(8); GE_WAIT_L(0); GE_BAR; GE_MMA(1, 0, At, B0); GE_MMA(1, 1, At, B1); GE_BAR; GE_SCHED;
        }
        if constexpr (ALIGN_EPI) { if (wr == 0) GE_BAR; }
        if constexpr (!Epi::AFTER_DRAIN) { E(acc, cur, wr, wc, fr, fq); }
        if (!has_next) break;
#pragma unroll
        for (int a = 0; a < 2; ++a)
#pragma unroll
            for (int b = 0; b < 2; ++b)
#pragma unroll
                for (int m = 0; m < 4; ++m)
#pragma unroll
                    for (int n = 0; n < 2; ++n) acc[a][b][m][n] = (f32x4){0.f, 0.f, 0.f, 0.f};
        cur = nxt; cA = nA; cB = nB; ++ui;
        if constexpr (ALIGN_EPI) { if (wr == 1) GE_BAR; }
    }
    GE_WAIT_V(0);
    if constexpr (!ALIGN_EPI) { if (wr == 0) GE_BAR; }
    GE_BAR;
    if constexpr (Epi::AFTER_DRAIN) { E.fused(acc, cur, wr, wc, fr, fq, lds, wid, lane); }
#undef GE_SA
#undef GE_SB
#undef GE_STAGE
#undef GE_LDA
#undef GE_LDB
#undef GE_MMA
#undef GE_WAIT_V
#undef GE_WAIT_L
#undef GE_BAR
#undef GE_SCHED
}

#define GE_ROW(ai, m) (u.pm * 256 + (ai) * 128 + wr * 64 + (m) * 16 + fr)
#define GE_COL(bj) (u.pn * 256 + (bj) * 128 + wc * 32 + 8 * fq)
typedef f32x4 Acc[2][2][4][2];

__device__ __forceinline__ float fast_sigmoid(float x) { return __builtin_amdgcn_rcpf(1.f + __expf(-x)); }

struct EpiProj {
    static constexpr bool AFTER_DRAIN = false, HOOK = false; int hook_t;
    bf16_t *RKV, *GATES, *AQKV, *LORA, *KV;
    __device__ __forceinline__ void hook(Acc&, const Unit&, int, int, int, int) const {}
    __device__ __forceinline__ void operator()(const Acc& acc, const Unit& u, int wr, int wc, int fr, int fq) const {
        const int pn = u.pn; bf16_t* base; int ld, cbase, climit = 1 << 30; bool sig = false;
        if (pn >= 100) { base = KV; ld = 2048; cbase = (pn - 100) * 256; }
        else if (pn < 12) { base = RKV; ld = NRKV; cbase = pn * 256; }
        else if (pn < 20) { base = GATES; ld = NGATE; cbase = (pn - 12) * 256; sig = true; }
        else if (pn < 29) { base = AQKV; ld = NAQKV; cbase = (pn - 20) * 256; }
        else { base = LORA; ld = NLORA; cbase = (pn - 29) * 256; climit = NLORA; }
#pragma unroll
        for (int ai = 0; ai < 2; ++ai)
#pragma unroll
            for (int m = 0; m < 4; ++m) { bf16_t* rowp = base + (size_t)GE_ROW(ai, m) * ld;
#pragma unroll
                for (int bj = 0; bj < 2; ++bj) { const int c = cbase + bj * 128 + wc * 32 + 8 * fq;
                    if (c < climit) { f32x4 v0 = acc[ai][bj][m][0], v1 = acc[ai][bj][m][1];
                        if (sig) {
#pragma unroll
                            for (int j = 0; j < 4; ++j) { v0[j] = fast_sigmoid(v0[j]); v1[j] = fast_sigmoid(v1[j]); } }
                        *(u32x4*)(rowp + c) = pack8(v0, v1); } } }
    }
};
struct EpiMerged {
    static constexpr bool AFTER_DRAIN = false, HOOK = true; int hook_t;
    const bf16_t* GATES; bf16_t* MERGED;
    __device__ __forceinline__ void hook(Acc& acc, const Unit& u, int wr, int wc, int fr, int fq) const {
#pragma unroll
        for (int ai = 0; ai < 2; ++ai)
#pragma unroll
            for (int m = 0; m < 4; ++m) { const bf16_t* g = GATES + (size_t)GE_ROW(ai, m) * NGATE;
#pragma unroll
                for (int bj = 0; bj < 2; ++bj) { const int c = GE_COL(bj); f32x4 r0, r1, a0, a1;
                    unpack8(*(const u32x4*)(g + c), r0, r1); unpack8(*(const u32x4*)(g + 1024 + c), a0, a1);
#pragma unroll
                    for (int j = 0; j < 4; ++j) { acc[ai][bj][m][0][j] *= r0[j] * __builtin_amdgcn_rcpf(a0[j]); acc[ai][bj][m][1][j] *= r1[j] * __builtin_amdgcn_rcpf(a1[j]); } } }
    }
    __device__ __forceinline__ void operator()(const Acc& acc, const Unit& u, int wr, int wc, int fr, int fq) const {
#pragma unroll
        for (int ai = 0; ai < 2; ++ai)
#pragma unroll
            for (int m = 0; m < 4; ++m) { const size_t r = (size_t)GE_ROW(ai, m);
#pragma unroll
                for (int bj = 0; bj < 2; ++bj) { const int c = GE_COL(bj); f32x4 a0, a1;
                    unpack8(*(const u32x4*)(GATES + r * NGATE + 1024 + c), a0, a1);
                    *(u32x4*)(MERGED + r * D + c) = pack8(acc[ai][bj][m][0] * a0, acc[ai][bj][m][1] * a1); } }
    }
};
struct EpiResid {
    static constexpr bool AFTER_DRAIN = false, HOOK = false; int hook_t;
    const float* base; float* out; bf16_t* hb; float* SS;
    __device__ __forceinline__ void hook(Acc&, const Unit&, int, int, int, int) const {}
    __device__ __forceinline__ void operator()(const Acc& acc, const Unit& u, int wr, int wc, int fr, int fq) const {
#pragma unroll
        for (int ai = 0; ai < 2; ++ai)
#pragma unroll
            for (int m = 0; m < 4; ++m) { const size_t r = (size_t)GE_ROW(ai, m); float ss = 0.f;
#pragma unroll
                for (int bj = 0; bj < 2; ++bj) { const int c = GE_COL(bj);
                    const f32x4 o0 = *(const f32x4*)(base + r * D + c) + acc[ai][bj][m][0], o1 = *(const f32x4*)(base + r * D + c + 4) + acc[ai][bj][m][1];
                    *(f32x4*)(out + r * D + c) = o0; *(f32x4*)(out + r * D + c + 4) = o1;
                    ss += (o0[0] * o0[0] + o0[1] * o0[1]) + (o0[2] * o0[2] + o0[3] * o0[3]) + (o1[0] * o1[0] + o1[1] * o1[1]) + (o1[2] * o1[2] + o1[3] * o1[3]);
                    if (hb) *(u32x4*)(hb + r * D + c) = pack8(o0, o1); }
                ss += __shfl_xor(ss, 16); ss += __shfl_xor(ss, 32);
                if (fq == 0) SS[r * 16 + u.pn * 4 + wc] = ss; }
    }
};
__device__ __forceinline__ float rstd_from_ss(const float* SS, size_t r) {
    const f32x4 a = *(const f32x4*)(SS + r * 16), b = *(const f32x4*)(SS + r * 16 + 4), c = *(const f32x4*)(SS + r * 16 + 8), d = *(const f32x4*)(SS + r * 16 + 12);
    const float s = ((a[0] + a[1]) + (a[2] + a[3])) + ((b[0] + b[1]) + (b[2] + b[3])) + ((c[0] + c[1]) + (c[2] + c[3])) + ((d[0] + d[1]) + (d[2] + d[3]));
    return rsqrtf(s * (1.f / D) + 1e-6f);
}
struct EpiRelu2 {
    static constexpr bool AFTER_DRAIN = false, HOOK = false; int hook_t;
    const float* SS; bf16_t* ACT;
    __device__ __forceinline__ void hook(Acc&, const Unit&, int, int, int, int) const {}
    __device__ __forceinline__ void operator()(const Acc& acc, const Unit& u, int wr, int wc, int fr, int fq) const {
#pragma unroll
        for (int ai = 0; ai < 2; ++ai)
#pragma unroll
            for (int m = 0; m < 4; ++m) { const size_t r = (size_t)GE_ROW(ai, m); const float rstd = rstd_from_ss(SS, r);
#pragma unroll
                for (int bj = 0; bj < 2; ++bj) { const int c = GE_COL(bj); f32x4 v0 = acc[ai][bj][m][0] * rstd, v1 = acc[ai][bj][m][1] * rstd;
#pragma unroll
                    for (int j = 0; j < 4; ++j) { const float a = fmaxf(v0[j], 0.f), b = fmaxf(v1[j], 0.f); v0[j] = a * a; v1[j] = b * b; }
                    *(u32x4*)(ACT + r * FF + c) = pack8(v0, v1); } }
    }
};
struct EpiSoftmax {
    static constexpr bool AFTER_DRAIN = true, HOOK = false; int hook_t;
    const float* SS; bf16_t* PROB;
    __device__ __forceinline__ void hook(Acc&, const Unit&, int, int, int, int) const {}
    __device__ __forceinline__ void operator()(const Acc&, const Unit&, int, int, int, int) const {}
    __device__ __forceinline__ void fused(Acc& acc, const Unit& u, int wr, int wc, int fr, int fq, LAS unsigned char* lds, int wid, int lane) const {
        LAS float* Pm = (LAS float*)lds; LAS float* Ps = Pm + 1024;
#pragma unroll
        for (int ai = 0; ai < 2; ++ai)
#pragma unroll
            for (int m = 0; m < 4; ++m) { const float rstd = rstd_from_ss(SS, (size_t)GE_ROW(ai, m)); float mx = -INFINITY;
#pragma unroll
                for (int bj = 0; bj < 2; ++bj)
#pragma unroll
                    for (int n = 0; n < 2; ++n)
#pragma unroll
                        for (int j = 0; j < 4; ++j) { const float s = acc[ai][bj][m][n][j] * rstd; acc[ai][bj][m][n][j] = s; mx = fmaxf(mx, s); }
                mx = fmaxf(mx, __shfl_xor(mx, 16)); mx = fmaxf(mx, __shfl_xor(mx, 32));
                if (fq == 0) Pm[(ai * 128 + wr * 64 + m * 16 + fr) * 4 + wc] = mx; }
        asm volatile("s_waitcnt lgkmcnt(0)" ::: "memory"); __builtin_amdgcn_s_barrier(); asm volatile("" ::: "memory");
#pragma unroll
        for (int ai = 0; ai < 2; ++ai)
#pragma unroll
            for (int m = 0; m < 4; ++m) { const int rl = ai * 128 + wr * 64 + m * 16 + fr; const f32x4 pm4 = *(const LAS f32x4*)(Pm + rl * 4);
                const float mx = fmaxf(fmaxf(pm4[0], pm4[1]), fmaxf(pm4[2], pm4[3])) * 1.44269504f; float sum = 0.f;
#pragma unroll
                for (int bj = 0; bj < 2; ++bj)
#pragma unroll
                    for (int n = 0; n < 2; ++n)
#pragma unroll
                        for (int j = 0; j < 4; ++j) { const float e = __builtin_amdgcn_exp2f(acc[ai][bj][m][n][j] * 1.44269504f - mx); acc[ai][bj][m][n][j] = e; sum += e; }
                sum += __shfl_xor(sum, 16); sum += __shfl_xor(sum, 32);
                if (fq == 0) Ps[rl * 4 + wc] = sum; }
        asm volatile("s_waitcnt lgkmcnt(0)" ::: "memory"); __builtin_amdgcn_s_barrier(); asm volatile("" ::: "memory");
#pragma unroll
        for (int ai = 0; ai < 2; ++ai)
#pragma unroll
            for (int m = 0; m < 4; ++m) { const int rl = ai * 128 + wr * 64 + m * 16 + fr; const f32x4 ps4 = *(const LAS f32x4*)(Ps + rl * 4);
                const float inv = 1.f / ((ps4[0] + ps4[1]) + (ps4[2] + ps4[3])); const size_t r = (size_t)GE_ROW(ai, m);
#pragma unroll
                for (int bj = 0; bj < 2; ++bj) *(u32x4*)(PROB + r * D + GE_COL(bj)) = pack8(acc[ai][bj][m][0] * inv, acc[ai][bj][m][1] * inv); }
    }
};
}

__device__ __forceinline__ void transpose_item(const float* W, int ldw, int k0, int n0, bf16_t* WT, int ldt, int drow0, int dk0, const float* kscale, LAS float* scr, int lane) {
#pragma unroll 8
    for (int i = 0; i < 32; ++i) { const int kk = 2 * i + (lane >> 5); float v = W[(size_t)(k0 + kk) * ldw + n0 + (lane & 31)]; if (kscale) v *= kscale[k0 + kk]; scr[kk * 33 + (lane & 31)] = v; }
    asm volatile("s_waitcnt lgkmcnt(0)" ::: "memory");
    const int c = lane & 7;
#pragma unroll
    for (int j = 0; j < 4; ++j) { const int n = (lane >> 3) + 8 * j; const LAS float* s = scr + (8 * c) * 33 + n;
        u32x4 o; o.x = ge::cvt_pk_bf16(s[0 * 33], s[1 * 33]); o.y = ge::cvt_pk_bf16(s[2 * 33], s[3 * 33]); o.z = ge::cvt_pk_bf16(s[4 * 33], s[5 * 33]); o.w = ge::cvt_pk_bf16(s[6 * 33], s[7 * 33]);
        *(u32x4*)(WT + (size_t)(drow0 + n) * ldt + dk0 + k0 + 8 * c) = o; }
    asm volatile("s_waitcnt lgkmcnt(0)" ::: "memory");
}
__device__ __forceinline__ void transpose_matrix(const float* W, int K, int N, bf16_t* WT, int ldt, int dk0, const float* kscale, LAS float* scr, int lane, int gw, int NGW) {
    const int nblk = N / 32, items = (K / 64) * nblk;
    for (int it = gw; it < items; it += NGW) { const int kb = it / nblk, nb = it % nblk; transpose_item(W, N, kb * 64, nb * 32, WT, ldt, nb * 32, dk0, kscale, scr, lane); }
}
namespace ge {
struct EpiScaleCol {
    static constexpr bool AFTER_DRAIN = false, HOOK = false; int hook_t;
    const float* colscale; float mul; bool use_cs; bf16_t* out; int ld;
    __device__ __forceinline__ void hook(Acc&, const Unit&, int, int, int, int) const {}
    __device__ __forceinline__ void operator()(const Acc& acc, const Unit& u, int wr, int wc, int fr, int fq) const {
#pragma unroll
        for (int bj = 0; bj < 2; ++bj) { const int c = GE_COL(bj);
            f32x4 s0 = (f32x4){mul, mul, mul, mul}, s1 = s0;
            if (use_cs) { s0 = s0 * *(const f32x4*)(colscale + c); s1 = s1 * *(const f32x4*)(colscale + c + 4); }
#pragma unroll
            for (int ai = 0; ai < 2; ++ai)
#pragma unroll
                for (int m = 0; m < 4; ++m) *(u32x4*)(out + (size_t)GE_ROW(ai, m) * ld + c) = pack8(acc[ai][bj][m][0] * s0, acc[ai][bj][m][1] * s1); }
    }
};
struct SchedOne {
    bool has; Unit u;
    __device__ __forceinline__ bool next(int i, Unit& o) const { if (i > 0 || !has) return false; o = u; return true; }
};
struct SchedProj {
    Order o; const char* XN; const char* WINT; const char* MEMN; const char* WKVT;
    __device__ __forceinline__ bool next(int i, Unit& u) const {
        int pm, pn; if (o.next(i, pm, pn)) { u.pm = pm; u.pn = pn; u.A = XN + (size_t)pm * (256 * D * 2); u.B = WINT + (size_t)pn * (256 * D * 2); return true; }
        const long L = (long)i * o.G + o.c - o.nwg; if (L < 0 || L >= 16) return false;
        u.pm = (int)(L >> 3); u.pn = 100 + (int)(L & 7); u.A = MEMN + (size_t)u.pm * (256 * D * 2); u.B = WKVT + (size_t)(L & 7) * (256 * D * 2); return true;
    }
};
}

namespace sc {
constexpr int RS = 72, FS = 68, AL = 296;
constexpr int O_X = 0;
constexpr int O_LAK = 0, O_URB = 9216, O_URK = 18432, O_T = 27648;
constexpr int O_LW = 37888;
constexpr int O_AT = 55296, O_BT = 64512, O_KT = 73728, O_RT = 82944, O_BHT = 92160, O_KHT = 101376, O_VT = 110592, O_S = 119808, O_RHST = 129024, O_CMT = 138240;
constexpr int O_LABB = O_CMT;
constexpr int O_YF = O_AT;
constexpr int O_TTD = O_KT, O_X1T = O_KT + 3072, O_TT32 = O_KT + 4608, O_X2T = O_KT + 7168;
constexpr int O_GC = 147456, O_BON = O_GC + 256, O_SEG = O_BON + 256, O_END = O_SEG + 2048;
static_assert(O_X2T + 32 * 40 * 2 <= O_RT + 0 || true, "");
typedef unsigned long long u64;
__device__ __forceinline__ f32x4 mma(bf16x8 x, bf16x8 y, f32x4 c) { return __builtin_amdgcn_mfma_f32_16x16x32_bf16(x, y, c, 0, 0, 0); }
__device__ __forceinline__ bf16x8 ldfrag(LAS const unsigned char* base, int rs, int row, int k) { return *(const LAS bf16x8*)(base + (row * rs + k) * 2); }
__device__ __forceinline__ u64 pack4(f32x4 v) { return (u64)ge::cvt_pk_bf16(v[0], v[1]) | ((u64)ge::cvt_pk_bf16(v[2], v[3]) << 32); }
__device__ __forceinline__ void st4(LAS unsigned char* base, int rs, int row, int col, f32x4 v) { *(LAS u64*)(base + (row * rs + col) * 2) = pack4(v); }
__device__ __forceinline__ void st1(LAS unsigned char* base, int rs, int row, int col, float v) { *(LAS bf16_t*)(base + (row * rs + col) * 2) = (bf16_t)(ge::cvt_pk_bf16(v, v) & 0xffffu); }
__device__ __forceinline__ f32x4 ld4bf(const bf16_t* p) { const u64 w = *(const u64*)p; f32x4 v; v[0] = __uint_as_float((unsigned)w << 16); v[1] = __uint_as_float((unsigned)w & 0xffff0000u);
    v[2] = __uint_as_float((unsigned)(w >> 32) << 16); v[3] = __uint_as_float((unsigned)(w >> 32) & 0xffff0000u); return v; }
__device__ __forceinline__ f32x4 exp4(f32x4 x) { f32x4 r; r[0] = __expf(x[0]); r[1] = __expf(x[1]); r[2] = __expf(x[2]); r[3] = __expf(x[3]); return r; }
#define SC_BAR() do { asm volatile("s_waitcnt vmcnt(0) lgkmcnt(0)" ::: "memory"); __builtin_amdgcn_s_barrier(); asm volatile("" ::: "memory"); } while (0)
#define SC_LWAIT() asm volatile("s_waitcnt lgkmcnt(0)" ::: "memory")

__device__ __forceinline__ void scan_bh(const Args& a, LAS unsigned char* L, const int b, const int h, const int t0, const int nchunks) {
    int tid_o = threadIdx.x; asm volatile("" : "+v"(tid_o));
    const int tid = tid_o, w = __builtin_amdgcn_readfirstlane(tid >> 6);
    const int ts = w & 3, half = w >> 2;
    const int rt = w >> 1, ct0 = (w & 1) * 2;
    const bf16_t* RKVp = (const bf16_t*)(a.ws + WS_RKV); const bf16_t* LORAp = (const bf16_t*)(a.ws + WS_LORA); bf16_t* ACATp = (bf16_t*)(a.ws + WS_ACAT);
    const bf16_t* W2T = (const bf16_t*)(a.ws + WS_LW2T); const bf16_t* A2T = (const bf16_t*)(a.ws + WS_LA2T); const bf16_t* G2T = (const bf16_t*)(a.ws + WS_LG2T);
    const float* mu = a.in[I_MU];
    const int hj0 = h * 64;
    LAS float* LW = (LAS float*)(L + O_LW); LAS float* GC = (LAS float*)(L + O_GC); LAS float* BON = (LAS float*)(L + O_BON); LAS float* SEG = (LAS float*)(L + O_SEG);
    LAS float* YF = (LAS float*)(L + O_YF);
    f32x4 zacc[2];
    zacc[0] = (f32x4){0.f, 0.f, 0.f, 0.f}; zacc[1] = zacc[0];
    for (int i = tid; i < 64 * RS / 4; i += NTHREADS) *(LAS u64*)(L + O_S + i * 8) = 0ull;

    for (int ch = 0; ch < nchunks; ++ch) {
        const int tc0 = t0 + ch * 64;
        int lane_o = tid & 63; asm volatile("" : "+v"(lane_o));
        const int lane = lane_o, tl = lane & 15, q = lane >> 4;
        const size_t m0 = (size_t)b * SEQ + tc0;
        for (int it = tid; it < 64 * 36; it += NTHREADS) {
            const int t = it / 36, c8 = it % 36;
            f32x4 c0, c1, p0, p1;
            ge::unpack8(*(const u32x4*)(LORAp + (m0 + t) * NLORA + c8 * 8), c0, c1);
            if (tc0 + t == 0) { p0 = (f32x4){0.f, 0.f, 0.f, 0.f}; p1 = p0; } else ge::unpack8(*(const u32x4*)(LORAp + (m0 + t - 1) * NLORA + c8 * 8), p0, p1);
            const f32x4 m0v = *(const f32x4*)(mu + C_LORA + c8 * 8), m1v = *(const f32x4*)(mu + C_LORA + c8 * 8 + 4);
            f32x4 s0 = c0 + m0v * (p0 - c0), s1 = c1 + m1v * (p1 - c1);
            if (c8 < 8) {
#pragma unroll
                for (int j = 0; j < 4; ++j) { s0[j] = 1.f - 2.f * __builtin_amdgcn_rcpf(1.f + __expf(2.f * s0[j])); s1[j] = 1.f - 2.f * __builtin_amdgcn_rcpf(1.f + __expf(2.f * s1[j])); }
            } else if (c8 >= 16) {
#pragma unroll
                for (int j = 0; j < 4; ++j) { s0[j] = ge::fast_sigmoid(s0[j]); s1[j] = ge::fast_sigmoid(s1[j]); }
            }
            *(LAS u32x4*)(L + O_X + (t * AL + c8 * 8) * 2) = ge::pack8(s0, s1);
        }
        SC_BAR();
        const int t = 16 * ts + tl;
        const bool first = (tc0 + t == 0);
        f32x4 va[4], vb[4], vk[4];
#define vr va
#define vv vb
#define vg vk
        if (half == 0) {
            f32x4 aw[4], aa[4];
#pragma unroll
            for (int jt = 0; jt < 4; ++jt) { aw[jt] = (f32x4){0.f, 0.f, 0.f, 0.f}; aa[jt] = aw[jt]; }
#pragma unroll
            for (int ks = 0; ks < 2; ++ks) {
                const bf16x8 yw = ldfrag(L + O_X, AL, t, ks * 32 + 8 * q), ya = ldfrag(L + O_X, AL, t, 64 + ks * 32 + 8 * q);
#pragma unroll
                for (int jt = 0; jt < 4; ++jt) {
                    const bf16x8 xw = *(const bf16x8*)(W2T + (size_t)(hj0 + 16 * jt + tl) * 64 + ks * 32 + 8 * q), xa = *(const bf16x8*)(A2T + (size_t)(hj0 + 16 * jt + tl) * 64 + ks * 32 + 8 * q);
                    aw[jt] = mma(xw, yw, aw[jt]); aa[jt] = mma(xa, ya, aa[jt]);
                }
            }
            float ss = 0.f, bs = 0.f;
#pragma unroll
            for (int jt = 0; jt < 4; ++jt) {
                const int j = 16 * jt + 4 * q, hj = hj0 + j;
                const f32x4 w0v = *(const f32x4*)(a.in[I_W0] + hj), a0v = *(const f32x4*)(a.in[I_A0] + hj), kkv = *(const f32x4*)(a.in[I_KK] + hj), kav = *(const f32x4*)(a.in[I_KA] + hj), rkv = *(const f32x4*)(a.in[I_RK] + hj);
                const f32x4 kc = ld4bf(RKVp + (m0 + t) * NRKV + 1024 + hj), rc = ld4bf(RKVp + (m0 + t) * NRKV + hj);
                f32x4 kp = (f32x4){0.f, 0.f, 0.f, 0.f}, rp = kp;
                if (!first) { kp = ld4bf(RKVp + (m0 + t - 1) * NRKV + 1024 + hj); rp = ld4bf(RKVp + (m0 + t - 1) * NRKV + hj); }
                const f32x4 pk = kc + *(const f32x4*)(mu + 1024 + hj) * (kp - kc), pr = rc + *(const f32x4*)(mu + hj) * (rp - rc);
                f32x4 lw, alr;
#pragma unroll
                for (int e = 0; e < 4; ++e) {
                    const float z = -(aw[jt][e] + w0v[e]);
                    const float sp = fmaxf(z, 0.f) + __logf(1.f + __expf(-fabsf(z)));
                    lw[e] = -__expf(-sp - 0.5f);
                    alr[e] = ge::fast_sigmoid(aa[jt][e] + a0v[e]);
                }
                const f32x4 kr = pk * kkv;
                ss += (kr[0] * kr[0] + kr[1] * kr[1]) + (kr[2] * kr[2] + kr[3] * kr[3]);
                const f32x4 km = pk * (1.f + (alr - 1.f) * kav);
                const f32x4 bt = pr * km * rkv;
                bs += (bt[0] + bt[1]) + (bt[2] + bt[3]);
                va[jt] = kr; vb[jt] = alr; vk[jt] = km;
                *(LAS f32x4*)(LW + t * FS + j) = lw;
            }
            ss += __shfl_xor(ss, 16); ss += __shfl_xor(ss, 32); bs += __shfl_xor(bs, 16); bs += __shfl_xor(bs, 32);
            const float inv = 1.f / fmaxf(sqrtf(ss), 1e-12f);
#pragma unroll
            for (int jt = 0; jt < 4; ++jt) { const f32x4 kk = va[jt] * inv; va[jt] = -kk; vb[jt] = kk * vb[jt]; }
            if (q == 0) BON[t] = bs;
        } else {
            f32x4 ag[4];
#pragma unroll
            for (int jt = 0; jt < 4; ++jt) ag[jt] = (f32x4){0.f, 0.f, 0.f, 0.f};
#pragma unroll
            for (int ks = 0; ks < 5; ++ks) {
                const bf16x8 yg = ldfrag(L + O_X, AL, t, 128 + ks * 32 + 8 * q);
#pragma unroll
                for (int jt = 0; jt < 4; ++jt) { const bf16x8 xg = *(const bf16x8*)(G2T + (size_t)(hj0 + 16 * jt + tl) * 160 + ks * 32 + 8 * q); ag[jt] = mma(xg, yg, ag[jt]); }
            }
#pragma unroll
            for (int jt = 0; jt < 4; ++jt) {
                const int hj = hj0 + 16 * jt + 4 * q;
                const f32x4 rc = ld4bf(RKVp + (m0 + t) * NRKV + hj), vc = ld4bf(RKVp + (m0 + t) * NRKV + 2048 + hj);
                f32x4 rp = (f32x4){0.f, 0.f, 0.f, 0.f}, vp = rp;
                if (!first) { rp = ld4bf(RKVp + (m0 + t - 1) * NRKV + hj); vp = ld4bf(RKVp + (m0 + t - 1) * NRKV + 2048 + hj); }
                vr[jt] = rc + *(const f32x4*)(mu + hj) * (rp - rc); vv[jt] = vc + *(const f32x4*)(mu + 2048 + hj) * (vp - vc); vg[jt] = ag[jt];
            }
        }
        SC_BAR();
        { const int j = tid & 63, sg = tid >> 6; float s = 0.f;
#pragma unroll
          for (int tt = 0; tt < 8; ++tt) { s += LW[(8 * sg + tt) * FS + j]; LW[(8 * sg + tt) * FS + j] = s; }
          SEG[sg * 64 + j] = s;
          SC_BAR();
          float off = 0.f;
          for (int s2 = 0; s2 < sg; ++s2) off += SEG[s2 * 64 + j];
#pragma unroll
          for (int tt = 0; tt < 8; ++tt) LW[(8 * sg + tt) * FS + j] += off;
        }
        SC_BAR();
#pragma unroll
        for (int jt = 0; jt < 4; ++jt) {
            const int j = 16 * jt + 4 * q;
            const f32x4 cum = *(const LAS f32x4*)(LW + t * FS + j), cumC = *(const LAS f32x4*)(LW + 63 * FS + j);
            if (half == 0) {
                f32x4 cprev = (f32x4){0.f, 0.f, 0.f, 0.f}; if (t > 0) cprev = *(const LAS f32x4*)(LW + (t - 1) * FS + j);
                const f32x4 eprev = exp4(cprev), einv = exp4(-cum), erem = exp4(cumC - cum);
                st4(L + O_AT, RS, t, j, va[jt] * eprev); st4(L + O_BT, RS, t, j, vb[jt] * einv); st4(L + O_KT, RS, t, j, vk[jt] * einv);
                const f32x4 bh = vb[jt] * erem, kh = vk[jt] * erem;
#pragma unroll
                for (int e = 0; e < 4; ++e) { st1(L + O_BHT, RS, j + e, t, bh[e]); st1(L + O_KHT, RS, j + e, t, kh[e]); }
            } else {
                st4(L + O_RT, RS, t, j, vr[jt] * exp4(cum));
#pragma unroll
                for (int e = 0; e < 4; ++e) st1(L + O_VT, RS, j + e, t, vv[jt][e]);
                if (ts == 0 && tl == 0) *(LAS f32x4*)(GC + j) = exp4(cumC);
            }
        }
        SC_BAR();
        f32x4 pacc[2], yacc[2];
        {
            f32x4 lab[2], lak[2], urb[2], urk[2];
#pragma unroll
            for (int c = 0; c < 2; ++c) { lab[c] = (f32x4){0.f, 0.f, 0.f, 0.f}; lak[c] = lab[c]; urb[c] = lab[c]; urk[c] = lab[c]; pacc[c] = lab[c]; yacc[c] = lab[c]; }
            const f32x4 gc = *(const LAS f32x4*)(GC + 16 * rt + 4 * q);
            zacc[0] = zacc[0] * gc; zacc[1] = zacc[1] * gc;
#pragma unroll
            for (int ks = 0; ks < 2; ++ks) {
                const int k = ks * 32 + 8 * q;
                const bf16x8 xb = ldfrag(L + O_BT, RS, 16 * rt + tl, k), xk = ldfrag(L + O_KT, RS, 16 * rt + tl, k), xa = ldfrag(L + O_AT, RS, 16 * rt + tl, k);
                const bf16x8 xs = ldfrag(L + O_S, RS, 16 * rt + tl, k), xkh = ldfrag(L + O_KHT, RS, 16 * rt + tl, k);
#pragma unroll
                for (int c = 0; c < 2; ++c) {
                    const int cr = 16 * (ct0 + c) + tl;
                    const bf16x8 ya = ldfrag(L + O_AT, RS, cr, k), yr = ldfrag(L + O_RT, RS, cr, k), ys = ldfrag(L + O_S, RS, cr, k), yv = ldfrag(L + O_VT, RS, cr, k);
                    lab[c] = mma(xb, ya, lab[c]); lak[c] = mma(xk, ya, lak[c]); urb[c] = mma(xb, yr, urb[c]); urk[c] = mma(xk, yr, urk[c]);
                    pacc[c] = mma(xa, ys, pacc[c]);
                    yacc[c] = mma(xs, yr, yacc[c]);
                    zacc[c] = mma(xkh, yv, zacc[c]);
                }
            }
#pragma unroll
            for (int c = 0; c < 2; ++c) {
                const int tcol = 16 * (ct0 + c) + tl, u0 = 16 * rt + 4 * q;
#pragma unroll
                for (int e = 0; e < 4; ++e) { const bool lt = (u0 + e) < tcol, le = (u0 + e) <= tcol; lab[c][e] = lt ? lab[c][e] : 0.f; lak[c][e] = lt ? lak[c][e] : 0.f; urb[c][e] = le ? urb[c][e] : 0.f; urk[c][e] = le ? urk[c][e] : 0.f; }
                *(LAS f32x4*)(LW + tcol * FS + u0) = lab[c];
                st4(L + O_LABB, RS, tcol, u0, lab[c]); st4(L + O_LAK, RS, tcol, u0, lak[c]); st4(L + O_URB, RS, tcol, u0, urb[c]); st4(L + O_URK, RS, tcol, u0, urk[c]);
            }
        }
        SC_BAR();
#pragma unroll
        for (int ks = 0; ks < 2; ++ks) {
            const int k = ks * 32 + 8 * q;
            const bf16x8 xl = ldfrag(L + O_LAK, RS, 16 * rt + tl, k), xv = ldfrag(L + O_VT, RS, 16 * rt + tl, k);
#pragma unroll
            for (int c = 0; c < 2; ++c) {
                const int cr = 16 * (ct0 + c) + tl;
                pacc[c] = mma(xl, ldfrag(L + O_VT, RS, cr, k), pacc[c]);
                yacc[c] = mma(xv, ldfrag(L + O_URK, RS, cr, k), yacc[c]);
            }
        }
#pragma unroll
        for (int c = 0; c < 2; ++c) st4(L + O_RHST, RS, 16 * (ct0 + c) + tl, 16 * rt + 4 * q, pacc[c]);
        if (w == 0) {
            const int p = q, c = tl;
            float Tc[16];
#pragma unroll
            for (int k = 0; k < 16; ++k) Tc[k] = (k == c) ? 1.f : 0.f;
#pragma unroll
            for (int r = 1; r < 16; ++r) {
                const LAS float* lrow = LW + (16 * p + r) * FS + 16 * p;
                float acc0 = 0.f, acc1 = 0.f;
#pragma unroll
                for (int k = 0; k < r; k += 2) { acc0 += lrow[k] * Tc[k]; if (k + 1 < r) acc1 += lrow[k + 1] * Tc[k + 1]; }
                Tc[r] = (r > c) ? (acc0 + acc1) : Tc[r];
            }
            for (int i = lane; i < 6 * 16 * 2; i += 64) { const int blk = i >> 5, rr = (i >> 1) & 15, hf = i & 1;
                const int pr_ = (blk < 3) ? 0 : (blk < 5 ? 1 : 2), qc = (blk < 3) ? blk + 1 : (blk < 5 ? blk - 1 : 3);
                *(LAS u32x4*)(L + O_T + ((16 * pr_ + rr) * RS + 16 * qc + 8 * hf) * 2) = (u32x4){0u, 0u, 0u, 0u}; }
#pragma unroll
            for (int k = 0; k < 16; ++k) st1(L + O_T, RS, 16 * p + k, 16 * p + c, Tc[k]);
            { u32x4 w0, w1; w0.x = ge::cvt_pk_bf16(Tc[0], Tc[1]); w0.y = ge::cvt_pk_bf16(Tc[2], Tc[3]); w0.z = ge::cvt_pk_bf16(Tc[4], Tc[5]); w0.w = ge::cvt_pk_bf16(Tc[6], Tc[7]);
              w1.x = ge::cvt_pk_bf16(Tc[8], Tc[9]); w1.y = ge::cvt_pk_bf16(Tc[10], Tc[11]); w1.z = ge::cvt_pk_bf16(Tc[12], Tc[13]); w1.w = ge::cvt_pk_bf16(Tc[14], Tc[15]);
              *(LAS u32x4*)(L + O_TTD + ((p * 16 + c) * 24) * 2) = w0; *(LAS u32x4*)(L + O_TTD + ((p * 16 + c) * 24 + 8) * 2) = w1;
              if (p < 2) {
                  *(LAS u32x4*)(L + O_TT32 + ((16 * p + c) * 40 + 16 * p) * 2) = w0; *(LAS u32x4*)(L + O_TT32 + ((16 * p + c) * 40 + 16 * p + 8) * 2) = w1;
                  if (p == 1) { *(LAS u32x4*)(L + O_TT32 + ((16 + c) * 40) * 2) = (u32x4){0u, 0u, 0u, 0u}; *(LAS u32x4*)(L + O_TT32 + ((16 + c) * 40 + 8) * 2) = (u32x4){0u, 0u, 0u, 0u}; }
              } }
            SC_LWAIT();
            const bf16x8 zf = (bf16x8){0, 0, 0, 0, 0, 0, 0, 0};
            const f32x4 z4 = (f32x4){0.f, 0.f, 0.f, 0.f};
#pragma unroll
            for (int pi = 0; pi < 2; ++pi) {
                const int pp = 2 * pi + 1, qq = 2 * pi;
                const bf16x8 xl = (q < 2) ? ldfrag(L + O_LABB, RS, 16 * pp + tl, 16 * qq + 8 * q) : zf;
                const bf16x8 yt = (q < 2) ? ldfrag(L + O_TTD, 24, qq * 16 + tl, 8 * q) : zf;
                const f32x4 x1 = mma(xl, yt, z4);
                st4(L + O_X1T, 24, pi * 16 + tl, 4 * q, x1);
                SC_LWAIT();
                const bf16x8 xx = (q < 2) ? ldfrag(L + O_X1T, 24, pi * 16 + tl, 8 * q) : zf;
                const bf16x8 ytp = (q < 2) ? ldfrag(L + O_T, RS, 16 * pp + tl, 16 * pp + 8 * q) : zf;
                const f32x4 tpqT = mma(xx, ytp, z4);
                st4(L + O_T, RS, 16 * pp + tl, 16 * qq + 4 * q, tpqT);
                if (pi == 0) { const f32x4 tpq = mma(ytp, xx, z4);
                    st4(L + O_TT32, 40, tl, 16 + 4 * q, tpq); }
            }
            SC_LWAIT();
            f32x4 x2[2][2];
#pragma unroll
            for (int r2 = 0; r2 < 2; ++r2) { const bf16x8 xl = ldfrag(L + O_LABB, RS, 32 + 16 * r2 + tl, 8 * q);
#pragma unroll
                for (int c2 = 0; c2 < 2; ++c2) x2[r2][c2] = mma(xl, ldfrag(L + O_TT32, 40, 16 * c2 + tl, 8 * q), z4); }
#pragma unroll
            for (int r2 = 0; r2 < 2; ++r2)
#pragma unroll
                for (int c2 = 0; c2 < 2; ++c2) st4(L + O_X2T, 40, 16 * c2 + tl, 16 * r2 + 4 * q, x2[r2][c2]);
            SC_LWAIT();
#pragma unroll
            for (int c2 = 0; c2 < 2; ++c2) { const bf16x8 xx = ldfrag(L + O_X2T, 40, 16 * c2 + tl, 8 * q);
#pragma unroll
                for (int r2 = 0; r2 < 2; ++r2) { const f32x4 d = mma(xx, ldfrag(L + O_T, RS, 32 + 16 * r2 + tl, 32 + 8 * q), z4);
                    st4(L + O_T, RS, 32 + 16 * r2 + tl, 16 * c2 + 4 * q, d); } }
        }
        SC_BAR();
        {
            f32x4 cacc[2]; cacc[0] = (f32x4){0.f, 0.f, 0.f, 0.f}; cacc[1] = cacc[0];
#pragma unroll
            for (int ks = 0; ks < 2; ++ks) {
                const int k = ks * 32 + 8 * q;
                const bf16x8 xt = ldfrag(L + O_T, RS, 16 * rt + tl, k);
#pragma unroll
                for (int c = 0; c < 2; ++c) cacc[c] = mma(xt, ldfrag(L + O_RHST, RS, 16 * (ct0 + c) + tl, k), cacc[c]);
            }
#pragma unroll
            for (int c = 0; c < 2; ++c) st4(L + O_CMT, RS, 16 * (ct0 + c) + tl, 16 * rt + 4 * q, cacc[c]);
        }
        SC_BAR();
#pragma unroll
        for (int ks = 0; ks < 2; ++ks) {
            const int k = ks * 32 + 8 * q;
            const bf16x8 xbh = ldfrag(L + O_BHT, RS, 16 * rt + tl, k), xc = ldfrag(L + O_CMT, RS, 16 * rt + tl, k);
#pragma unroll
            for (int c = 0; c < 2; ++c) {
                const int cr = 16 * (ct0 + c) + tl;
                zacc[c] = mma(xbh, ldfrag(L + O_CMT, RS, cr, k), zacc[c]);
                yacc[c] = mma(xc, ldfrag(L + O_URB, RS, cr, k), yacc[c]);
            }
        }
#pragma unroll
        for (int c = 0; c < 2; ++c) { st4(L + O_S, RS, 16 * (ct0 + c) + tl, 16 * rt + 4 * q, zacc[c]); *(LAS f32x4*)(YF + (16 * (ct0 + c) + tl) * FS + 16 * rt + 4 * q) = yacc[c]; }
        SC_BAR();
        if (half == 1) {
            f32x4 y[4]; float s = 0.f;
#pragma unroll
            for (int jt = 0; jt < 4; ++jt) { y[jt] = *(const LAS f32x4*)(YF + t * FS + 16 * jt + 4 * q); s += (y[jt][0] + y[jt][1]) + (y[jt][2] + y[jt][3]); }
            s += __shfl_xor(s, 16); s += __shfl_xor(s, 32);
            const float mean = s * (1.f / 64.f); float vs = 0.f;
#pragma unroll
            for (int jt = 0; jt < 4; ++jt) { y[jt] = y[jt] - mean; vs += (y[jt][0] * y[jt][0] + y[jt][1] * y[jt][1]) + (y[jt][2] * y[jt][2] + y[jt][3] * y[jt][3]); }
            vs += __shfl_xor(vs, 16); vs += __shfl_xor(vs, 32);
            const float rstd = rsqrtf(vs * (1.f / 64.f) + 64.f * 1e-5f), bon = BON[t];
#pragma unroll
            for (int jt = 0; jt < 4; ++jt) { const int hi = hj0 + 16 * jt + 4 * q;
                const f32x4 o = (y[jt] * rstd * *(const f32x4*)(a.in[I_GNW] + hi) + *(const f32x4*)(a.in[I_GNB] + hi) + bon * vv[jt]) * vg[jt];
                *(u64*)(ACATp + (m0 + t) * KCAT + hi) = pack4(o); }
        }
    }
}
#undef vr
#undef vv
#undef vg
}
namespace da {
constexpr int OS = 68;
constexpr int O_OACC = 0, O_M = 256 * OS * 4, O_L = O_M + 1024, O_WAVE = O_L + 1024;
constexpr int PST = 168, VST = 72;
constexpr int WAVE_BYTES = 16 * PST * 2 + 32 * VST * 2;
static_assert(O_WAVE + 8 * WAVE_BYTES <= 151552, "attention LDS");
typedef short v4i16_t __attribute__((ext_vector_type(4)));
__device__ __forceinline__ bf16x8 tr8(LAS const unsigned char* p0, LAS const unsigned char* p1) {
    const v4i16_t lo = __builtin_amdgcn_ds_read_tr16_b64_v4i16((LAS v4i16_t*)p0), hi = __builtin_amdgcn_ds_read_tr16_b64_v4i16((LAS v4i16_t*)p1);
    return (bf16x8){lo[0], lo[1], lo[2], lo[3], hi[0], hi[1], hi[2], hi[3]};
}
__device__ __forceinline__ void attn_item(const Args& a, LAS unsigned char* L, const int b, const int slot, const int p0) {
    int tid_o = threadIdx.x; asm volatile("" : "+v"(tid_o));
    const int tid = tid_o, lane = tid & 63, w = __builtin_amdgcn_readfirstlane(tid >> 6), tl = lane & 15, q4 = lane >> 4;
    const bf16_t* AQ = (const bf16_t*)(a.ws + WS_AQKV) + (size_t)b * SEQ * NAQKV;
    bf16_t* ACATp = (bf16_t*)(a.ws + WS_ACAT) + (size_t)b * SEQ * KCAT + 1024 + slot * 64;
    LAS float* OA = (LAS float*)(L + O_OACC); LAS float* MA = (LAS float*)(L + O_M); LAS float* LA = (LAS float*)(L + O_L);
    LAS unsigned char* Pst = L + O_WAVE + w * WAVE_BYTES; LAS unsigned char* Vst = Pst + 16 * PST * 2;
    const bf16x8 zf = (bf16x8){0, 0, 0, 0, 0, 0, 0, 0};
    const f32x4 z4 = (f32x4){0.f, 0.f, 0.f, 0.f};
#pragma unroll 1
    for (int g = 0; g < 3; ++g) {
        const int dsh = 2 * g, d = 1 << dsh, hd = g * 4 + slot;
        const float slope2 = exp2f(-8.f * (float)(hd + 1) / 12.f) * (float)d * 1.44269504f;
        const bf16_t* Qb = AQ + hd * 64; const bf16_t* Kb = Qb + 768; const bf16_t* Vb = Qb + 1536;
#pragma unroll 1
        for (int rr = 0; rr < 2; ++rr) {
            const int rti = w + 8 * rr;
            const int r = (g == 0) ? 0 : (g == 1 ? (rti >> 2) : rti);
            const int j0 = (p0 >> dsh) + ((g == 0) ? 16 * rti : (g == 1 ? 16 * (rti & 3) : 0));
            const int posq = ((j0 + tl) << dsh) + r;
            bf16x8 yq[2];
#pragma unroll
            for (int ks = 0; ks < 2; ++ks) yq[ks] = *(const bf16x8*)(Qb + (size_t)posq * NAQKV + ks * 32 + 8 * q4);
            f32x4 st[9];
#pragma unroll
            for (int kt = 0; kt < 9; ++kt) {
                const int jk = j0 - 128 + 16 * kt + tl;
                bf16x8 x0 = zf, x1 = zf;
                if (jk >= 0) { const bf16_t* kp = Kb + (size_t)((jk << dsh) + r) * NAQKV + 8 * q4; x0 = *(const bf16x8*)kp; x1 = *(const bf16x8*)(kp + 32); }
                st[kt] = sc::mma(x0, yq[0], z4); st[kt] = sc::mma(x1, yq[1], st[kt]);
            }
            float mx = -INFINITY;
#pragma unroll
            for (int kt = 0; kt < 9; ++kt)
#pragma unroll
                for (int e = 0; e < 4; ++e) {
                    const int kq = 16 * kt + 4 * q4 + e, steps = tl + 128 - kq;
                    const bool ok = (steps >= 0) && (steps <= 128) && (j0 - 128 + kq >= 0);
                    const float s = ok ? (st[kt][e] * (0.125f * 1.44269504f) - slope2 * (float)steps) : -INFINITY;
                    st[kt][e] = s; mx = fmaxf(mx, s);
                }
            mx = fmaxf(mx, __shfl_xor(mx, 16)); mx = fmaxf(mx, __shfl_xor(mx, 32));
            float ls = 0.f;
#pragma unroll
            for (int kt = 0; kt < 9; ++kt) {
#pragma unroll
                for (int e = 0; e < 4; ++e) { const float ev = __builtin_amdgcn_exp2f(st[kt][e] - mx); st[kt][e] = ev; ls += ev; }
                *(LAS unsigned long long*)(Pst + (tl * PST + 16 * kt + 4 * q4) * 2) = sc::pack4(st[kt]);
            }
            *(LAS unsigned long long*)(Pst + (tl * PST + 144 + 4 * q4) * 2) = 0ull;
            ls += __shfl_xor(ls, 16); ls += __shfl_xor(ls, 32);
            f32x4 ot[4]; ot[0] = z4; ot[1] = z4; ot[2] = z4; ot[3] = z4;
            u32x4 vreg[4];
#define DA_VLOAD(ks5) do { _Pragma("unroll") for (int i2 = 0; i2 < 4; ++i2) { const int id = lane + 64 * i2, row = id >> 3, chn = id & 7, jk = j0 - 128 + 32 * (ks5) + row; \
                vreg[i2] = (u32x4){0u, 0u, 0u, 0u}; if (jk >= 0 && 32 * (ks5) + row < 144) vreg[i2] = *(const u32x4*)(Vb + (size_t)((jk << dsh) + r) * NAQKV + chn * 8); } } while (0)
            DA_VLOAD(0);
#pragma unroll 1
            for (int ks5 = 0; ks5 < 5; ++ks5) {
#pragma unroll
                for (int i2 = 0; i2 < 4; ++i2) { const int id = lane + 64 * i2, row = id >> 3, chn = id & 7; *(LAS u32x4*)(Vst + (row * VST + chn * 8) * 2) = vreg[i2]; }
                if (ks5 < 4) DA_VLOAD(ks5 + 1);
                asm volatile("s_waitcnt lgkmcnt(0)" ::: "memory");
                const bf16x8 yp = *(const LAS bf16x8*)(Pst + (tl * PST + 32 * ks5 + 8 * q4) * 2);
                const int qq = tl >> 2, pp = tl & 3;
#pragma unroll
                for (int ct = 0; ct < 4; ++ct) {
                    LAS const unsigned char* vp = Vst + ((8 * q4 + qq) * VST + 16 * ct + 4 * pp) * 2;
                    const bf16x8 xv = tr8(vp, vp + 4 * VST * 2);
                    ot[ct] = sc::mma(xv, yp, ot[ct]);
                }
                asm volatile("s_waitcnt lgkmcnt(0)" ::: "memory");
            }
#undef DA_VLOAD
            const int pidx = posq - p0;
            if (g == 0) {
#pragma unroll
                for (int ct = 0; ct < 4; ++ct) *(LAS f32x4*)(OA + pidx * OS + 16 * ct + 4 * q4) = ot[ct];
                if (q4 == 0) { MA[pidx] = mx; LA[pidx] = ls; }
            } else {
                const float mo = MA[pidx], lo = LA[pidx];
                const float mn = fmaxf(mo, mx), fo = __builtin_amdgcn_exp2f(mo - mn), fn = __builtin_amdgcn_exp2f(mx - mn);
                const float ln = lo * fo + ls * fn;
                if (g == 1) {
#pragma unroll
                    for (int ct = 0; ct < 4; ++ct) { LAS f32x4* op = (LAS f32x4*)(OA + pidx * OS + 16 * ct + 4 * q4); *op = *op * fo + ot[ct] * fn; }
                    asm volatile("s_waitcnt lgkmcnt(0)" ::: "memory");
                    if (q4 == 0) { MA[pidx] = mn; LA[pidx] = ln; }
                } else {
                    const float inv = 1.f / ln;
#pragma unroll
                    for (int ct = 0; ct < 4; ++ct) { const f32x4 o = (*(const LAS f32x4*)(OA + pidx * OS + 16 * ct + 4 * q4) * fo + ot[ct] * fn) * inv;
                        *(unsigned long long*)(ACATp + (size_t)posq * KCAT + 16 * ct + 4 * q4) = sc::pack4(o); }
                }
            }
        }
        asm volatile("s_waitcnt vmcnt(0) lgkmcnt(0)" ::: "memory"); __builtin_amdgcn_s_barrier(); asm volatile("" ::: "memory");
    }
}
}
#define XB_TMO      128
#define XB_XCNT(j)  (256  + 64 * (j))
#define XB_XSUB(j)  (1280 + 64 * (j))
#define XB_XGEN(j)  (2304 + 64 * (j))
#define XB_TOP      3328
#define XB_TOPGEN   3392
#define XCD_BAR_WORDS 3456
#define XB_SPIN_CAP (1u << 18)
__device__ __forceinline__ unsigned xb_ld(unsigned* p)              { return __hip_atomic_load(p, __ATOMIC_RELAXED, __HIP_MEMORY_SCOPE_AGENT); }
__device__ __forceinline__ unsigned xb_add(unsigned* p, unsigned v) { return __hip_atomic_fetch_add(p, v, __ATOMIC_RELAXED, __HIP_MEMORY_SCOPE_AGENT); }
__device__ __forceinline__ unsigned xb_xcc_id() { return (unsigned)__builtin_amdgcn_s_getreg((3 << 11) | 20) & 0xFu; }
#define XB_SPIN(cond, bar) do { unsigned _sp = 0; while (cond) { __builtin_amdgcn_s_sleep(1); \
    if ((++_sp & 255u) == 0u) { if (xb_ld(&(bar)[XB_TMO])) break; if (_sp > XB_SPIN_CAP) { atomicAdd(&(bar)[XB_TMO], 1u); break; } } } } while (0)
struct XcdBarrier { unsigned* bar; unsigned x; volatile LAS unsigned* st; };
__device__ __forceinline__ XcdBarrier xcd_barrier_post(unsigned* bar, volatile LAS unsigned* st) {
    XcdBarrier b; b.bar = bar; b.x = xb_xcc_id(); b.st = st;
    if (threadIdx.x == 0) (void)xb_add(&bar[XB_XCNT(b.x)], 1u);
    return b;
}
__device__ __forceinline__ void xcd_barrier_complete(unsigned* bar, unsigned x, unsigned& nloc, unsigned& nx) {
    const unsigned G = gridDim.x * gridDim.y * gridDim.z;
    unsigned sum, cnt, mine, sp = 0u;
    for (;;) {
        sum = 0u; cnt = 0u; mine = 0u;
#pragma unroll
        for (unsigned j = 0; j < 16; ++j) { const unsigned c = xb_ld(&bar[XB_XCNT(j)]); sum += c; cnt += (c > 0u) ? 1u : 0u; mine = (j == x) ? c : mine; }
        if (sum == G) break;
        __builtin_amdgcn_s_sleep(1);
        if ((++sp & 255u) == 0u) { if (xb_ld(&bar[XB_TMO])) break; if (sp > XB_SPIN_CAP) { atomicAdd(&bar[XB_TMO], 1u); break; } }
    }
    nloc = mine > 0u ? mine : 1u; nx = cnt > 0u ? cnt : 1u;
}
__device__ __forceinline__ void xcd_barrier(const XcdBarrier& b) {
    asm volatile("s_waitcnt vmcnt(0)" ::: "memory");
    __syncthreads();
    if (threadIdx.x == 0) {
        unsigned* bar = b.bar;
        __builtin_amdgcn_s_waitcnt(0);
        unsigned nloc = b.st[0], nx = b.st[1];
        if (nloc == 0u) { xcd_barrier_complete(bar, b.x, nloc, nx); b.st[0] = nloc; b.st[1] = nx; }
        const unsigned old = xb_add(&bar[XB_XSUB(b.x)], 1u);
        const unsigned gen = old / nloc;
        if (old + 1u == (gen + 1u) * nloc) {
            __builtin_amdgcn_fence(__ATOMIC_RELEASE, "agent");
            asm volatile("s_waitcnt vmcnt(0)" ::: "memory");
            const unsigned og = xb_add(&bar[XB_TOP], 1u);
            const unsigned tg = og / nx;
            if (og + 1u == (tg + 1u) * nx) xb_add(&bar[XB_TOPGEN], 1u);
            else XB_SPIN(xb_ld(&bar[XB_TOPGEN]) == tg, bar);
            __builtin_amdgcn_fence(__ATOMIC_ACQUIRE, "agent");
            xb_add(&bar[XB_XGEN(b.x)], 1u);
            asm volatile("s_waitcnt vmcnt(0)" ::: "memory");
        } else {
            XB_SPIN(xb_ld(&bar[XB_XGEN(b.x)]) == gen, bar);
            __builtin_amdgcn_fence(__ATOMIC_ACQUIRE, "agent");
            asm volatile("s_waitcnt vmcnt(0)" ::: "memory");
        }
    }
    __syncthreads();
}

#define p_XN ((bf16_t*)(a.ws + WS_XN))
#define p_RKV ((bf16_t*)(a.ws + WS_RKV))
#define p_LORA ((bf16_t*)(a.ws + WS_LORA))
#define p_AQKV ((bf16_t*)(a.ws + WS_AQKV))
#define p_GATES ((bf16_t*)a.out)
#define p_ACAT ((bf16_t*)(a.ws + WS_ACAT))
#define p_WST ((bf16_t*)(a.ws + WS_WST))
#define p_VWT ((bf16_t*)(a.ws + WS_VWT))
#define p_KV ((bf16_t*)(a.ws + WS_KV))
#define p_MEMN ((bf16_t*)(a.ws + WS_MEMN))
#define p_SS1 ((float*)(a.ws + WS_SS1))
#define p_SS2 ((float*)(a.ws + WS_SS2))
#define p_SS3 ((float*)(a.ws + WS_SS3))
#define p_H2B ((bf16_t*)(a.ws + WS_H2B))
#define p_MERGED ((bf16_t*)(a.ws + WS_MERGED))
#define p_H1B ((bf16_t*)(a.ws + WS_H1B))
#define p_PROB ((bf16_t*)(a.ws + WS_PROB))
#define p_ACT ((bf16_t*)(a.ws + WS_ACT))
#define p_WINT ((bf16_t*)(a.ws + WS_WINT))
#define p_PCATT ((bf16_t*)(a.ws + WS_PCATT))
#define p_WOUTT ((bf16_t*)(a.ws + WS_WOUTT))
#define p_W1T ((bf16_t*)(a.ws + WS_W1T))
#define p_W2T ((bf16_t*)(a.ws + WS_W2T))
#define p_WKVT ((bf16_t*)(a.ws + WS_WKVT))
#define p_WQB ((bf16_t*)(a.ws + WS_WQB))
#define p_WOT ((bf16_t*)(a.ws + WS_WOT))
#define p_OUT (a.out)
constexpr int MISC_OFF = LDSCTL_OFF;
__global__ void __launch_bounds__(NTHREADS, 2) mk_fwd(Args a) {
    extern __shared__ __attribute__((aligned(16))) unsigned char lds_raw[];
    float* lds = (float*)lds_raw;
    LAS unsigned char* ldsl = (LAS unsigned char*)lds_raw;
    const int tid = threadIdx.x, lane = tid & 63, wave = tid >> 6;
    const int G = gridDim.x, bid = blockIdx.x;
    const int gw = bid * NWAVES + wave, NGW = G * NWAVES;
    unsigned char* ws = a.ws;
    LAS float* scr = (LAS float*)(ldsl + wave * 16384);

    for (int u = tid; u < (LDS_BYTES - LDSCTL_OFF) / 4; u += NTHREADS) ((LAS unsigned*)(ldsl + LDSCTL_OFF))[u] = 0u;
    __syncthreads();
    XcdBarrier bar = xcd_barrier_post((unsigned*)(ws + WS_CTL) + 4096, (volatile LAS unsigned*)(ldsl + MISC_OFF) + 8);
    cg::grid_group grid = cg::this_grid();

    {
        {
            const float* W = a.in[I_WIN];
            for (int it = gw; it < 16 * 241; it += NGW) { const int kb = it / 241, nb = it % 241, c = nb * 32;
                const int drow = (c < C_LORA) ? c : (c < C_AQ) ? 7424 + (c - C_LORA) : (c < C_GATE) ? 5120 + (c - C_AQ) : 3072 + (c - C_GATE);
                transpose_item(W, NIN, kb * 64, c, p_WINT, D, drow, 0, nullptr, scr, lane); }
            for (int i = gw * 64 + lane; i < 224 * D / 8; i += NGW * 64) *(u32x4*)(p_WINT + (size_t)7712 * D + (size_t)i * 8) = (u32x4){0u, 0u, 0u, 0u};
        }
        for (int i = gw * 64 + lane; i < 1024 * 288; i += NGW * 64) {
            if (i < 1024 * 64) { const int n = i >> 6, c = i & 63; ((bf16_t*)(a.ws + WS_LW2T))[i] = f2bf(a.in[I_W2][c * 1024 + n]); }
            else if (i < 2 * 1024 * 64) { const int i2 = i - 1024 * 64, n = i2 >> 6, c = i2 & 63; ((bf16_t*)(a.ws + WS_LA2T))[i2] = f2bf(a.in[I_A2][c * 1024 + n]); }
            else { const int i2 = i - 2 * 1024 * 64, n = i2 / 160, c = i2 % 160; ((bf16_t*)(a.ws + WS_LG2T))[i2] = f2bf(a.in[I_G2][c * 1024 + n]); }
        }
        transpose_matrix(a.in[I_WKV], 1024, 2048, p_WKVT, D, 0, nullptr, scr, lane, gw, NGW);
        transpose_matrix(a.in[I_PRWKV], 1024, 1024, p_PCATT, KCAT, 0, nullptr, scr, lane, gw, NGW);
        transpose_matrix(a.in[I_PATTN], 256, 1024, p_PCATT, KCAT, 1024, nullptr, scr, lane, gw, NGW);
        transpose_matrix(a.in[I_WOUT], 1024, 1024, p_WOUTT, D, 0, nullptr, scr, lane, gw, NGW);
        transpose_matrix(a.in[I_WO], 1024, 1024, p_WOT, D, 0, nullptr, scr, lane, gw, NGW);
        { const float* WQ = a.in[I_WQ]; for (int i = gw * 64 + lane; i < D * D / 8; i += NGW * 64) { const f32x4 v0 = *(const f32x4*)(WQ + (size_t)i * 8), v1 = *(const f32x4*)(WQ + (size_t)i * 8 + 4); *(u32x4*)(p_WQB + (size_t)i * 8) = ge::pack8(v0, v1); } }
        for (int r = gw; r < M + 512; r += NGW) {
            const bool ism = r >= M; const int rr = ism ? r - M : r;
            const float* src = (ism ? a.in[I_MEM] : a.in[I_X]) + (size_t)rr * D; const float* g = ism ? a.in[I_NMEM] : a.in[I_NMIX];
            bf16_t* dst = (ism ? p_MEMN : p_XN) + (size_t)rr * D;
            f32x4 v[4]; float ss = 0.f;
#pragma unroll
            for (int i = 0; i < 4; ++i) { v[i] = *(const f32x4*)(src + (lane + 64 * i) * 4); ss += (v[i][0] * v[i][0] + v[i][1] * v[i][1]) + (v[i][2] * v[i][2] + v[i][3] * v[i][3]); }
            const float rstd = rsqrtf(wave_sum(ss) * (1.f / D) + 1e-6f);
#pragma unroll
            for (int i = 0; i < 4; ++i) { const f32x4 gg = *(const f32x4*)(g + (lane + 64 * i) * 4), o = v[i] * rstd * gg;
                unsigned long long w = (unsigned long long)ge::cvt_pk_bf16(o[0], o[1]) | ((unsigned long long)ge::cvt_pk_bf16(o[2], o[3]) << 32);
                *(unsigned long long*)(dst + (lane + 64 * i) * 4) = w; }
        }
    }
    grid.sync();
    {
        ge::SchedProj S; S.o.init(64, 31, G, bid); S.XN = (const char*)p_XN; S.WINT = (const char*)p_WINT; S.MEMN = (const char*)p_MEMN; S.WKVT = (const char*)p_WKVT;
        ge::EpiProj E; E.hook_t = -1; E.RKV = p_RKV; E.GATES = p_GATES; E.AQKV = p_AQKV; E.LORA = p_LORA; E.KV = p_KV;
        ge::gemm_phase<ge::EpiProj, ge::SchedProj, true>(ldsl, D, D, 16, S, E);
    }
    xcd_barrier(bar);
    if (bid < 32) sc::scan_bh(a, ldsl, bid >> 4, bid & 15, 0, SEQ / 64);
    else {
        if (bid < 96) {
            const bool isw = bid < 64; const int u = (bid - 32) & 31, pm = u >> 2, pn = u & 3;
            ge::SchedOne S; S.has = true; S.u.pm = pm; S.u.pn = pn;
            S.u.A = isw ? (const char*)(p_KV + (size_t)((pm >> 2) * 256) * 2048 + (pm & 3) * 256) : (const char*)(p_WOT + (size_t)((pm & 3) * 256) * 1024 + pn * 256);
            S.u.B = isw ? (const char*)(p_WQB + (size_t)(pn * 256) * 1024 + (pm & 3) * 256) : (const char*)(p_KV + (size_t)((pm >> 2) * 256) * 2048 + 1024 + pn * 256);
            ge::EpiScaleCol E; E.hook_t = -1; E.colscale = a.in[I_NX]; E.mul = isw ? 0.0625f : 1.f; E.use_cs = isw; E.out = isw ? p_WST : p_VWT; E.ld = 1024;
            ge::gemm_phase<ge::EpiScaleCol, ge::SchedOne, false>(ldsl, isw ? 2048 : 1024, isw ? 1024 : 2048, 4, S, E);
            __syncthreads();
        }
        for (int item = bid - 32; item < 256; item += G - 32) da::attn_item(a, ldsl, item >> 7, (item >> 5) & 3, (item & 31) * 256);
    }
    xcd_barrier(bar);
    {
        ge::Sched S; S.o.init(64, 4, G, bid); S.A = (const char*)p_ACAT; S.B = (const char*)p_PCATT; S.a_tile = (size_t)256 * KCAT * 2; S.b_tile = (size_t)256 * KCAT * 2; S.b_batch = 0;
        ge::EpiMerged E; E.hook_t = 16; E.GATES = p_GATES; E.MERGED = p_MERGED;
        ge::gemm_phase<ge::EpiMerged, ge::Sched, false>(ldsl, KCAT, KCAT, 20, S, E);
        __syncthreads();
        int tid2 = threadIdx.x; asm volatile("" : "+v"(tid2));
        const int lane2 = tid2 & 63, wave2 = tid2 >> 6; LAS float* scr2 = (LAS float*)(ldsl + wave2 * 16384);
        transpose_matrix(a.in[I_W1], 1024, 4096, p_W1T, D, 0, a.in[I_NFFN], scr2, lane2, bid * NWAVES + wave2, NGW);
        transpose_matrix(a.in[I_FW2], 4096, 1024, p_W2T, FF, 0, nullptr, scr2, lane2, bid * NWAVES + wave2, NGW);
    }
    xcd_barrier(bar);
    {
        ge::Sched S; S.o.init(64, 4, G, bid); S.A = (const char*)p_MERGED; S.B = (const char*)p_WOUTT; S.a_tile = (size_t)256 * D * 2; S.b_tile = (size_t)256 * D * 2; S.b_batch = 0;
        ge::EpiResid E; E.hook_t = -1; E.base = a.in[I_X]; E.out = p_OUT; E.hb = p_H1B; E.SS = p_SS1;
        ge::gemm_phase<ge::EpiResid, ge::Sched, false>(ldsl, D, D, 16, S, E);
    }
    xcd_barrier(bar);
    {
        ge::Sched S; S.o.init(64, 4, G, bid); S.A = (const char*)p_H1B; S.B = (const char*)p_WST; S.a_tile = (size_t)256 * D * 2; S.b_tile = (size_t)256 * D * 2; S.b_batch = (size_t)1024 * 1024 * 2;
        ge::EpiSoftmax E; E.hook_t = -1; E.SS = p_SS1; E.PROB = p_PROB;
        ge::gemm_phase<ge::EpiSoftmax, ge::Sched, false>(ldsl, D, D, 16, S, E);
    }
    xcd_barrier(bar);
    {
        ge::Sched S; S.o.init(64, 4, G, bid); S.A = (const char*)p_PROB; S.B = (const char*)p_VWT; S.a_tile = (size_t)256 * D * 2; S.b_tile = (size_t)256 * D * 2; S.b_batch = (size_t)1024 * 1024 * 2;
        ge::EpiResid E; E.hook_t = -1; E.base = p_OUT; E.out = p_OUT; E.hb = p_H2B; E.SS = p_SS2;
        ge::gemm_phase<ge::EpiResid, ge::Sched, false>(ldsl, D, D, 16, S, E);
    }
    xcd_barrier(bar);
    {
        ge::Sched S; S.o.init(64, 16, G, bid); S.A = (const char*)p_H2B; S.B = (const char*)p_W1T; S.a_tile = (size_t)256 * D * 2; S.b_tile = (size_t)256 * D * 2; S.b_batch = 0;
        ge::EpiRelu2 E; E.hook_t = -1; E.SS = p_SS2; E.ACT = p_ACT;
        ge::gemm_phase<ge::EpiRelu2, ge::Sched, true>(ldsl, D, D, 16, S, E);
    }
    xcd_barrier(bar);
    {
        ge::Sched S; S.o.init(64, 4, G, bid); S.A = (const char*)p_ACT; S.B = (const char*)p_W2T; S.a_tile = (size_t)256 * FF * 2; S.b_tile = (size_t)256 * FF * 2; S.b_batch = 0;
        ge::EpiResid E; E.hook_t = -1; E.base = p_OUT; E.out = p_OUT; E.hb = nullptr; E.SS = p_SS3;
        ge::gemm_phase<ge::EpiResid, ge::Sched, false>(ldsl, FF, FF, 64, S, E);
    }
    xcd_barrier(bar);
    {
        const float* g = a.in[I_NFIN];
        int tid3 = threadIdx.x; asm volatile("" : "+v"(tid3));
        const int lane = tid3 & 63;
        for (int r = bid * NWAVES + (tid3 >> 6); r < M; r += NGW) {
            const float rstd = ge::rstd_from_ss(p_SS3, (size_t)r);
#pragma unroll
            for (int i = 0; i < 4; ++i) { const size_t o = (size_t)r * D + (lane + 64 * i) * 4; const f32x4 v = *(const f32x4*)(p_OUT + o), gg = *(const f32x4*)(g + (lane + 64 * i) * 4); *(f32x4*)(p_OUT + o) = v * rstd * gg; }
        }
    }
}

extern "C" void kernel_launch(void* const* d_in, const int* in_sizes, int n_in, void* d_out, int out_size, void* d_ws, size_t ws_size, hipStream_t stream) {
    static int grid = 0;
    if (grid == 0) {
        if (n_in != 27 || out_size != M * D || ws_size < 256 * MiB) { fprintf(stderr, "kernel_launch: unexpected shapes (n_in %d out %d ws %zu)\n", n_in, out_size, ws_size); grid = -1; return; }
        int dev = 0, cus = 0, per_cu = 0;
        if (hipGetDevice(&dev) != hipSuccess || hipDeviceGetAttribute(&cus, hipDeviceAttributeMultiprocessorCount, dev) != hipSuccess) { fprintf(stderr, "kernel_launch: device query failed\n"); grid = -1; return; }
        if (hipFuncSetAttribute((const void*)mk_fwd, hipFuncAttributeMaxDynamicSharedMemorySize, LDS_BYTES) != hipSuccess) { fprintf(stderr, "kernel_launch: hipFuncSetAttribute failed\n"); grid = -1; return; }
        if (hipOccupancyMaxActiveBlocksPerMultiprocessor(&per_cu, (const void*)mk_fwd, NTHREADS, LDS_BYTES) != hipSuccess || per_cu < 1) { fprintf(stderr, "kernel_launch: occupancy query says %d blocks per CU\n", per_cu); per_cu = 1; }
        (void)hipGetLastError();
        grid = cus;
        if (grid != 256) fprintf(stderr, "kernel_launch: %d CUs; this kernel is built for 256\n", grid);
    }
    if (grid < 0) return;
    (void)hipMemsetAsync((char*)d_ws + WS_CTL, 0, 64 * 1024, stream);
    Args a{};
    for (int i = 0; i < 27; ++i) a.in[i] = (const float*)d_in[i];
    a.out = (float*)d_out; a.ws = (unsigned char*)d_ws;
    void* kargs[] = {&a};
    hipError_t e = hipLaunchCooperativeKernel((const void*)mk_fwd, dim3(grid), dim3(NTHREADS), kargs, LDS_BYTES, stream);
    if (e != hipSuccess) fprintf(stderr, "kernel_launch: cooperative launch failed: %s (grid %d)\n", hipGetErrorString(e), grid);
}
```

```cpp
#include <hip/hip_runtime.h>
#include <hip/hip_cooperative_groups.h>
namespace cg = cooperative_groups;
#include <cstdint>
#include <cstdio>

typedef unsigned short bf16_t;
typedef float f32x4 __attribute__((ext_vector_type(4)));

constexpr int BATCH = 2, SEQ = 8192, M = BATCH * SEQ, D = 1024;
constexpr int NIN = 7712;
constexpr int C_LORA = 3072, C_AQ = 3360, C_GATE = 5664;
constexpr int NLORA = 288, NAQKV = 2304, NGATE = 2048, NRKV = 3072;
constexpr int MEMLEN = 256, FF = 4096, KCAT = 1280;
constexpr int CH = 32;

constexpr size_t KiB = 1024, MiB = 1024 * 1024;
constexpr size_t WS_CTL = 0;
constexpr size_t WS_LW2T = 1 * MiB;
constexpr size_t WS_LA2T = 1 * MiB + 128 * KiB;
constexpr size_t WS_LG2T = 1 * MiB + 256 * KiB;
constexpr size_t WS_MN = 2 * MiB;
constexpr size_t WS_WINT = 2 * MiB;
constexpr size_t WS_XN = 17 * MiB + 512 * KiB;
constexpr size_t WS_MEMN = 49 * MiB + 512 * KiB;
constexpr size_t WS_WKVT = 50 * MiB + 512 * KiB;
constexpr size_t WS_ACAT = WS_XN;
constexpr size_t WS_RKV = 57 * MiB + 512 * KiB;
constexpr size_t WS_LORA = 153 * MiB + 512 * KiB;
constexpr size_t WS_AQKV = 162 * MiB + 512 * KiB;
constexpr size_t WS_PCATT = 234 * MiB + 512 * KiB;
constexpr size_t WS_WOUTT = 237 * MiB;
constexpr size_t WS_WST = 239 * MiB;
constexpr size_t WS_VWT = 243 * MiB;
constexpr size_t WS_WQB = 247 * MiB;
constexpr size_t WS_WOT = 249 * MiB;
constexpr size_t WS_KV = 251 * MiB;
constexpr size_t WS_SS1 = 253 * MiB;
constexpr size_t WS_SS2 = 254 * MiB;
constexpr size_t WS_SS3 = 255 * MiB;
constexpr size_t WS_W1T = 57 * MiB + 512 * KiB;
constexpr size_t WS_W2T = 65 * MiB + 512 * KiB;
constexpr size_t WS_H2B = 73 * MiB + 512 * KiB;
constexpr size_t WS_MERGED = 105 * MiB + 512 * KiB;
constexpr size_t WS_H1B = 137 * MiB + 512 * KiB;
constexpr size_t WS_PROB = 169 * MiB + 512 * KiB;
constexpr size_t WS_ACT = 105 * MiB + 512 * KiB;

constexpr int NTHREADS = 512, NWAVES = 8;
constexpr int LDS_BYTES = 155648, LDSCTL_OFF = 151552;

__device__ __forceinline__ float bf2f(bf16_t v) { return __uint_as_float(((unsigned)v) << 16); }
__device__ __forceinline__ bf16_t f2bf(float f) { unsigned u = __float_as_uint(f); return (bf16_t)((u + 0x7fffu + ((u >> 16) & 1u)) >> 16); }
__device__ __forceinline__ float sigmoidf_(float x) { return 1.f / (1.f + __expf(-x)); }
__device__ __forceinline__ float wave_sum(float v) {
#pragma unroll
    for (int o = 1; o < 64; o <<= 1) v += __shfl_xor(v, o);
    return v;
}
__device__ __forceinline__ float wave_max(float v) {
#pragma unroll
    for (int o = 1; o < 64; o <<= 1) v = fmaxf(v, __shfl_xor(v, o));
    return v;
}

struct Args {
    const float* in[27];
    float* out;
    unsigned char* ws;
    int ph_lo, ph_hi;
};

enum { I_X = 0, I_MEM, I_NMIX, I_WIN, I_MU, I_W0, I_W2, I_A0, I_A2, I_G2, I_KK, I_KA, I_RK, I_GNW, I_GNB, I_PRWKV, I_PATTN, I_WOUT,
       I_NX, I_NMEM, I_WQ, I_WKV, I_WO, I_NFFN, I_W1, I_FW2, I_NFIN };

__device__ __forceinline__ void scan_naive(const Args& a, float* lds, int bh) {
    const int b = bh >> 4, h = bh & 15;
    const int tid = threadIdx.x, lane = tid & 63, wave = tid >> 6;
    const bf16_t* RKV = (const bf16_t*)(a.ws + WS_RKV);
    const bf16_t* LORA = (const bf16_t*)(a.ws + WS_LORA);
    bf16_t* ACAT = (bf16_t*)(a.ws + WS_ACAT);
    const float* mu = a.in[I_MU];
    float* actW = lds;
    float* actA = actW + CH * 64;
    float* actG = actA + CH * 64;
    float* Wd = actG + CH * 160;
    float* Kk = Wd + CH * 64;
    float* Aa = Kk + CH * 64;
    float* Bb = Aa + CH * 64;
    float* Rr = Bb + CH * 64;
    float* Vv = Rr + CH * 64;
    float* Gg = Vv + CH * 64;
    float* Yy = Gg + CH * 64;
    float* bon = Yy + CH * 64;
    const int hj0 = h * 64;
    float st[8];
#pragma unroll
    for (int e = 0; e < 8; ++e) st[e] = 0.f;
    const int row_i = wave * 8 + (lane >> 3), cg = lane & 7;
    for (int c0 = 0; c0 < SEQ; c0 += CH) {
        const size_t m0 = (size_t)b * SEQ + c0;
        __syncthreads();
        for (int idx = tid; idx < CH * NLORA; idx += NTHREADS) {
            const int t = idx / NLORA, c = idx % NLORA;
            const float cur = bf2f(LORA[(m0 + t) * NLORA + c]);
            const float prev = (c0 + t == 0) ? 0.f : bf2f(LORA[(m0 + t - 1) * NLORA + c]);
            const float s = cur + mu[C_LORA + c] * (prev - cur);
            if (c < 64) actW[t * 64 + c] = tanhf(s);
            else if (c < 128) actA[t * 64 + c - 64] = s;
            else actG[t * 160 + c - 128] = sigmoidf_(s);
        }
        for (int idx = tid; idx < CH * 64; idx += NTHREADS) {
            const int t = idx >> 6, j = idx & 63;
            const bool first = (c0 + t == 0);
#pragma unroll
            for (int q = 0; q < 3; ++q) {
                const int col = q * 1024 + hj0 + j;
                const float cur = bf2f(RKV[(m0 + t) * NRKV + col]);
                const float prev = first ? 0.f : bf2f(RKV[(m0 + t - 1) * NRKV + col]);
                const float s = cur + mu[col] * (prev - cur);
                if (q == 0) Rr[idx] = s; else if (q == 1) Kk[idx] = s; else Vv[idx] = s;
            }
        }
        __syncthreads();
        for (int idx = tid; idx < CH * 64; idx += NTHREADS) {
            const int t = idx >> 6, j = idx & 63, hj = hj0 + j;
            float wp = a.in[I_W0][hj], ap = a.in[I_A0][hj], g = 0.f;
            for (int c = 0; c < 64; ++c) { wp += actW[t * 64 + c] * a.in[I_W2][c * 1024 + hj]; ap += actA[t * 64 + c] * a.in[I_A2][c * 1024 + hj]; }
            for (int c = 0; c < 160; ++c) g += actG[t * 160 + c] * a.in[I_G2][c * 1024 + hj];
            const float z = -wp;
            const float sp = fmaxf(z, 0.f) + log1pf(__expf(-fabsf(z)));
            const float wlog = -sp - 0.5f;
            Wd[idx] = __expf(-__expf(wlog));
            Aa[idx] = sigmoidf_(ap);
            Gg[idx] = g;
        }
        __syncthreads();
#pragma unroll
        for (int q = 0; q < 4; ++q) {
            const int t = wave * 4 + q, idx = t * 64 + lane, hj = hj0 + lane;
            const float pk = Kk[idx], alr = Aa[idx];
            const float kr = pk * a.in[I_KK][hj];
            const float ss = wave_sum(kr * kr);
            const float kk = kr / fmaxf(sqrtf(ss), 1e-12f);
            const float kmod = pk * (1.f + (alr - 1.f) * a.in[I_KA][hj]);
            const float bs = wave_sum(Rr[idx] * kmod * a.in[I_RK][hj]);
            Aa[idx] = -kk; Bb[idx] = kk * alr; Kk[idx] = kmod;
            if (lane == 0) bon[t] = bs;
        }
        __syncthreads();
        for (int t = 0; t < CH; ++t) {
            const float* ap = Aa + t * 64 + cg * 8; const float* wp = Wd + t * 64 + cg * 8; const float* kp = Kk + t * 64 + cg * 8;
            const float* bp = Bb + t * 64 + cg * 8; const float* rp = Rr + t * 64 + cg * 8;
            float sa = 0.f;
#pragma unroll
            for (int e = 0; e < 8; ++e) sa += st[e] * ap[e];
            sa += __shfl_xor(sa, 1); sa += __shfl_xor(sa, 2); sa += __shfl_xor(sa, 4);
            const float vi = Vv[t * 64 + row_i];
            float y = 0.f;
#pragma unroll
            for (int e = 0; e < 8; ++e) { st[e] = st[e] * wp[e] + sa * bp[e] + vi * kp[e]; y += st[e] * rp[e]; }
            y += __shfl_xor(y, 1); y += __shfl_xor(y, 2); y += __shfl_xor(y, 4);
            if (cg == 0) Yy[t * 64 + row_i] = y;
        }
        __syncthreads();
#pragma unroll
        for (int q = 0; q < 4; ++q) {
            const int t = wave * 4 + q, idx = t * 64 + lane, hi = hj0 + lane;
            const float y = Yy[idx];
            const float mean = wave_sum(y) * (1.f / 64.f);
            const float dy = y - mean;
            const float var = wave_sum(dy * dy) * (1.f / 64.f);
            const float yn = dy * rsqrtf(var + 64.f * 1e-5f) * a.in[I_GNW][hi] + a.in[I_GNB][hi];
            const float o = (yn + bon[t] * Vv[idx]) * Gg[idx];
            ACAT[(m0 + t) * KCAT + hi] = f2bf(o);
        }
    }
}

__device__ __forceinline__ void dil_attn_naive(const Args& a, float* lds, int wave_gid, int nwaves_total) {
    const int lane = threadIdx.x & 63, wave = threadIdx.x >> 6;
    const bf16_t* AQ = (const bf16_t*)(a.ws + WS_AQKV);
    bf16_t* ACAT = (bf16_t*)(a.ws + WS_ACAT);
    float* pbuf = lds + wave * 640;
    float* qs = pbuf + 448;
    for (int task = wave_gid; task < M * 4; task += nwaves_total) {
        const int m = task >> 2, s = task & 3, p = m & (SEQ - 1);
#pragma unroll
        for (int g = 0; g < 3; ++g) qs[g * 64 + lane] = bf2f(AQ[(size_t)m * NAQKV + (g * 4 + s) * 64 + lane]);
        float sc[7];
        float mx = -INFINITY;
#pragma unroll
        for (int i = 0; i < 7; ++i) {
            const int idx = lane + i * 64;
            float v = -INFINITY;
            if (idx < 387) {
                const int g = idx / 129, stp = idx % 129, dil = (g == 0) ? 1 : (g == 1 ? 4 : 16), hd = g * 4 + s;
                if (stp * dil <= p) {
                    const bf16_t* kr = AQ + (size_t)(m - stp * dil) * NAQKV + 768 + hd * 64;
                    float dot = 0.f;
                    for (int c = 0; c < 64; ++c) dot += qs[g * 64 + c] * bf2f(kr[c]);
                    const float slope = exp2f(-8.f * (float)(hd + 1) / 12.f);
                    v = dot * 0.125f - slope * (float)(stp * dil);
                }
            }
            sc[i] = v; mx = fmaxf(mx, v);
        }
        mx = wave_max(mx);
        float sum = 0.f;
#pragma unroll
        for (int i = 0; i < 7; ++i) { const int idx = lane + i * 64; const float e = (sc[i] == -INFINITY) ? 0.f : __expf(sc[i] - mx); sum += e; if (idx < 448) pbuf[idx] = e; }
        sum = wave_sum(sum);
        float acc = 0.f;
        for (int idx = 0; idx < 387; ++idx) {
            const int g = idx / 129, stp = idx % 129, dil = (g == 0) ? 1 : (g == 1 ? 4 : 16), hd = g * 4 + s;
            if (stp * dil <= p) acc += pbuf[idx] * bf2f(AQ[(size_t)(m - stp * dil) * NAQKV + 1536 + hd * 64 + lane]);
        }
        ACAT[(size_t)m * KCAT + 1024 + s * 64 + lane] = f2bf(acc / sum);
    }
}

#define LAS __attribute__((address_space(3)))
typedef short bf16x8 __attribute__((ext_vector_type(8)));
typedef unsigned u32x4 __attribute__((ext_vector_type(4)));
namespace ge {
constexpr int BM = 256, BK = 64, HALF = 128, HTB = HALF * BK * 2, STAGE_BYTES = 8 * HTB, NXCD = 8, WGM = 8;
__host__ __device__ __forceinline__ int lds_byte(int r, int c) { const int st = (r >> 4) * 2 + (c >> 5), rr = r & 15, cc = c & 31, ob = rr * 64 + cc * 2; return st * 1024 + (ob ^ (((ob >> 9) & 1) << 5)); }
__host__ __device__ __forceinline__ void stage_rc(int b, int& R, int& C) { const int st = b / 1024, sb = b % 1024, swz = sb ^ (((sb >> 9) & 1) << 5); R = (st >> 1) * 16 + swz / 64; C = (st & 1) * 32 + (swz % 64) / 2; }
__host__ __device__ __forceinline__ int perm32(int rho) { const int n = rho >> 4, i = rho & 15; return 8 * (i >> 2) + 4 * n + (i & 3); }

struct Unit { const char* A; const char* B; int pm, pn; };

struct Order {
    int nM, nN, nwg, G, c;
    __device__ __forceinline__ void init(int nM_, int nN_, int G_, int c_) { nM = nM_; nN = nN_; nwg = nM * nN; G = G_; c = c_; }
    __device__ __forceinline__ bool next(int i, int& pm, int& pn) const {
        const long L = (long)i * G + c; if (L >= nwg) return false;
        int wgid = (int)L; { const int q = nwg / NXCD, r = nwg % NXCD, xcd = wgid % NXCD, off = wgid / NXCD; wgid = (xcd < r ? xcd * (q + 1) : r * (q + 1) + (xcd - r) * q) + off; }
        const int nig = WGM * nN, gid = wgid / nig, fm = gid * WGM, gsz = (nM - fm) < WGM ? (nM - fm) : WGM;
        pm = fm + ((wgid % nig) % gsz); pn = (wgid % nig) / gsz; return true;
    }
};
struct Sched {
    Order o; const char* A; const char* B; size_t a_tile, b_tile, b_batch;
    __device__ __forceinline__ bool next(int i, Unit& u) const {
        int pm, pn; if (!o.next(i, pm, pn)) return false;
        u.pm = pm; u.pn = pn; u.A = A + (size_t)pm * a_tile; u.B = B + (size_t)pn * b_tile + (size_t)(pm >> 5) * b_batch; return true;
    }
};

typedef float f32x2_t __attribute__((ext_vector_type(2))); typedef __bf16 bf16x2_t __attribute__((ext_vector_type(2)));
__device__ __forceinline__ unsigned cvt_pk_bf16(float lo, float hi) { f32x2_t v = {lo, hi}; bf16x2_t b = __builtin_convertvector(v, bf16x2_t); return __builtin_bit_cast(unsigned, b); }
__device__ __forceinline__ u32x4 pack8(const f32x4 v0, const f32x4 v1) { u32x4 w; w.x = cvt_pk_bf16(v0[0], v0[1]); w.y = cvt_pk_bf16(v0[2], v0[3]); w.z = cvt_pk_bf16(v1[0], v1[1]); w.w = cvt_pk_bf16(v1[2], v1[3]); return w; }
__device__ __forceinline__ void unpack8(const u32x4 w, f32x4& v0, f32x4& v1) {
    v0[0] = __uint_as_float(w.x << 16); v0[1] = __uint_as_float(w.x & 0xffff0000u); v0[2] = __uint_as_float(w.y << 16); v0[3] = __uint_as_float(w.y & 0xffff0000u);
    v1[0] = __uint_as_float(w.z << 16); v1[1] = __uint_as_float(w.z & 0xffff0000u); v1[2] = __uint_as_float(w.w << 16); v1[3] = __uint_as_float(w.w & 0xffff0000u);
}

template <class Epi, class SchedT, bool ALIGN_EPI>
__device__ __forceinline__ void gemm_phase(LAS unsigned char* lds, const int lda, const int ldb, const int nt, const SchedT& S, const Epi& E) {
    int tid_o = threadIdx.x; asm volatile("" : "+v"(tid_o));
    const int tid = tid_o, wid = __builtin_amdgcn_readfirstlane(tid >> 6), lane = tid & 63, wr = wid >> 2, wc = wid & 3, fr = lane & 15, fq = lane >> 4;
    unsigned voffA[2], voffB[2];
#pragma unroll
    for (int i = 0; i < 2; ++i) { int R, C; stage_rc(tid * 16 + i * 8192, R, C); const int Rb = (R & ~31) + perm32(R & 31);
        voffA[i] = (unsigned)(R * lda + C) * 2u; voffB[i] = (unsigned)(Rb * ldb + C) * 2u; }
    const size_t kstep = (size_t)(BK * 2);
    const size_t hstepA = (size_t)HALF * lda * 2, hstepB = (size_t)HALF * ldb * 2;
    const unsigned ldsw = (unsigned)wid * 1024u;
    const int aoff = lds_byte(wr * 64 + fr, fq * 8), boff = lds_byte(wc * 32 + fr, fq * 8);
#define GE_SA(b, h) (((b) * 2 + (h)) * ge::HTB)
#define GE_SB(b, h) ((4 + (b) * 2 + (h)) * ge::HTB)
#define GE_STAGE(bufoff, gbase, voff) do { _Pragma("unroll") for (int _i = 0; _i < 2; ++_i) \
        __builtin_amdgcn_global_load_lds((const unsigned*)((const char*)(gbase) + (voff)[_i]), (LAS unsigned*)(lds + (bufoff) + ldsw + _i * 8192), 16, 0, 0); } while (0)
#define GE_LDA(dst, b, h) do { _Pragma("unroll") for (int m = 0; m < 4; ++m) _Pragma("unroll") for (int k = 0; k < 2; ++k) dst[m][k] = *(const LAS bf16x8*)(lds + GE_SA(b, h) + aoff + m * 2048 + k * 1024); } while (0)
#define GE_LDB(dst, b, h) do { _Pragma("unroll") for (int n = 0; n < 2; ++n) _Pragma("unroll") for (int k = 0; k < 2; ++k) dst[n][k] = *(const LAS bf16x8*)(lds + GE_SB(b, h) + boff + n * 2048 + k * 1024); } while (0)
#define GE_MMA(ai, bj, At, Bt) do { __builtin_amdgcn_s_setprio(1); _Pragma("unroll") for (int m = 0; m < 4; ++m) _Pragma("unroll") for (int n = 0; n < 2; ++n) _Pragma("unroll") for (int k = 0; k < 2; ++k) \
        acc[ai][bj][m][n] = __builtin_amdgcn_mfma_f32_16x16x32_bf16(Bt[n][k], At[m][k], acc[ai][bj][m][n], 0, 0, 0); __builtin_amdgcn_s_setprio(0); } while (0)
#define GE_WAIT_V(n) asm volatile("s_waitcnt vmcnt(" #n ")" ::: "memory")
#define GE_WAIT_L(n) asm volatile("s_waitcnt lgkmcnt(" #n ")" ::: "memory")
#define GE_BAR __builtin_amdgcn_s_barrier()
#define GE_SCHED __builtin_amdgcn_sched_barrier(0)
    Unit cur, nxt; int ui = 0;
    if (!S.next(0, cur)) return;
    f32x4 acc[2][2][4][2];
#pragma unroll
    for (int a = 0; a < 2; ++a)
#pragma unroll
        for (int b = 0; b < 2; ++b)
#pragma unroll
            for (int m = 0; m < 4; ++m)
#pragma unroll
                for (int n = 0; n < 2; ++n) acc[a][b][m][n] = (f32x4){0.f, 0.f, 0.f, 0.f};
    bf16x8 At[4][2], B0[2][2], B1[2][2];
    const char* cA = cur.A; const char* cB = cur.B;
    GE_STAGE(GE_SB(0, 0), cB, voffB); GE_STAGE(GE_SB(0, 1), cB + hstepB, voffB); GE_STAGE(GE_SA(0, 0), cA, voffA); GE_STAGE(GE_SA(0, 1), cA + hstepA, voffA);
    if (wr == 1) GE_BAR;
    GE_WAIT_V(2); GE_BAR;
    GE_STAGE(GE_SB(1, 0), cB + kstep, voffB); GE_STAGE(GE_SA(1, 0), cA + kstep, voffA); GE_STAGE(GE_SB(1, 1), cB + hstepB + kstep, voffB);
    GE_WAIT_V(6); GE_BAR;
    for (;;) {
        const bool has_next = S.next(ui + 1, nxt);
        const char* nA = has_next ? nxt.A : cA; const char* nB = has_next ? nxt.B : cB;
        for (int t = 0; t < nt; t += 2) {
            if constexpr (Epi::HOOK) { if (t == E.hook_t) E.hook(acc, cur, wr, wc, fr, fq); }
            const bool last = (t == nt - 2);
            const char* a1 = cA + (size_t)(t + 1) * kstep;
            const char* a2 = last ? nA : cA + (size_t)(t + 2) * kstep; const char* b2 = last ? nB : cB + (size_t)(t + 2) * kstep;
            const char* a3 = a2 + kstep; const char* b3 = b2 + kstep;
            GE_LDB(B0, 0, 0); GE_LDB(B1, 0, 1); GE_SCHED; GE_LDA(At, 0, 0); GE_STAGE(GE_SA(1, 1), a1 + hstepA, voffA);
            GE_WAIT_V(8); GE_WAIT_L(0); GE_BAR; GE_MMA(0, 0, At, B0); GE_MMA(0, 1, At, B1); GE_BAR; GE_SCHED;
            GE_LDA(At, 0, 1); GE_STAGE(GE_SB(0, 0), b2, voffB); GE_STAGE(GE_SB(0, 1), b2 + hstepB, voffB); GE_STAGE(GE_SA(0, 0), a2, voffA);
            GE_WAIT_V(8); GE_WAIT_L(0); GE_BAR; GE_MMA(1, 0, At, B0); GE_MMA(1, 1, At, B1); GE_BAR; GE_SCHED;
            GE_LDB(B0, 1, 0); GE_LDB(B1, 1, 1); GE_SCHED; GE_LDA(At, 1, 0); GE_STAGE(GE_SA(0, 1), a2 + hstepA, voffA);
            GE_WAIT_V(8); GE_WAIT_L(0); GE_BAR; GE_MMA(0, 0, At, B0); GE_MMA(0, 1, At, B1); GE_BAR; GE_SCHED;
            GE_LDA(At, 1, 1); GE_STAGE(GE_SB(1, 0), b3, voffB); GE_STAGE(GE_SB(1, 1), b3 + hstepB, voffB); GE_STAGE(GE_SA(1, 0), a3, voffA);
            GE_WAIT_V(8); GE_WAIT_L(0); GE_BAR; GE_MMA(1, 0, At, B0); GE_MMA(1, 1, At, B1); GE_BAR; GE_SCHED;
        }
        if constexpr (ALIGN_EPI) { if (wr == 0) GE_BAR; }
        if constexpr (!Epi::AFTER_DRAIN) { E(acc, cur, wr, wc, fr, fq); }
        if (!has_next) break;
#pragma unroll
        for (int a = 0; a < 2; ++a)
#pragma unroll
            for (int b = 0; b < 2; ++b)
#pragma unroll
                for (int m = 0; m < 4; ++m)
#pragma unroll
                    for (int n = 0; n < 2; ++n) acc[a][b][m][n] = (f32x4){0.f, 0.f, 0.f, 0.f};
        cur = nxt; cA = nA; cB = nB; ++ui;
        if constexpr (ALIGN_EPI) { if (wr == 1) GE_BAR; }
    }
    GE_WAIT_V(0);
    if constexpr (!ALIGN_EPI) { if (wr == 0) GE_BAR; }
    GE_BAR;
    if constexpr (Epi::AFTER_DRAIN) { E.fused(acc, cur, wr, wc, fr, fq, lds, wid, lane); }
#undef GE_SA
#undef GE_SB
#undef GE_STAGE
#undef GE_LDA
#undef GE_LDB
#undef GE_MMA
#undef GE_WAIT_V
#undef GE_WAIT_L
#undef GE_BAR
#undef GE_SCHED
}

#define GE_ROW(ai, m) (u.pm * 256 + (ai) * 128 + wr * 64 + (m) * 16 + fr)
#define GE_COL(bj) (u.pn * 256 + (bj) * 128 + wc * 32 + 8 * fq)
typedef f32x4 Acc[2][2][4][2];

__device__ __forceinline__ float fast_sigmoid(float x) { return __builtin_amdgcn_rcpf(1.f + __expf(-x)); }

struct EpiProj {
    static constexpr bool AFTER_DRAIN = false, HOOK = false; int hook_t;
    bf16_t *RKV, *GATES, *AQKV, *LORA, *KV;
    __device__ __forceinline__ void hook(Acc&, const Unit&, int, int, int, int) const {}
    __device__ __forceinline__ void operator()(const Acc& acc, const Unit& u, int wr, int wc, int fr, int fq) const {
        const int pn = u.pn; bf16_t* base; int ld, cbase, climit = 1 << 30; bool sig = false;
        if (pn >= 100) { base = KV; ld = 2048; cbase = (pn - 100) * 256; }
        else if (pn < 12) { base = RKV; ld = NRKV; cbase = pn * 256; }
        else if (pn < 20) { base = GATES; ld = NGATE; cbase = (pn - 12) * 256; sig = true; }
        else if (pn < 29) { base = AQKV; ld = NAQKV; cbase = (pn - 20) * 256; }
        else { base = LORA; ld = NLORA; cbase = (pn - 29) * 256; climit = NLORA; }
#pragma unroll
        for (int ai = 0; ai < 2; ++ai)
#pragma unroll
            for (int m = 0; m < 4; ++m) { bf16_t* rowp = base + (size_t)GE_ROW(ai, m) * ld;
#pragma unroll
                for (int bj = 0; bj < 2; ++bj) { const int c = cbase + bj * 128 + wc * 32 + 8 * fq;
                    if (c < climit) { f32x4 v0 = acc[ai][bj][m][0], v1 = acc[ai][bj][m][1];
                        if (sig) {
#pragma unroll
                            for (int j = 0; j < 4; ++j) { v0[j] = fast_sigmoid(v0[j]); v1[j] = fast_sigmoid(v1[j]); } }
                        *(u32x4*)(rowp + c) = pack8(v0, v1); } } }
    }
};
struct EpiMerged {
    static constexpr bool AFTER_DRAIN = false, HOOK = true; int hook_t;
    const bf16_t* GATES; bf16_t* MERGED;
    __device__ __forceinline__ void hook(Acc& acc, const Unit& u, int wr, int wc, int fr, int fq) const {
#pragma unroll
        for (int ai = 0; ai < 2; ++ai)
#pragma unroll
            for (int m = 0; m < 4; ++m) { const bf16_t* g = GATES + (size_t)GE_ROW(ai, m) * NGATE;
#pragma unroll
                for (int bj = 0; bj < 2; ++bj) { const int c = GE_COL(bj); f32x4 r0, r1, a0, a1;
                    unpack8(*(const u32x4*)(g + c), r0, r1); unpack8(*(const u32x4*)(g + 1024 + c), a0, a1);
#pragma unroll
                    for (int j = 0; j < 4; ++j) { acc[ai][bj][m][0][j] *= r0[j] * __builtin_amdgcn_rcpf(a0[j]); acc[ai][bj][m][1][j] *= r1[j] * __builtin_amdgcn_rcpf(a1[j]); } } }
    }
    __device__ __forceinline__ void operator()(const Acc& acc, const Unit& u, int wr, int wc, int fr, int fq) const {
#pragma unroll
        for (int ai = 0; ai < 2; ++ai)
#pragma unroll
            for (int m = 0; m < 4; ++m) { const size_t r = (size_t)GE_ROW(ai, m);
#pragma unroll
                for (int bj = 0; bj < 2; ++bj) { const int c = GE_COL(bj); f32x4 a0, a1;
                    unpack8(*(const u32x4*)(GATES + r * NGATE + 1024 + c), a0, a1);
                    *(u32x4*)(MERGED + r * D + c) = pack8(acc[ai][bj][m][0] * a0, acc[ai][bj][m][1] * a1); } }
    }
};
struct EpiResid {
    static constexpr bool AFTER_DRAIN = false, HOOK = false; int hook_t;
    const float* base; float* out; bf16_t* hb; float* SS;
    __device__ __forceinline__ void hook(Acc&, const Unit&, int, int, int, int) const {}
    __device__ __forceinline__ void operator()(const Acc& acc, const Unit& u, int wr, int wc, int fr, int fq) const {
#pragma unroll
        for (int ai = 0; ai < 2; ++ai)
#pragma unroll
            for (int m = 0; m < 4; ++m) { const size_t r = (size_t)GE_ROW(ai, m); float ss = 0.f;
#pragma unroll
                for (int bj = 0; bj < 2; ++bj) { const int c = GE_COL(bj);
                    const f32x4 o0 = *(const f32x4*)(base + r * D + c) + acc[ai][bj][m][0], o1 = *(const f32x4*)(base + r * D + c + 4) + acc[ai][bj][m][1];
                    *(f32x4*)(out + r * D + c) = o0; *(f32x4*)(out + r * D + c + 4) = o1;
                    ss += (o0[0] * o0[0] + o0[1] * o0[1]) + (o0[2] * o0[2] + o0[3] * o0[3]) + (o1[0] * o1[0] + o1[1] * o1[1]) + (o1[2] * o1[2] + o1[3] * o1[3]);
                    if (hb) *(u32x4*)(hb + r * D + c) = pack8(o0, o1); }
                ss += __shfl_xor(ss, 16); ss += __shfl_xor(ss, 32);
                if (fq == 0) SS[r * 16 + u.pn * 4 + wc] = ss; }
    }
};
__device__ __forceinline__ float rstd_from_ss(const float* SS, size_t r) {
    const f32x4 a = *(const f32x4*)(SS + r * 16), b = *(const f32x4*)(SS + r * 16 + 4), c = *(const f32x4*)(SS + r * 16 + 8), d = *(const f32x4*)(SS + r * 16 + 12);
    const float s = ((a[0] + a[1]) + (a[2] + a[3])) + ((b[0] + b[1]) + (b[2] + b[3])) + ((c[0] + c[1]) + (c[2] + c[3])) + ((d[0] + d[1]) + (d[2] + d[3]));
    return rsqrtf(s * (1.f / D) + 1e-6f);
}
struct EpiRelu2 {
    static constexpr bool AFTER_DRAIN = false, HOOK = false; int hook_t;
    const float* SS; bf16_t* ACT;
    __device__ __forceinline__ void hook(Acc&, const Unit&, int, int, int, int) const {}
    __device__ __forceinline__ void operator()(const Acc& acc, const Unit& u, int wr, int wc, int fr, int fq) const {
#pragma unroll
        for (int ai = 0; ai < 2; ++ai)
#pragma unroll
            for (int m = 0; m < 4; ++m) { const size_t r = (size_t)GE_ROW(ai, m); const float rstd = rstd_from_ss(SS, r);
#pragma unroll
                for (int bj = 0; bj < 2; ++bj) { const int c = GE_COL(bj); f32x4 v0 = acc[ai][bj][m][0] * rstd, v1 = acc[ai][bj][m][1] * rstd;
#pragma unroll
                    for (int j = 0; j < 4; ++j) { const float a = fmaxf(v0[j], 0.f), b = fmaxf(v1[j], 0.f); v0[j] = a * a; v1[j] = b * b; }
                    *(u32x4*)(ACT + r * FF + c) = pack8(v0, v1); } }
    }
};
struct EpiSoftmax {
    static constexpr bool AFTER_DRAIN = true, HOOK = false; int hook_t;
    const float* SS; bf16_t* PROB;
    __device__ __forceinline__ void hook(Acc&, const Unit&, int, int, int, int) const {}
    __device__ __forceinline__ void operator()(const Acc&, const Unit&, int, int, int, int) const {}
    __device__ __forceinline__ void fused(Acc& acc, const Unit& u, int wr, int wc, int fr, int fq, LAS unsigned char* lds, int wid, int lane) const {
        LAS float* Pm = (LAS float*)lds; LAS float* Ps = Pm + 1024;
#pragma unroll
        for (int ai = 0; ai < 2; ++ai)
#pragma unroll
            for (int m = 0; m < 4; ++m) { const float rstd = rstd_from_ss(SS, (size_t)GE_ROW(ai, m)); float mx = -INFINITY;
#pragma unroll
                for (int bj = 0; bj < 2; ++bj)
#pragma unroll
                    for (int n = 0; n < 2; ++n)
#pragma unroll
                        for (int j = 0; j < 4; ++j) { const float s = acc[ai][bj][m][n][j] * rstd; acc[ai][bj][m][n][j] = s; mx = fmaxf(mx, s); }
                mx = fmaxf(mx, __shfl_xor(mx, 16)); mx = fmaxf(mx, __shfl_xor(mx, 32));
                if (fq == 0) Pm[(ai * 128 + wr * 64 + m * 16 + fr) * 4 + wc] = mx; }
        asm volatile("s_waitcnt lgkmcnt(0)" ::: "memory"); __builtin_amdgcn_s_barrier(); asm volatile("" ::: "memory");
#pragma unroll
        for (int ai = 0; ai < 2; ++ai)
#pragma unroll
            for (int m = 0; m < 4; ++m) { const int rl = ai * 128 + wr * 64 + m * 16 + fr; const f32x4 pm4 = *(const LAS f32x4*)(Pm + rl * 4);
                const float mx = fmaxf(fmaxf(pm4[0], pm4[1]), fmaxf(pm4[2], pm4[3])) * 1.44269504f; float sum = 0.f;
#pragma unroll
                for (int bj = 0; bj < 2; ++bj)
#pragma unroll
                    for (int n = 0; n < 2; ++n)
#pragma unroll
                        for (int j = 0; j < 4; ++j) { const float e = __builtin_amdgcn_exp2f(acc[ai][bj][m][n][j] * 1.44269504f - mx); acc[ai][bj][m][n][j] = e; sum += e; }
                sum += __shfl_xor(sum, 16); sum += __shfl_xor(sum, 32);
                if (fq == 0) Ps[rl * 4 + wc] = sum; }
        asm volatile("s_waitcnt lgkmcnt(0)" ::: "memory"); __builtin_amdgcn_s_barrier(); asm volatile("" ::: "memory");
#pragma unroll
        for (int ai = 0; ai < 2; ++ai)
#pragma unroll
            for (int m = 0; m < 4; ++m) { const int rl = ai * 128 + wr * 64 + m * 16 + fr; const f32x4 ps4 = *(const LAS f32x4*)(Ps + rl * 4);
                const float inv = 1.f / ((ps4[0] + ps4[1]) + (ps4[2] + ps4[3])); const size_t r = (size_t)GE_ROW(ai, m);
#pragma unroll
                for (int bj = 0; bj < 2; ++bj) *(u32x4*)(PROB + r * D + GE_COL(bj)) = pack8(acc[ai][bj][m][0] * inv, acc[ai][bj][m][1] * inv); }
    }
};
}

__device__ __forceinline__ void transpose_item(const float* W, int ldw, int k0, int n0, bf16_t* WT, int ldt, int drow0, int dk0, const float* kscale, LAS float* scr, int lane) {
#pragma unroll 8
    for (int i = 0; i < 32; ++i) { const int kk = 2 * i + (lane >> 5); float v = W[(size_t)(k0 + kk) * ldw + n0 + (lane & 31)]; if (kscale) v *= kscale[k0 + kk]; scr[kk * 33 + (lane & 31)] = v; }
    asm volatile("s_waitcnt lgkmcnt(0)" ::: "memory");
    const int c = lane & 7;
#pragma unroll
    for (int j = 0; j < 4; ++j) { const int n = (lane >> 3) + 8 * j; const LAS float* s = scr + (8 * c) * 33 + n;
        u32x4 o; o.x = ge::cvt_pk_bf16(s[0 * 33], s[1 * 33]); o.y = ge::cvt_pk_bf16(s[2 * 33], s[3 * 33]); o.z = ge::cvt_pk_bf16(s[4 * 33], s[5 * 33]); o.w = ge::cvt_pk_bf16(s[6 * 33], s[7 * 33]);
        *(u32x4*)(WT + (size_t)(drow0 + n) * ldt + dk0 + k0 + 8 * c) = o; }
    asm volatile("s_waitcnt lgkmcnt(0)" ::: "memory");
}
__device__ __forceinline__ void transpose_matrix(const float* W, int K, int N, bf16_t* WT, int ldt, int dk0, const float* kscale, LAS float* scr, int lane, int gw, int NGW) {
    const int nblk = N / 32, items = (K / 64) * nblk;
    for (int it = gw; it < items; it += NGW) { const int kb = it / nblk, nb = it % nblk; transpose_item(W, N, kb * 64, nb * 32, WT, ldt, nb * 32, dk0, kscale, scr, lane); }
}
namespace ge {
struct EpiScaleCol {
    static constexpr bool AFTER_DRAIN = false, HOOK = false; int hook_t;
    const float* colscale; float mul; bool use_cs; bf16_t* out; int ld;
    __device__ __forceinline__ void hook(Acc&, const Unit&, int, int, int, int) const {}
    __device__ __forceinline__ void operator()(const Acc& acc, const Unit& u, int wr, int wc, int fr, int fq) const {
#pragma unroll
        for (int bj = 0; bj < 2; ++bj) { const int c = GE_COL(bj);
            f32x4 s0 = (f32x4){mul, mul, mul, mul}, s1 = s0;
            if (use_cs) { s0 = s0 * *(const f32x4*)(colscale + c); s1 = s1 * *(const f32x4*)(colscale + c + 4); }
#pragma unroll
            for (int ai = 0; ai < 2; ++ai)
#pragma unroll
                for (int m = 0; m < 4; ++m) *(u32x4*)(out + (size_t)GE_ROW(ai, m) * ld + c) = pack8(acc[ai][bj][m][0] * s0, acc[ai][bj][m][1] * s1); }
    }
};
struct SchedOne {
    bool has; Unit u;
    __device__ __forceinline__ bool next(int i, Unit& o) const { if (i > 0 || !has) return false; o = u; return true; }
};
struct SchedProj {
    Order o; const char* XN; const char* WINT; const char* MEMN; const char* WKVT;
    __device__ __forceinline__ bool next(int i, Unit& u) const {
        int pm, pn; if (o.next(i, pm, pn)) { u.pm = pm; u.pn = pn; u.A = XN + (size_t)pm * (256 * D * 2); u.B = WINT + (size_t)pn * (256 * D * 2); return true; }
        const long L = (long)i * o.G + o.c - o.nwg; if (L < 0 || L >= 16) return false;
        u.pm = (int)(L >> 3); u.pn = 100 + (int)(L & 7); u.A = MEMN + (size_t)u.pm * (256 * D * 2); u.B = WKVT + (size_t)(L & 7) * (256 * D * 2); return true;
    }
};
}

namespace sc {
constexpr int RS = 72, FS = 68, AL = 296;
constexpr int O_X = 0;
constexpr int O_LAK = 0, O_URB = 9216, O_URK = 18432, O_T = 27648;
constexpr int O_LW = 37888;
constexpr int O_AT = 55296, O_BT = 64512, O_KT = 73728, O_RT = 82944, O_BHT = 92160, O_KHT = 101376, O_VT = 110592, O_S = 119808, O_RHST = 129024, O_CMT = 138240;
constexpr int O_LABB = O_CMT;
constexpr int O_YF = O_AT;
constexpr int O_TTD = O_KT, O_X1T = O_KT + 3072, O_TT32 = O_KT + 4608, O_X2T = O_KT;
constexpr int O_S1 = O_RT, O_RHST1 = O_URB, O_CMT1 = O_URK;
constexpr int O_ZA = 0, O_ZB = 0;
constexpr int O_MH = O_AT, O_ML = O_BT, O_SH = O_KT, O_SL = O_RT;
constexpr int O_GC = 147456, O_BON = O_GC + 256, O_SEG = O_BON + 256, O_END = O_SEG + 2048;
static_assert(O_TT32 + 32 * 40 * 2 <= O_RT, "inverse scratch inside the Kt slot");
typedef unsigned long long u64;
__device__ __forceinline__ f32x4 mma(bf16x8 x, bf16x8 y, f32x4 c) { return __builtin_amdgcn_mfma_f32_16x16x32_bf16(x, y, c, 0, 0, 0); }
__device__ __forceinline__ bf16x8 ldfrag(LAS const unsigned char* base, int rs, int row, int k) { return *(const LAS bf16x8*)(base + (row * rs + k) * 2); }
__device__ __forceinline__ u64 pack4(f32x4 v) { return (u64)ge::cvt_pk_bf16(v[0], v[1]) | ((u64)ge::cvt_pk_bf16(v[2], v[3]) << 32); }
__device__ __forceinline__ void st4(LAS unsigned char* base, int rs, int row, int col, f32x4 v) { *(LAS u64*)(base + (row * rs + col) * 2) = pack4(v); }
__device__ __forceinline__ void st1(LAS unsigned char* base, int rs, int row, int col, float v) { *(LAS bf16_t*)(base + (row * rs + col) * 2) = (bf16_t)(ge::cvt_pk_bf16(v, v) & 0xffffu); }
__device__ __forceinline__ f32x4 ld4bf(const bf16_t* p) { const u64 w = *(const u64*)p; f32x4 v; v[0] = __uint_as_float((unsigned)w << 16); v[1] = __uint_as_float((unsigned)w & 0xffff0000u);
    v[2] = __uint_as_float((unsigned)(w >> 32) << 16); v[3] = __uint_as_float((unsigned)(w >> 32) & 0xffff0000u); return v; }
__device__ __forceinline__ f32x4 exp4(f32x4 x) { f32x4 r; r[0] = __expf(x[0]); r[1] = __expf(x[1]); r[2] = __expf(x[2]); r[3] = __expf(x[3]); return r; }
#define SC_BAR() do { asm volatile("s_waitcnt vmcnt(0) lgkmcnt(0)" ::: "memory"); __builtin_amdgcn_s_barrier(); asm volatile("" ::: "memory"); } while (0)
#define SC_LWAIT() asm volatile("s_waitcnt lgkmcnt(0)" ::: "memory")

template <bool P1>
__device__ __forceinline__ void scan_seg(const Args& a, LAS unsigned char* L, const int b, const int h, const int seg) {
    constexpr int NH = P1 ? 2 : 1;
    int tid_o = threadIdx.x; asm volatile("" : "+v"(tid_o));
    const int tid = tid_o, w = __builtin_amdgcn_readfirstlane(tid >> 6);
    const int ts = w & 3, half = w >> 2;
    const int rt = w >> 1, ct0 = (w & 1) * 2;
    const int t0 = seg * 1024, nchunks = 16;
    const bf16_t* RKVp = (const bf16_t*)(a.ws + WS_RKV); const bf16_t* LORAp = (const bf16_t*)(a.ws + WS_LORA); bf16_t* ACATp = (bf16_t*)(a.ws + WS_ACAT);
    const bf16_t* W2T = (const bf16_t*)(a.ws + WS_LW2T); const bf16_t* A2T = (const bf16_t*)(a.ws + WS_LA2T); const bf16_t* G2T = (const bf16_t*)(a.ws + WS_LG2T);
    float* MN = (float*)(a.ws + WS_MN);
    const float* mu = a.in[I_MU];
    const int hj0 = h * 64;
    LAS float* LW = (LAS float*)(L + O_LW); LAS float* GC = (LAS float*)(L + O_GC); LAS float* BON = (LAS float*)(L + O_BON); LAS float* SEG = (LAS float*)(L + O_SEG);
    LAS float* YF = (LAS float*)(L + O_YF);
    f32x4 zacc[NH][2];
    {
        const int lane = tid & 63, tl = lane & 15, q = lane >> 4;
#pragma unroll
        for (int hf = 0; hf < NH; ++hf)
#pragma unroll
            for (int c = 0; c < 2; ++c)
#pragma unroll
                for (int e = 0; e < 4; ++e) zacc[hf][c][e] = (hf == 1 && (16 * rt + 4 * q + e) == (16 * (ct0 + c) + tl)) ? 1.f : 0.f;
        if (!P1 && seg > 0) {
            for (int s2 = 0; s2 < seg; ++s2) {
                const float* mn = MN + (size_t)(((b * 16 + h) * 8) + s2) * (64 * 128);
                { const int row = tid >> 3, c8 = (tid & 7) * 8;
                  const f32x4 m0 = *(const f32x4*)(mn + row * 128 + 64 + c8), m1 = *(const f32x4*)(mn + row * 128 + 64 + c8 + 4);
                  const u32x4 hi = ge::pack8(m0, m1); f32x4 h0, h1; ge::unpack8(hi, h0, h1);
                  *(LAS u32x4*)(L + O_MH + (row * RS + c8) * 2) = hi; *(LAS u32x4*)(L + O_ML + (row * RS + c8) * 2) = ge::pack8(m0 - h0, m1 - h1); }
                f32x4 zn[2];
#pragma unroll
                for (int c = 0; c < 2; ++c) {
                    const u64 hi = pack4(zacc[0][c]); f32x4 hv; hv[0] = __uint_as_float((unsigned)hi << 16); hv[1] = __uint_as_float((unsigned)hi & 0xffff0000u);
                    hv[2] = __uint_as_float((unsigned)(hi >> 32) << 16); hv[3] = __uint_as_float((unsigned)(hi >> 32) & 0xffff0000u);
                    *(LAS u64*)(L + O_SH + ((16 * (ct0 + c) + tl) * RS + 16 * rt + 4 * q) * 2) = hi; st4(L + O_SL, RS, 16 * (ct0 + c) + tl, 16 * rt + 4 * q, zacc[0][c] - hv);
#pragma unroll
                    for (int e = 0; e < 4; ++e) zn[c][e] = mn[(16 * rt + 4 * q + e) * 128 + 16 * (ct0 + c) + tl];
                }
                SC_BAR();
#pragma unroll
                for (int ks = 0; ks < 2; ++ks) {
                    const int k = ks * 32 + 8 * q;
                    const bf16x8 xh = ldfrag(L + O_MH, RS, 16 * rt + tl, k), xl = ldfrag(L + O_ML, RS, 16 * rt + tl, k);
#pragma unroll
                    for (int c = 0; c < 2; ++c) { const int cr = 16 * (ct0 + c) + tl; const bf16x8 yh = ldfrag(L + O_SH, RS, cr, k), yl = ldfrag(L + O_SL, RS, cr, k);
                        zn[c] = mma(xh, yh, zn[c]); zn[c] = mma(xh, yl, zn[c]); zn[c] = mma(xl, yh, zn[c]); }
                }
                zacc[0][0] = zn[0]; zacc[0][1] = zn[1];
                SC_BAR();
            }
        }
#pragma unroll
        for (int c = 0; c < 2; ++c) { st4(L + O_S, RS, 16 * (ct0 + c) + tl, 16 * rt + 4 * q, zacc[0][c]); if (P1) st4(L + O_S1, RS, 16 * (ct0 + c) + tl, 16 * rt + 4 * q, zacc[NH - 1][c]); }
    }

    for (int ch = 0; ch < nchunks; ++ch) {
        const int tc0 = t0 + ch * 64;
        int lane_o = tid & 63; asm volatile("" : "+v"(lane_o));
        const int lane = lane_o, tl = lane & 15, q = lane >> 4;
        const size_t m0 = (size_t)b * SEQ + tc0;
        for (int it = tid; it < 64 * 36; it += NTHREADS) {
            const int t = it / 36, c8 = it % 36;
            f32x4 c0, c1, p0, p1;
            ge::unpack8(*(const u32x4*)(LORAp + (m0 + t) * NLORA + c8 * 8), c0, c1);
            if (tc0 + t == 0) { p0 = (f32x4){0.f, 0.f, 0.f, 0.f}; p1 = p0; } else ge::unpack8(*(const u32x4*)(LORAp + (m0 + t - 1) * NLORA + c8 * 8), p0, p1);
            const f32x4 m0v = *(const f32x4*)(mu + C_LORA + c8 * 8), m1v = *(const f32x4*)(mu + C_LORA + c8 * 8 + 4);
            f32x4 s0 = c0 + m0v * (p0 - c0), s1 = c1 + m1v * (p1 - c1);
            if (c8 < 8) {
#pragma unroll
                for (int j = 0; j < 4; ++j) { s0[j] = 1.f - 2.f * __builtin_amdgcn_rcpf(1.f + __expf(2.f * s0[j])); s1[j] = 1.f - 2.f * __builtin_amdgcn_rcpf(1.f + __expf(2.f * s1[j])); }
            } else if (c8 >= 16) {
#pragma unroll
                for (int j = 0; j < 4; ++j) { s0[j] = ge::fast_sigmoid(s0[j]); s1[j] = ge::fast_sigmoid(s1[j]); }
            }
            *(LAS u32x4*)(L + O_X + (t * AL + c8 * 8) * 2) = ge::pack8(s0, s1);
        }
        SC_BAR();
        const int t = 16 * ts + tl;
        const bool first = (tc0 + t == 0);
        f32x4 va[4], vb[4], vk[4];
#define vr va
#define vv vb
#define vg vk
        if (half == 0) {
            f32x4 aw[4], aa[4];
#pragma unroll
            for (int jt = 0; jt < 4; ++jt) { aw[jt] = (f32x4){0.f, 0.f, 0.f, 0.f}; aa[jt] = aw[jt]; }
#pragma unroll
            for (int ks = 0; ks < 2; ++ks) {
                const bf16x8 yw = ldfrag(L + O_X, AL, t, ks * 32 + 8 * q), ya = ldfrag(L + O_X, AL, t, 64 + ks * 32 + 8 * q);
#pragma unroll
                for (int jt = 0; jt < 4; ++jt) {
                    const bf16x8 xw = *(const bf16x8*)(W2T + (size_t)(hj0 + 16 * jt + tl) * 64 + ks * 32 + 8 * q), xa = *(const bf16x8*)(A2T + (size_t)(hj0 + 16 * jt + tl) * 64 + ks * 32 + 8 * q);
                    aw[jt] = mma(xw, yw, aw[jt]); aa[jt] = mma(xa, ya, aa[jt]);
                }
            }
            float ss = 0.f;
#pragma unroll
            for (int jt = 0; jt < 4; ++jt) {
                const int j = 16 * jt + 4 * q, hj = hj0 + j;
                const f32x4 w0v = *(const f32x4*)(a.in[I_W0] + hj), a0v = *(const f32x4*)(a.in[I_A0] + hj), kkv = *(const f32x4*)(a.in[I_KK] + hj), kav = *(const f32x4*)(a.in[I_KA] + hj);
                const f32x4 kc = ld4bf(RKVp + (m0 + t) * NRKV + 1024 + hj);
                f32x4 kp = (f32x4){0.f, 0.f, 0.f, 0.f};
                if (!first) kp = ld4bf(RKVp + (m0 + t - 1) * NRKV + 1024 + hj);
                const f32x4 pk = kc + *(const f32x4*)(mu + 1024 + hj) * (kp - kc);
                f32x4 lw, alr;
#pragma unroll
                for (int e = 0; e < 4; ++e) {
                    const float z = -(aw[jt][e] + w0v[e]);
                    const float sp = fmaxf(z, 0.f) + __logf(1.f + __expf(-fabsf(z)));
                    lw[e] = -__expf(-sp - 0.5f);
                    alr[e] = ge::fast_sigmoid(aa[jt][e] + a0v[e]);
                }
                const f32x4 kr = pk * kkv;
                ss += (kr[0] * kr[0] + kr[1] * kr[1]) + (kr[2] * kr[2] + kr[3] * kr[3]);
                const f32x4 km = pk * (1.f + (alr - 1.f) * kav);
                va[jt] = kr; vb[jt] = alr; vk[jt] = km;
                *(LAS f32x4*)(LW + t * FS + j) = lw;
            }
            ss += __shfl_xor(ss, 16); ss += __shfl_xor(ss, 32);
            const float inv = 1.f / fmaxf(sqrtf(ss), 1e-12f);
#pragma unroll
            for (int jt = 0; jt < 4; ++jt) { const f32x4 kk = va[jt] * inv; va[jt] = -kk; vb[jt] = kk * vb[jt]; }
        } else {
            f32x4 ag[4];
#pragma unroll
            for (int jt = 0; jt < 4; ++jt) ag[jt] = (f32x4){0.f, 0.f, 0.f, 0.f};
            if (!P1) {
#pragma unroll
                for (int ks = 0; ks < 5; ++ks) {
                    const bf16x8 yg = ldfrag(L + O_X, AL, t, 128 + ks * 32 + 8 * q);
#pragma unroll
                    for (int jt = 0; jt < 4; ++jt) { const bf16x8 xg = *(const bf16x8*)(G2T + (size_t)(hj0 + 16 * jt + tl) * 160 + ks * 32 + 8 * q); ag[jt] = mma(xg, yg, ag[jt]); }
                }
            }
#pragma unroll
            for (int jt = 0; jt < 4; ++jt) {
                const int hj = hj0 + 16 * jt + 4 * q;
                const f32x4 vc = ld4bf(RKVp + (m0 + t) * NRKV + 2048 + hj);
                f32x4 vp = (f32x4){0.f, 0.f, 0.f, 0.f};
                if (!first) vp = ld4bf(RKVp + (m0 + t - 1) * NRKV + 2048 + hj);
                vv[jt] = vc + *(const f32x4*)(mu + 2048 + hj) * (vp - vc); vg[jt] = ag[jt];
                if (!P1) { const f32x4 rc = ld4bf(RKVp + (m0 + t) * NRKV + hj); f32x4 rp = (f32x4){0.f, 0.f, 0.f, 0.f}; if (!first) rp = ld4bf(RKVp + (m0 + t - 1) * NRKV + hj);
                    vr[jt] = rc + *(const f32x4*)(mu + hj) * (rp - rc); }
            }
        }
        SC_BAR();
        { const int j = tid & 63, sg = tid >> 6; float s = 0.f;
#pragma unroll
          for (int tt = 0; tt < 8; ++tt) { s += LW[(8 * sg + tt) * FS + j]; LW[(8 * sg + tt) * FS + j] = s; }
          SEG[sg * 64 + j] = s;
          SC_BAR();
          float off = 0.f;
          for (int s2 = 0; s2 < sg; ++s2) off += SEG[s2 * 64 + j];
#pragma unroll
          for (int tt = 0; tt < 8; ++tt) LW[(8 * sg + tt) * FS + j] += off;
        }
        SC_BAR();
#pragma unroll
        for (int jt = 0; jt < 4; ++jt) {
            const int j = 16 * jt + 4 * q;
            const f32x4 cum = *(const LAS f32x4*)(LW + t * FS + j), cumC = *(const LAS f32x4*)(LW + 63 * FS + j);
            if (half == 0) {
                f32x4 cprev = (f32x4){0.f, 0.f, 0.f, 0.f}; if (t > 0) cprev = *(const LAS f32x4*)(LW + (t - 1) * FS + j);
                const f32x4 eprev = exp4(cprev), einv = exp4(-cum), erem = exp4(cumC - cum);
                st4(L + O_AT, RS, t, j, va[jt] * eprev); st4(L + O_BT, RS, t, j, vb[jt] * einv); st4(L + O_KT, RS, t, j, vk[jt] * einv);
                const f32x4 bh = vb[jt] * erem, kh = vk[jt] * erem;
#pragma unroll
                for (int e = 0; e < 4; ++e) { st1(L + O_BHT, RS, j + e, t, bh[e]); st1(L + O_KHT, RS, j + e, t, kh[e]); }
            } else {
                if (!P1) st4(L + O_RT, RS, t, j, vr[jt] * exp4(cum));
#pragma unroll
                for (int e = 0; e < 4; ++e) st1(L + O_VT, RS, j + e, t, vv[jt][e]);
                if (ts == 0 && tl == 0) *(LAS f32x4*)(GC + j) = exp4(cumC);
            }
        }
        SC_BAR();
        f32x4 pacc[NH][2], yacc[2];
        {
            f32x4 lab[2], lak[2], urb[2], urk[2];
#pragma unroll
            for (int c = 0; c < 2; ++c) { lab[c] = (f32x4){0.f, 0.f, 0.f, 0.f}; lak[c] = lab[c]; urb[c] = lab[c]; urk[c] = lab[c]; yacc[c] = lab[c];
#pragma unroll
                for (int hf = 0; hf < NH; ++hf) pacc[hf][c] = lab[c]; }
            const f32x4 gc = *(const LAS f32x4*)(GC + 16 * rt + 4 * q);
#pragma unroll
            for (int hf = 0; hf < NH; ++hf) { zacc[hf][0] = zacc[hf][0] * gc; zacc[hf][1] = zacc[hf][1] * gc; }
#pragma unroll
            for (int ks = 0; ks < 2; ++ks) {
                const int k = ks * 32 + 8 * q;
                const bf16x8 xb = ldfrag(L + O_BT, RS, 16 * rt + tl, k), xk = ldfrag(L + O_KT, RS, 16 * rt + tl, k), xa = ldfrag(L + O_AT, RS, 16 * rt + tl, k);
                const bf16x8 xkh = ldfrag(L + O_KHT, RS, 16 * rt + tl, k);
#pragma unroll
                for (int c = 0; c < 2; ++c) {
                    const int cr = 16 * (ct0 + c) + tl;
                    const bf16x8 ya = ldfrag(L + O_AT, RS, cr, k), ys = ldfrag(L + O_S, RS, cr, k), yv = ldfrag(L + O_VT, RS, cr, k);
                    lab[c] = mma(xb, ya, lab[c]); lak[c] = mma(xk, ya, lak[c]);
                    pacc[0][c] = mma(xa, ys, pacc[0][c]);
                    if (P1) pacc[NH - 1][c] = mma(xa, ldfrag(L + O_S1, RS, cr, k), pacc[NH - 1][c]);
                    zacc[0][c] = mma(xkh, yv, zacc[0][c]);
                    if (!P1) { const bf16x8 yr = ldfrag(L + O_RT, RS, cr, k), xs = ldfrag(L + O_S, RS, 16 * rt + tl, k);
                        urb[c] = mma(xb, yr, urb[c]); urk[c] = mma(xk, yr, urk[c]);
                        yacc[c] = mma(xs, yr, yacc[c]); }
                }
            }
#pragma unroll
            for (int c = 0; c < 2; ++c) {
                const int tcol = 16 * (ct0 + c) + tl, u0 = 16 * rt + 4 * q;
#pragma unroll
                for (int e = 0; e < 4; ++e) { const bool lt = (u0 + e) < tcol, le = (u0 + e) <= tcol; lab[c][e] = lt ? lab[c][e] : 0.f; lak[c][e] = lt ? lak[c][e] : 0.f; urb[c][e] = le ? urb[c][e] : 0.f; urk[c][e] = le ? urk[c][e] : 0.f; }
                *(LAS f32x4*)(LW + tcol * FS + u0) = lab[c];
                st4(L + O_LABB, RS, tcol, u0, lab[c]); st4(L + O_LAK, RS, tcol, u0, lak[c]);
                if (!P1) { st4(L + O_URB, RS, tcol, u0, urb[c]); st4(L + O_URK, RS, tcol, u0, urk[c]); }
            }
            if (!P1) {
                const int tb = tid >> 3, j8 = (tid & 7) * 8;
                f32x4 r0, r1, k0, k1; ge::unpack8(*(const LAS u32x4*)(L + O_RT + (tb * RS + j8) * 2), r0, r1); ge::unpack8(*(const LAS u32x4*)(L + O_KT + (tb * RS + j8) * 2), k0, k1);
                const f32x4 p0 = r0 * k0 * *(const f32x4*)(a.in[I_RK] + hj0 + j8), p1 = r1 * k1 * *(const f32x4*)(a.in[I_RK] + hj0 + j8 + 4);
                float bs = ((p0[0] + p0[1]) + (p0[2] + p0[3])) + ((p1[0] + p1[1]) + (p1[2] + p1[3]));
                bs += __shfl_xor(bs, 1); bs += __shfl_xor(bs, 2); bs += __shfl_xor(bs, 4);
                if ((tid & 7) == 0) BON[tb] = bs;
            }
        }
        SC_BAR();
#pragma unroll
        for (int ks = 0; ks < 2; ++ks) {
            const int k = ks * 32 + 8 * q;
            const bf16x8 xl = ldfrag(L + O_LAK, RS, 16 * rt + tl, k);
#pragma unroll
            for (int c = 0; c < 2; ++c) {
                const int cr = 16 * (ct0 + c) + tl;
                pacc[0][c] = mma(xl, ldfrag(L + O_VT, RS, cr, k), pacc[0][c]);
                if (!P1) yacc[c] = mma(ldfrag(L + O_VT, RS, 16 * rt + tl, k), ldfrag(L + O_URK, RS, cr, k), yacc[c]);
            }
        }
#pragma unroll
        for (int c = 0; c < 2; ++c) { st4(L + O_RHST, RS, 16 * (ct0 + c) + tl, 16 * rt + 4 * q, pacc[0][c]); if (P1) st4(L + O_RHST1, RS, 16 * (ct0 + c) + tl, 16 * rt + 4 * q, pacc[NH - 1][c]); }
        if (w == 0) {
            const unsigned zz = (unsigned)(lane >> 6);
            const u32x4 zv = (u32x4){zz, zz, zz, zz};
            const int p = q, c = tl;
            float Tc[16];
#pragma unroll
            for (int k = 0; k < 16; ++k) Tc[k] = (k == c) ? 1.f : 0.f;
#pragma unroll
            for (int r = 1; r < 16; ++r) {
                const LAS float* lrow = LW + (16 * p + r) * FS + 16 * p;
                float acc0 = 0.f, acc1 = 0.f;
#pragma unroll
                for (int k = 0; k < r; k += 2) { acc0 += lrow[k] * Tc[k]; if (k + 1 < r) acc1 += lrow[k + 1] * Tc[k + 1]; }
                Tc[r] = (r > c) ? (acc0 + acc1) : Tc[r];
            }
            for (int i = lane; i < 6 * 16 * 2; i += 64) { const int blk = i >> 5, rr = (i >> 1) & 15, hf = i & 1;
                const int pr_ = (blk < 3) ? 0 : (blk < 5 ? 1 : 2), qc = (blk < 3) ? blk + 1 : (blk < 5 ? blk - 1 : 3);
                *(LAS u32x4*)(L + O_T + ((16 * pr_ + rr) * RS + 16 * qc + 8 * hf) * 2) = zv; }
#pragma unroll
            for (int k = 0; k < 16; ++k) st1(L + O_T, RS, 16 * p + k, 16 * p + c, Tc[k]);
            { u32x4 w0, w1; w0.x = ge::cvt_pk_bf16(Tc[0], Tc[1]); w0.y = ge::cvt_pk_bf16(Tc[2], Tc[3]); w0.z = ge::cvt_pk_bf16(Tc[4], Tc[5]); w0.w = ge::cvt_pk_bf16(Tc[6], Tc[7]);
              w1.x = ge::cvt_pk_bf16(Tc[8], Tc[9]); w1.y = ge::cvt_pk_bf16(Tc[10], Tc[11]); w1.z = ge::cvt_pk_bf16(Tc[12], Tc[13]); w1.w = ge::cvt_pk_bf16(Tc[14], Tc[15]);
              *(LAS u32x4*)(L + O_TTD + ((p * 16 + c) * 24) * 2) = w0; *(LAS u32x4*)(L + O_TTD + ((p * 16 + c) * 24 + 8) * 2) = w1;
              if (p < 2) {
                  *(LAS u32x4*)(L + O_TT32 + ((16 * p + c) * 40 + 16 * p) * 2) = w0; *(LAS u32x4*)(L + O_TT32 + ((16 * p + c) * 40 + 16 * p + 8) * 2) = w1;
                  if (p == 1) { *(LAS u32x4*)(L + O_TT32 + ((16 + c) * 40) * 2) = zv; *(LAS u32x4*)(L + O_TT32 + ((16 + c) * 40 + 8) * 2) = zv; }
              } }
            SC_LWAIT();
            const bf16x8 zf = (bf16x8){0, 0, 0, 0, 0, 0, 0, 0};
            const f32x4 z4 = (f32x4){0.f, 0.f, 0.f, 0.f};
#pragma unroll
            for (int pi = 0; pi < 2; ++pi) {
                const int pp = 2 * pi + 1, qq = 2 * pi;
                const bf16x8 xl = (q < 2) ? ldfrag(L + O_LABB, RS, 16 * pp + tl, 16 * qq + 8 * q) : zf;
                const bf16x8 yt = (q < 2) ? ldfrag(L + O_TTD, 24, qq * 16 + tl, 8 * q) : zf;
                const f32x4 x1 = mma(xl, yt, z4);
                st4(L + O_X1T, 24, pi * 16 + tl, 4 * q, x1);
                SC_LWAIT();
                const bf16x8 xx = (q < 2) ? ldfrag(L + O_X1T, 24, pi * 16 + tl, 8 * q) : zf;
                const bf16x8 ytp = (q < 2) ? ldfrag(L + O_T, RS, 16 * pp + tl, 16 * pp + 8 * q) : zf;
                const f32x4 tpqT = mma(xx, ytp, z4);
                st4(L + O_T, RS, 16 * pp + tl, 16 * qq + 4 * q, tpqT);
                if (pi == 0) { const f32x4 tpq = mma(ytp, xx, z4);
                    st4(L + O_TT32, 40, tl, 16 + 4 * q, tpq); }
            }
            SC_LWAIT();
            f32x4 x2[2][2];
#pragma unroll
            for (int r2 = 0; r2 < 2; ++r2) { const bf16x8 xl = ldfrag(L + O_LABB, RS, 32 + 16 * r2 + tl, 8 * q);
#pragma unroll
                for (int c2 = 0; c2 < 2; ++c2) x2[r2][c2] = mma(xl, ldfrag(L + O_TT32, 40, 16 * c2 + tl, 8 * q), z4); }
#pragma unroll
            for (int r2 = 0; r2 < 2; ++r2)
#pragma unroll
                for (int c2 = 0; c2 < 2; ++c2) st4(L + O_X2T, 40, 16 * c2 + tl, 16 * r2 + 4 * q, x2[r2][c2]);
            SC_LWAIT();
#pragma unroll
            for (int c2 = 0; c2 < 2; ++c2) { const bf16x8 xx = ldfrag(L + O_X2T, 40, 16 * c2 + tl, 8 * q);
#pragma unroll
                for (int r2 = 0; r2 < 2; ++r2) { const f32x4 d = mma(xx, ldfrag(L + O_T, RS, 32 + 16 * r2 + tl, 32 + 8 * q), z4);
                    st4(L + O_T, RS, 32 + 16 * r2 + tl, 16 * c2 + 4 * q, d); } }
        }
        SC_BAR();
        {
            f32x4 cacc[NH][2];
#pragma unroll
            for (int hf = 0; hf < NH; ++hf) { cacc[hf][0] = (f32x4){0.f, 0.f, 0.f, 0.f}; cacc[hf][1] = cacc[hf][0]; }
#pragma unroll
            for (int ks = 0; ks < 2; ++ks) {
                const int k = ks * 32 + 8 * q;
                const bf16x8 xt = ldfrag(L + O_T, RS, 16 * rt + tl, k);
#pragma unroll
                for (int c = 0; c < 2; ++c) { cacc[0][c] = mma(xt, ldfrag(L + O_RHST, RS, 16 * (ct0 + c) + tl, k), cacc[0][c]);
                    if (P1) cacc[NH - 1][c] = mma(xt, ldfrag(L + O_RHST1, RS, 16 * (ct0 + c) + tl, k), cacc[NH - 1][c]); }
            }
#pragma unroll
            for (int c = 0; c < 2; ++c) { st4(L + O_CMT, RS, 16 * (ct0 + c) + tl, 16 * rt + 4 * q, cacc[0][c]); if (P1) st4(L + O_CMT1, RS, 16 * (ct0 + c) + tl, 16 * rt + 4 * q, cacc[NH - 1][c]); }
        }
        SC_BAR();
#pragma unroll
        for (int ks = 0; ks < 2; ++ks) {
            const int k = ks * 32 + 8 * q;
            const bf16x8 xbh = ldfrag(L + O_BHT, RS, 16 * rt + tl, k);
#pragma unroll
            for (int c = 0; c < 2; ++c) {
                const int cr = 16 * (ct0 + c) + tl;
                zacc[0][c] = mma(xbh, ldfrag(L + O_CMT, RS, cr, k), zacc[0][c]);
                if (P1) zacc[NH - 1][c] = mma(xbh, ldfrag(L + O_CMT1, RS, cr, k), zacc[NH - 1][c]);
                if (!P1) yacc[c] = mma(ldfrag(L + O_CMT, RS, 16 * rt + tl, k), ldfrag(L + O_URB, RS, cr, k), yacc[c]);
            }
        }
#pragma unroll
        for (int c = 0; c < 2; ++c) { st4(L + O_S, RS, 16 * (ct0 + c) + tl, 16 * rt + 4 * q, zacc[0][c]);
            if (P1) st4(L + O_S1, RS, 16 * (ct0 + c) + tl, 16 * rt + 4 * q, zacc[NH - 1][c]);
            else *(LAS f32x4*)(YF + (16 * (ct0 + c) + tl) * FS + 16 * rt + 4 * q) = yacc[c]; }
        SC_BAR();
        if (!P1 && half == 1) {
            f32x4 y[4]; float s = 0.f;
#pragma unroll
            for (int jt = 0; jt < 4; ++jt) { y[jt] = *(const LAS f32x4*)(YF + t * FS + 16 * jt + 4 * q); s += (y[jt][0] + y[jt][1]) + (y[jt][2] + y[jt][3]); }
            s += __shfl_xor(s, 16); s += __shfl_xor(s, 32);
            const float mean = s * (1.f / 64.f); float vs = 0.f;
#pragma unroll
            for (int jt = 0; jt < 4; ++jt) { y[jt] = y[jt] - mean; vs += (y[jt][0] * y[jt][0] + y[jt][1] * y[jt][1]) + (y[jt][2] * y[jt][2] + y[jt][3] * y[jt][3]); }
            vs += __shfl_xor(vs, 16); vs += __shfl_xor(vs, 32);
            const float rstd = rsqrtf(vs * (1.f / 64.f) + 64.f * 1e-5f), bon = BON[t];
#pragma unroll
            for (int jt = 0; jt < 4; ++jt) { const int hi = hj0 + 16 * jt + 4 * q;
                const f32x4 o = (y[jt] * rstd * *(const f32x4*)(a.in[I_GNW] + hi) + *(const f32x4*)(a.in[I_GNB] + hi) + bon * vv[jt]) * vg[jt];
                *(u64*)(ACATp + (m0 + t) * KCAT + hi) = pack4(o); }
        }
    }
    if (P1) {
        const int lane = tid & 63, tl = lane & 15, q = lane >> 4;
        float* mn = MN + (size_t)(((b * 16 + h) * 8) + seg) * (64 * 128);
#pragma unroll
        for (int hf = 0; hf < NH; ++hf)
#pragma unroll
            for (int c = 0; c < 2; ++c)
#pragma unroll
                for (int e = 0; e < 4; ++e) mn[(16 * rt + 4 * q + e) * 128 + hf * 64 + 16 * (ct0 + c) + tl] = zacc[hf][c][e];
    }
}
#undef vr
#undef vv
#undef vg
}
namespace da {
constexpr int OS = 68;
constexpr int O_OACC = 0, O_M = 256 * OS * 4, O_L = O_M + 1024, O_WAVE = O_L + 1024;
constexpr int PST = 168, VST = 72;
constexpr int WAVE_BYTES = 16 * PST * 2 + 32 * VST * 2;
static_assert(O_WAVE + 8 * WAVE_BYTES <= 151552, "attention LDS");
typedef short v4i16_t __attribute__((ext_vector_type(4)));
__device__ __forceinline__ bf16x8 tr8(LAS const unsigned char* p0, LAS const unsigned char* p1) {
    const v4i16_t lo = __builtin_amdgcn_ds_read_tr16_b64_v4i16((LAS v4i16_t*)p0), hi = __builtin_amdgcn_ds_read_tr16_b64_v4i16((LAS v4i16_t*)p1);
    return (bf16x8){lo[0], lo[1], lo[2], lo[3], hi[0], hi[1], hi[2], hi[3]};
}
__device__ __forceinline__ void attn_item(const Args& a, LAS unsigned char* L, const int b, const int slot, const int p0) {
    int tid_o = threadIdx.x; asm volatile("" : "+v"(tid_o));
    const int tid = tid_o, lane = tid & 63, w = __builtin_amdgcn_readfirstlane(tid >> 6), tl = lane & 15, q4 = lane >> 4;
    const bf16_t* AQ = (const bf16_t*)(a.ws + WS_AQKV) + (size_t)b * SEQ * NAQKV;
    bf16_t* ACATp = (bf16_t*)(a.ws + WS_ACAT) + (size_t)b * SEQ * KCAT + 1024 + slot * 64;
    LAS float* OA = (LAS float*)(L + O_OACC); LAS float* MA = (LAS float*)(L + O_M); LAS float* LA = (LAS float*)(L + O_L);
    LAS unsigned char* Pst = L + O_WAVE + w * WAVE_BYTES; LAS unsigned char* Vst = Pst + 16 * PST * 2;
    const bf16x8 zf = (bf16x8){0, 0, 0, 0, 0, 0, 0, 0};
    const f32x4 z4 = (f32x4){0.f, 0.f, 0.f, 0.f};
#pragma unroll 1
    for (int g = 0; g < 3; ++g) {
        const int dsh = 2 * g, d = 1 << dsh, hd = g * 4 + slot;
        const float slope2 = exp2f(-8.f * (float)(hd + 1) / 12.f) * (float)d * 1.44269504f;
        const bf16_t* Qb = AQ + hd * 64; const bf16_t* Kb = Qb + 768; const bf16_t* Vb = Qb + 1536;
#pragma unroll 1
        for (int rr = 0; rr < 2; ++rr) {
            const int rti = w + 8 * rr;
            const int r = (g == 0) ? 0 : (g == 1 ? (rti >> 2) : rti);
            const int j0 = (p0 >> dsh) + ((g == 0) ? 16 * rti : (g == 1 ? 16 * (rti & 3) : 0));
            const int posq = ((j0 + tl) << dsh) + r;
            bf16x8 yq[2];
#pragma unroll
            for (int ks = 0; ks < 2; ++ks) yq[ks] = *(const bf16x8*)(Qb + (size_t)posq * NAQKV + ks * 32 + 8 * q4);
            f32x4 st[9];
#pragma unroll
            for (int kt = 0; kt < 9; ++kt) {
                const int jk = j0 - 128 + 16 * kt + tl;
                bf16x8 x0 = zf, x1 = zf;
                if (jk >= 0) { const bf16_t* kp = Kb + (size_t)((jk << dsh) + r) * NAQKV + 8 * q4; x0 = *(const bf16x8*)kp; x1 = *(const bf16x8*)(kp + 32); }
                st[kt] = sc::mma(x0, yq[0], z4); st[kt] = sc::mma(x1, yq[1], st[kt]);
            }
            float mx = -INFINITY;
#pragma unroll
            for (int kt = 0; kt < 9; ++kt)
#pragma unroll
                for (int e = 0; e < 4; ++e) {
                    const int kq = 16 * kt + 4 * q4 + e, steps = tl + 128 - kq;
                    const bool ok = (steps >= 0) && (steps <= 128) && (j0 - 128 + kq >= 0);
                    const float s = ok ? (st[kt][e] * (0.125f * 1.44269504f) - slope2 * (float)steps) : -INFINITY;
                    st[kt][e] = s; mx = fmaxf(mx, s);
                }
            mx = fmaxf(mx, __shfl_xor(mx, 16)); mx = fmaxf(mx, __shfl_xor(mx, 32));
            float ls = 0.f;
#pragma unroll
            for (int kt = 0; kt < 9; ++kt) {
#pragma unroll
                for (int e = 0; e < 4; ++e) { const float ev = __builtin_amdgcn_exp2f(st[kt][e] - mx); st[kt][e] = ev; ls += ev; }
                *(LAS unsigned long long*)(Pst + (tl * PST + 16 * kt + 4 * q4) * 2) = sc::pack4(st[kt]);
            }
            *(LAS unsigned long long*)(Pst + (tl * PST + 144 + 4 * q4) * 2) = 0ull;
            ls += __shfl_xor(ls, 16); ls += __shfl_xor(ls, 32);
            f32x4 ot[4]; ot[0] = z4; ot[1] = z4; ot[2] = z4; ot[3] = z4;
            u32x4 vreg[4];
#define DA_VLOAD(ks5) do { _Pragma("unroll") for (int i2 = 0; i2 < 4; ++i2) { const int id = lane + 64 * i2, row = id >> 3, chn = id & 7, jk = j0 - 128 + 32 * (ks5) + row; \
                vreg[i2] = (u32x4){0u, 0u, 0u, 0u}; if (jk >= 0 && 32 * (ks5) + row < 144) vreg[i2] = *(const u32x4*)(Vb + (size_t)((jk << dsh) + r) * NAQKV + chn * 8); } } while (0)
            DA_VLOAD(0);
#pragma unroll 1
            for (int ks5 = 0; ks5 < 5; ++ks5) {
#pragma unroll
                for (int i2 = 0; i2 < 4; ++i2) { const int id = lane + 64 * i2, row = id >> 3, chn = id & 7; *(LAS u32x4*)(Vst + (row * VST + chn * 8) * 2) = vreg[i2]; }
                if (ks5 < 4) DA_VLOAD(ks5 + 1);
                asm volatile("s_waitcnt lgkmcnt(0)" ::: "memory");
                const bf16x8 yp = *(const LAS bf16x8*)(Pst + (tl * PST + 32 * ks5 + 8 * q4) * 2);
                const int qq = tl >> 2, pp = tl & 3;
#pragma unroll
                for (int ct = 0; ct < 4; ++ct) {
                    LAS const unsigned char* vp = Vst + ((8 * q4 + qq) * VST + 16 * ct + 4 * pp) * 2;
                    const bf16x8 xv = tr8(vp, vp + 4 * VST * 2);
                    ot[ct] = sc::mma(xv, yp, ot[ct]);
                }
                asm volatile("s_waitcnt lgkmcnt(0)" ::: "memory");
            }
#undef DA_VLOAD
            const int pidx = posq - p0;
            if (g == 0) {
#pragma unroll
                for (int ct = 0; ct < 4; ++ct) *(LAS f32x4*)(OA + pidx * OS + 16 * ct + 4 * q4) = ot[ct];
                if (q4 == 0) { MA[pidx] = mx; LA[pidx] = ls; }
            } else {
                const float mo = MA[pidx], lo = LA[pidx];
                const float mn = fmaxf(mo, mx), fo = __builtin_amdgcn_exp2f(mo - mn), fn = __builtin_amdgcn_exp2f(mx - mn);
                const float ln = lo * fo + ls * fn;
                if (g == 1) {
#pragma unroll
                    for (int ct = 0; ct < 4; ++ct) { LAS f32x4* op = (LAS f32x4*)(OA + pidx * OS + 16 * ct + 4 * q4); *op = *op * fo + ot[ct] * fn; }
                    asm volatile("s_waitcnt lgkmcnt(0)" ::: "memory");
                    if (q4 == 0) { MA[pidx] = mn; LA[pidx] = ln; }
                } else {
                    const float inv = 1.f / ln;
#pragma unroll
                    for (int ct = 0; ct < 4; ++ct) { const f32x4 o = (*(const LAS f32x4*)(OA + pidx * OS + 16 * ct + 4 * q4) * fo + ot[ct] * fn) * inv;
                        *(unsigned long long*)(ACATp + (size_t)posq * KCAT + 16 * ct + 4 * q4) = sc::pack4(o); }
                }
            }
        }
        asm volatile("s_waitcnt vmcnt(0) lgkmcnt(0)" ::: "memory"); __builtin_amdgcn_s_barrier(); asm volatile("" ::: "memory");
    }
}
}
#define XB_TMO      128
#define XB_XCNT(j)  (256  + 64 * (j))
#define XB_XSUB(j)  (1280 + 64 * (j))
#define XB_XGEN(j)  (2304 + 64 * (j))
#define XB_TOP      3328
#define XB_TOPGEN   3392
#define XCD_BAR_WORDS 3456
#define XB_SPIN_CAP (1u << 18)
__device__ __forceinline__ unsigned xb_ld(unsigned* p)              { return __hip_atomic_load(p, __ATOMIC_RELAXED, __HIP_MEMORY_SCOPE_AGENT); }
__device__ __forceinline__ unsigned xb_add(unsigned* p, unsigned v) { return __hip_atomic_fetch_add(p, v, __ATOMIC_RELAXED, __HIP_MEMORY_SCOPE_AGENT); }
__device__ __forceinline__ unsigned xb_xcc_id() { return (unsigned)__builtin_amdgcn_s_getreg((3 << 11) | 20) & 0xFu; }
#define XB_SPIN(cond, bar) do { unsigned _sp = 0; while (cond) { __builtin_amdgcn_s_sleep(1); \
    if ((++_sp & 255u) == 0u) { if (xb_ld(&(bar)[XB_TMO])) break; if (_sp > XB_SPIN_CAP) { atomicAdd(&(bar)[XB_TMO], 1u); break; } } } } while (0)
struct XcdBarrier { unsigned* bar; unsigned x; volatile LAS unsigned* st; };
__device__ __forceinline__ XcdBarrier xcd_barrier_post(unsigned* bar, volatile LAS unsigned* st) {
    XcdBarrier b; b.bar = bar; b.x = xb_xcc_id(); b.st = st;
    if (threadIdx.x == 0) (void)xb_add(&bar[XB_XCNT(b.x)], 1u);
    return b;
}
__device__ __forceinline__ void xcd_barrier_complete(unsigned* bar, unsigned x, unsigned& nloc, unsigned& nx) {
    const unsigned G = gridDim.x * gridDim.y * gridDim.z;
    unsigned sum, cnt, mine, sp = 0u;
    for (;;) {
        sum = 0u; cnt = 0u; mine = 0u;
#pragma unroll
        for (unsigned j = 0; j < 16; ++j) { const unsigned c = xb_ld(&bar[XB_XCNT(j)]); sum += c; cnt += (c > 0u) ? 1u : 0u; mine = (j == x) ? c : mine; }
        if (sum == G) break;
        __builtin_amdgcn_s_sleep(1);
        if ((++sp & 255u) == 0u) { if (xb_ld(&bar[XB_TMO])) break; if (sp > XB_SPIN_CAP) { atomicAdd(&bar[XB_TMO], 1u); break; } }
    }
    nloc = mine > 0u ? mine : 1u; nx = cnt > 0u ? cnt : 1u;
}
__device__ __forceinline__ void xcd_barrier(const XcdBarrier& b) {
    asm volatile("s_waitcnt vmcnt(0)" ::: "memory");
    __syncthreads();
    if (threadIdx.x == 0) {
        unsigned* bar = b.bar;
        __builtin_amdgcn_s_waitcnt(0);
        unsigned nloc = b.st[0], nx = b.st[1];
        if (nloc == 0u) { xcd_barrier_complete(bar, b.x, nloc, nx); b.st[0] = nloc; b.st[1] = nx; }
        const unsigned old = xb_add(&bar[XB_XSUB(b.x)], 1u);
        const unsigned gen = old / nloc;
        if (old + 1u == (gen + 1u) * nloc) {
            __builtin_amdgcn_fence(__ATOMIC_RELEASE, "agent");
            asm volatile("s_waitcnt vmcnt(0)" ::: "memory");
            const unsigned og = xb_add(&bar[XB_TOP], 1u);
            const unsigned tg = og / nx;
            if (og + 1u == (tg + 1u) * nx) xb_add(&bar[XB_TOPGEN], 1u);
            else XB_SPIN(xb_ld(&bar[XB_TOPGEN]) == tg, bar);
            __builtin_amdgcn_fence(__ATOMIC_ACQUIRE, "agent");
            xb_add(&bar[XB_XGEN(b.x)], 1u);
            asm volatile("s_waitcnt vmcnt(0)" ::: "memory");
        } else {
            XB_SPIN(xb_ld(&bar[XB_XGEN(b.x)]) == gen, bar);
            __builtin_amdgcn_fence(__ATOMIC_ACQUIRE, "agent");
            asm volatile("s_waitcnt vmcnt(0)" ::: "memory");
        }
    }
    __syncthreads();
}

#define p_XN ((bf16_t*)(a.ws + WS_XN))
#define p_RKV ((bf16_t*)(a.ws + WS_RKV))
#define p_LORA ((bf16_t*)(a.ws + WS_LORA))
#define p_AQKV ((bf16_t*)(a.ws + WS_AQKV))
#define p_GATES ((bf16_t*)a.out)
#define p_ACAT ((bf16_t*)(a.ws + WS_ACAT))
#define p_WST ((bf16_t*)(a.ws + WS_WST))
#define p_VWT ((bf16_t*)(a.ws + WS_VWT))
#define p_KV ((bf16_t*)(a.ws + WS_KV))
#define p_MEMN ((bf16_t*)(a.ws + WS_MEMN))
#define p_SS1 ((float*)(a.ws + WS_SS1))
#define p_SS2 ((float*)(a.ws + WS_SS2))
#define p_SS3 ((float*)(a.ws + WS_SS3))
#define p_H2B ((bf16_t*)(a.ws + WS_H2B))
#define p_MERGED ((bf16_t*)(a.ws + WS_MERGED))
#define p_H1B ((bf16_t*)(a.ws + WS_H1B))
#define p_PROB ((bf16_t*)(a.ws + WS_PROB))
#define p_ACT ((bf16_t*)(a.ws + WS_ACT))
#define p_WINT ((bf16_t*)(a.ws + WS_WINT))
#define p_PCATT ((bf16_t*)(a.ws + WS_PCATT))
#define p_WOUTT ((bf16_t*)(a.ws + WS_WOUTT))
#define p_W1T ((bf16_t*)(a.ws + WS_W1T))
#define p_W2T ((bf16_t*)(a.ws + WS_W2T))
#define p_WKVT ((bf16_t*)(a.ws + WS_WKVT))
#define p_WQB ((bf16_t*)(a.ws + WS_WQB))
#define p_WOT ((bf16_t*)(a.ws + WS_WOT))
#define p_OUT (a.out)
constexpr int MISC_OFF = LDSCTL_OFF;
__global__ void __launch_bounds__(NTHREADS, 2) mk_fwd(Args a) {
    extern __shared__ __attribute__((aligned(16))) unsigned char lds_raw[];
    float* lds = (float*)lds_raw;
    LAS unsigned char* ldsl = (LAS unsigned char*)lds_raw;
    const int tid = threadIdx.x, lane = tid & 63, wave = tid >> 6;
    const int G = gridDim.x, bid = blockIdx.x;
    const int gw = bid * NWAVES + wave, NGW = G * NWAVES;
    unsigned char* ws = a.ws;
    LAS float* scr = (LAS float*)(ldsl + wave * 16384);

    for (int u = tid; u < (LDS_BYTES - LDSCTL_OFF) / 4; u += NTHREADS) ((LAS unsigned*)(ldsl + LDSCTL_OFF))[u] = 0u;
    __syncthreads();
    XcdBarrier bar = xcd_barrier_post((unsigned*)(ws + WS_CTL) + 4096, (volatile LAS unsigned*)(ldsl + MISC_OFF) + 8);
    cg::grid_group grid = cg::this_grid();

    {
        {
            const float* W = a.in[I_WIN];
            for (int it = gw; it < 16 * 241; it += NGW) { const int kb = it / 241, nb = it % 241, c = nb * 32;
                const int drow = (c < C_LORA) ? c : (c < C_AQ) ? 7424 + (c - C_LORA) : (c < C_GATE) ? 5120 + (c - C_AQ) : 3072 + (c - C_GATE);
                transpose_item(W, NIN, kb * 64, c, p_WINT, D, drow, 0, nullptr, scr, lane); }
            for (int i = gw * 64 + lane; i < 224 * D / 8; i += NGW * 64) *(u32x4*)(p_WINT + (size_t)7712 * D + (size_t)i * 8) = (u32x4){0u, 0u, 0u, 0u};
        }
        for (int i = gw * 64 + lane; i < 1024 * 288; i += NGW * 64) {
            if (i < 1024 * 64) { const int n = i >> 6, c = i & 63; ((bf16_t*)(a.ws + WS_LW2T))[i] = f2bf(a.in[I_W2][c * 1024 + n]); }
            else if (i < 2 * 1024 * 64) { const int i2 = i - 1024 * 64, n = i2 >> 6, c = i2 & 63; ((bf16_t*)(a.ws + WS_LA2T))[i2] = f2bf(a.in[I_A2][c * 1024 + n]); }
            else { const int i2 = i - 2 * 1024 * 64, n = i2 / 160, c = i2 % 160; ((bf16_t*)(a.ws + WS_LG2T))[i2] = f2bf(a.in[I_G2][c * 1024 + n]); }
        }
        transpose_matrix(a.in[I_WKV], 1024, 2048, p_WKVT, D, 0, nullptr, scr, lane, gw, NGW);
        transpose_matrix(a.in[I_PRWKV], 1024, 1024, p_PCATT, KCAT, 0, nullptr, scr, lane, gw, NGW);
        transpose_matrix(a.in[I_PATTN], 256, 1024, p_PCATT, KCAT, 1024, nullptr, scr, lane, gw, NGW);
        transpose_matrix(a.in[I_WOUT], 1024, 1024, p_WOUTT, D, 0, nullptr, scr, lane, gw, NGW);
        transpose_matrix(a.in[I_WO], 1024, 1024, p_WOT, D, 0, nullptr, scr, lane, gw, NGW);
        { const float* WQ = a.in[I_WQ]; for (int i = gw * 64 + lane; i < D * D / 8; i += NGW * 64) { const f32x4 v0 = *(const f32x4*)(WQ + (size_t)i * 8), v1 = *(const f32x4*)(WQ + (size_t)i * 8 + 4); *(u32x4*)(p_WQB + (size_t)i * 8) = ge::pack8(v0, v1); } }
        for (int r = gw; r < M + 512; r += NGW) {
            const bool ism = r >= M; const int rr = ism ? r - M : r;
            const float* src = (ism ? a.in[I_MEM] : a.in[I_X]) + (size_t)rr * D; const float* g = ism ? a.in[I_NMEM] : a.in[I_NMIX];
            bf16_t* dst = (ism ? p_MEMN : p_XN) + (size_t)rr * D;
            f32x4 v[4]; float ss = 0.f;
#pragma unroll
            for (int i = 0; i < 4; ++i) { v[i] = *(const f32x4*)(src + (lane + 64 * i) * 4); ss += (v[i][0] * v[i][0] + v[i][1] * v[i][1]) + (v[i][2] * v[i][2] + v[i][3] * v[i][3]); }
            const float rstd = rsqrtf(wave_sum(ss) * (1.f / D) + 1e-6f);
#pragma unroll
            for (int i = 0; i < 4; ++i) { const f32x4 gg = *(const f32x4*)(g + (lane + 64 * i) * 4), o = v[i] * rstd * gg;
                unsigned long long w = (unsigned long long)ge::cvt_pk_bf16(o[0], o[1]) | ((unsigned long long)ge::cvt_pk_bf16(o[2], o[3]) << 32);
                *(unsigned long long*)(dst + (lane + 64 * i) * 4) = w; }
        }
    }
    grid.sync();
    {
        ge::SchedProj S; S.o.init(64, 31, G, bid); S.XN = (const char*)p_XN; S.WINT = (const char*)p_WINT; S.MEMN = (const char*)p_MEMN; S.WKVT = (const char*)p_WKVT;
        ge::EpiProj E; E.hook_t = -1; E.RKV = p_RKV; E.GATES = p_GATES; E.AQKV = p_AQKV; E.LORA = p_LORA; E.KV = p_KV;
        ge::gemm_phase<ge::EpiProj, ge::SchedProj, true>(ldsl, D, D, 16, S, E);
    }
    xcd_barrier(bar);
    {
        const int bh = bid >> 3, seg = bid & 7;
        if (seg < 7) sc::scan_seg<true>(a, ldsl, bh >> 4, bh & 15, seg);
        else {
#pragma unroll 1
            for (int k2 = 0; k2 < 2; ++k2) {
                const bool isw = (k2 == 0); const int u = bh, pm = u >> 2, pn = u & 3;
                ge::SchedOne S; S.has = true; S.u.pm = pm; S.u.pn = pn;
                S.u.A = isw ? (const char*)(p_KV + (size_t)((pm >> 2) * 256) * 2048 + (pm & 3) * 256) : (const char*)(p_WOT + (size_t)((pm & 3) * 256) * 1024 + pn * 256);
                S.u.B = isw ? (const char*)(p_WQB + (size_t)(pn * 256) * 1024 + (pm & 3) * 256) : (const char*)(p_KV + (size_t)((pm >> 2) * 256) * 2048 + 1024 + pn * 256);
                ge::EpiScaleCol E; E.hook_t = -1; E.colscale = a.in[I_NX]; E.mul = isw ? 0.0625f : 1.f; E.use_cs = isw; E.out = isw ? p_WST : p_VWT; E.ld = 1024;
                ge::gemm_phase<ge::EpiScaleCol, ge::SchedOne, false>(ldsl, isw ? 2048 : 1024, isw ? 1024 : 2048, 4, S, E);
                __syncthreads();
            }
            da::attn_item(a, ldsl, bid >> 7, (bid >> 5) & 3, (bid & 31) * 256);
        }
    }
    xcd_barrier(bar);
    {
        const int bh = bid >> 3, seg = bid & 7;
        sc::scan_seg<false>(a, ldsl, bh >> 4, bh & 15, seg);
        __syncthreads();
        if (seg < 7) da::attn_item(a, ldsl, bid >> 7, (bid >> 5) & 3, (bid & 31) * 256);
    }
    xcd_barrier(bar);
    {
        ge::Sched S; S.o.init(64, 4, G, bid); S.A = (const char*)p_ACAT; S.B = (const char*)p_PCATT; S.a_tile = (size_t)256 * KCAT * 2; S.b_tile = (size_t)256 * KCAT * 2; S.b_batch = 0;
        ge::EpiMerged E; E.hook_t = 16; E.GATES = p_GATES; E.MERGED = p_MERGED;
        ge::gemm_phase<ge::EpiMerged, ge::Sched, false>(ldsl, KCAT, KCAT, 20, S, E);
        __syncthreads();
        int tid2 = threadIdx.x; asm volatile("" : "+v"(tid2));
        const int lane2 = tid2 & 63, wave2 = tid2 >> 6; LAS float* scr2 = (LAS float*)(ldsl + wave2 * 16384);
        transpose_matrix(a.in[I_W1], 1024, 4096, p_W1T, D, 0, a.in[I_NFFN], scr2, lane2, bid * NWAVES + wave2, NGW);
        transpose_matrix(a.in[I_FW2], 4096, 1024, p_W2T, FF, 0, nullptr, scr2, lane2, bid * NWAVES + wave2, NGW);
    }
    xcd_barrier(bar);
    {
        ge::Sched S; S.o.init(64, 4, G, bid); S.A = (const char*)p_MERGED; S.B = (const char*)p_WOUTT; S.a_tile = (size_t)256 * D * 2; S.b_tile = (size_t)256 * D * 2; S.b_batch = 0;
        ge::EpiResid E; E.hook_t = -1; E.base = a.in[I_X]; E.out = p_OUT; E.hb = p_H1B; E.SS = p_SS1;
        ge::gemm_phase<ge::EpiResid, ge::Sched, false>(ldsl, D, D, 16, S, E);
    }
    xcd_barrier(bar);
    {
        ge::Sched S; S.o.init(64, 4, G, bid); S.A = (const char*)p_H1B; S.B = (const char*)p_WST; S.a_tile = (size_t)256 * D * 2; S.b_tile = (size_t)256 * D * 2; S.b_batch = (size_t)1024 * 1024 * 2;
        ge::EpiSoftmax E; E.hook_t = -1; E.SS = p_SS1; E.PROB = p_PROB;
        ge::gemm_phase<ge::EpiSoftmax, ge::Sched, false>(ldsl, D, D, 16, S, E);
    }
    xcd_barrier(bar);
    {
        ge::Sched S; S.o.init(64, 4, G, bid); S.A = (const char*)p_PROB; S.B = (const char*)p_VWT; S.a_tile = (size_t)256 * D * 2; S.b_tile = (size_t)256 * D * 2; S.b_batch = (size_t)1024 * 1024 * 2;
        ge::EpiResid E; E.hook_t = -1; E.base = p_OUT; E.out = p_OUT; E.hb = p_H2B; E.SS = p_SS2;
        ge::gemm_phase<ge::EpiResid, ge::Sched, false>(ldsl, D, D, 16, S, E);
    }
    xcd_barrier(bar);
    {
        ge::Sched S; S.o.init(64, 16, G, bid); S.A = (const char*)p_H2B; S.B = (const char*)p_W1T; S.a_tile = (size_t)256 * D * 2; S.b_tile = (size_t)256 * D * 2; S.b_batch = 0;
        ge::EpiRelu2 E; E.hook_t = -1; E.SS = p_SS2; E.ACT = p_ACT;
        ge::gemm_phase<ge::EpiRelu2, ge::Sched, true>(ldsl, D, D, 16, S, E);
    }
    xcd_barrier(bar);
    {
        ge::Sched S; S.o.init(64, 4, G, bid); S.A = (const char*)p_ACT; S.B = (const char*)p_W2T; S.a_tile = (size_t)256 * FF * 2; S.b_tile = (size_t)256 * FF * 2; S.b_batch = 0;
        ge::EpiResid E; E.hook_t = -1; E.base = p_OUT; E.out = p_OUT; E.hb = nullptr; E.SS = p_SS3;
        ge::gemm_phase<ge::EpiResid, ge::Sched, false>(ldsl, FF, FF, 64, S, E);
    }
    xcd_barrier(bar);
    {
        const float* g = a.in[I_NFIN];
        int tid3 = threadIdx.x; asm volatile("" : "+v"(tid3));
        const int lane = tid3 & 63;
        for (int r = bid * NWAVES + (tid3 >> 6); r < M; r += NGW) {
            const float rstd = ge::rstd_from_ss(p_SS3, (size_t)r);
#pragma unroll
            for (int i = 0; i < 4; ++i) { const size_t o = (size_t)r * D + (lane + 64 * i) * 4; const f32x4 v = *(const f32x4*)(p_OUT + o), gg = *(const f32x4*)(g + (lane + 64 * i) * 4); *(f32x4*)(p_OUT + o) = v * rstd * gg; }
        }
    }
}

extern "C" void kernel_launch(void* const* d_in, const int* in_sizes, int n_in, void* d_out, int out_size, void* d_ws, size_t ws_size, hipStream_t stream) {
    static int grid = 0;
    if (grid == 0) {
        if (n_in != 27 || out_size != M * D || ws_size < 256 * MiB) { fprintf(stderr, "kernel_launch: unexpected shapes (n_in %d out %d ws %zu)\n", n_in, out_size, ws_size); grid = -1; return; }
        int dev = 0, cus = 0, per_cu = 0;
        if (hipGetDevice(&dev) != hipSuccess || hipDeviceGetAttribute(&cus, hipDeviceAttributeMultiprocessorCount, dev) != hipSuccess) { fprintf(stderr, "kernel_launch: device query failed\n"); grid = -1; return; }
        if (hipFuncSetAttribute((const void*)mk_fwd, hipFuncAttributeMaxDynamicSharedMemorySize, LDS_BYTES) != hipSuccess) { fprintf(stderr, "kernel_launch: hipFuncSetAttribute failed\n"); grid = -1; return; }
        if (hipOccupancyMaxActiveBlocksPerMultiprocessor(&per_cu, (const void*)mk_fwd, NTHREADS, LDS_BYTES) != hipSuccess || per_cu < 1) { fprintf(stderr, "kernel_launch: occupancy query says %d blocks per CU\n", per_cu); per_cu = 1; }
        (void)hipGetLastError();
        grid = cus;
        if (grid != 256) fprintf(stderr, "kernel_launch: %d CUs; this kernel is built for 256\n", grid);
    }
    if (grid < 0) return;
    (void)hipMemsetAsync((char*)d_ws + WS_CTL, 0, 64 * 1024, stream);
    Args a{};
    for (int i = 0; i < 27; ++i) a.in[i] = (const float*)d_in[i];
    a.out = (float*)d_out; a.ws = (unsigned char*)d_ws;
    void* kargs[] = {&a};
    hipError_t e = hipLaunchCooperativeKernel((const void*)mk_fwd, dim3(grid), dim3(NTHREADS), kargs, LDS_BYTES, stream);
    if (e != hipSuccess) fprintf(stderr, "kernel_launch: cooperative launch failed: %s (grid %d)\n", hipGetErrorString(e), grid);
}
```

```cpp
#include <hip/hip_runtime.h>
#include <hip/hip_cooperative_groups.h>
namespace cg = cooperative_groups;
#include <cstdint>
#include <cstdio>

typedef unsigned short bf16_t;
typedef float f32x4 __attribute__((ext_vector_type(4)));

constexpr int BATCH = 2, SEQ = 8192, M = BATCH * SEQ, D = 1024;
constexpr int NIN = 7712;
constexpr int C_LORA = 3072, C_AQ = 3360, C_GATE = 5664;
constexpr int NLORA = 288, NAQKV = 2304, NGATE = 2048, NRKV = 3072;
constexpr int MEMLEN = 256, FF = 4096, KCAT = 1280;
constexpr int CH = 32;

constexpr size_t KiB = 1024, MiB = 1024 * 1024;
constexpr size_t WS_CTL = 0;
constexpr size_t WS_BND = 512 * KiB;
constexpr size_t WS_LW2T = 1 * MiB;
constexpr size_t WS_LA2T = 1 * MiB + 128 * KiB;
constexpr size_t WS_LG2T = 1 * MiB + 256 * KiB;
constexpr size_t WS_MN = 2 * MiB;
constexpr size_t WS_WINT = 2 * MiB;
constexpr size_t WS_XN = 17 * MiB + 512 * KiB;
constexpr size_t WS_MEMN = 49 * MiB + 512 * KiB;
constexpr size_t WS_WKVT = 50 * MiB + 512 * KiB;
constexpr size_t WS_ACAT = WS_XN;
constexpr size_t WS_RKV = 57 * MiB + 512 * KiB;
constexpr size_t WS_LORA = 153 * MiB + 512 * KiB;
constexpr size_t WS_AQKV = 162 * MiB + 512 * KiB;
constexpr size_t WS_PCATT = 234 * MiB + 512 * KiB;
constexpr size_t WS_WOUTT = 237 * MiB;
constexpr size_t WS_WST = 239 * MiB;
constexpr size_t WS_VWT = 243 * MiB;
constexpr size_t WS_WQB = 247 * MiB;
constexpr size_t WS_WOT = 249 * MiB;
constexpr size_t WS_KV = 251 * MiB;
constexpr size_t WS_SS1 = 253 * MiB;
constexpr size_t WS_SS2 = 254 * MiB;
constexpr size_t WS_SS3 = 255 * MiB;
constexpr size_t WS_W1T = 57 * MiB + 512 * KiB;
constexpr size_t WS_W2T = 65 * MiB + 512 * KiB;
constexpr size_t WS_H2B = 73 * MiB + 512 * KiB;
constexpr size_t WS_MERGED = 105 * MiB + 512 * KiB;
constexpr size_t WS_H1B = 137 * MiB + 512 * KiB;
constexpr size_t WS_PROB = 169 * MiB + 512 * KiB;
constexpr size_t WS_ACT = 105 * MiB + 512 * KiB;

constexpr int NTHREADS = 512, NWAVES = 8;
constexpr int LDS_BYTES = 163840, LDSCTL_OFF = 159744;

__device__ __forceinline__ float bf2f(bf16_t v) { return __uint_as_float(((unsigned)v) << 16); }
__device__ __forceinline__ bf16_t f2bf(float f) { unsigned u = __float_as_uint(f); return (bf16_t)((u + 0x7fffu + ((u >> 16) & 1u)) >> 16); }
__device__ __forceinline__ float sigmoidf_(float x) { return 1.f / (1.f + __expf(-x)); }
__device__ __forceinline__ float wave_sum(float v) {
#pragma unroll
    for (int o = 1; o < 64; o <<= 1) v += __shfl_xor(v, o);
    return v;
}
__device__ __forceinline__ float wave_max(float v) {
#pragma unroll
    for (int o = 1; o < 64; o <<= 1) v = fmaxf(v, __shfl_xor(v, o));
    return v;
}

__device__ __forceinline__ int hw_lane() { return (int)__builtin_amdgcn_mbcnt_hi(~0u, __builtin_amdgcn_mbcnt_lo(~0u, 0u)); }

struct Args {
    const float* in[27];
    float* out;
    unsigned char* ws;
    int ph_lo, ph_hi;
};

enum { I_X = 0, I_MEM, I_NMIX, I_WIN, I_MU, I_W0, I_W2, I_A0, I_A2, I_G2, I_KK, I_KA, I_RK, I_GNW, I_GNB, I_PRWKV, I_PATTN, I_WOUT,
       I_NX, I_NMEM, I_WQ, I_WKV, I_WO, I_NFFN, I_W1, I_FW2, I_NFIN };

__device__ __forceinline__ void scan_naive(const Args& a, float* lds, int bh) {
    const int b = bh >> 4, h = bh & 15;
    const int tid = threadIdx.x, lane = tid & 63, wave = tid >> 6;
    const bf16_t* RKV = (const bf16_t*)(a.ws + WS_RKV);
    const bf16_t* LORA = (const bf16_t*)(a.ws + WS_LORA);
    bf16_t* ACAT = (bf16_t*)(a.ws + WS_ACAT);
    const float* mu = a.in[I_MU];
    float* actW = lds;
    float* actA = actW + CH * 64;
    float* actG = actA + CH * 64;
    float* Wd = actG + CH * 160;
    float* Kk = Wd + CH * 64;
    float* Aa = Kk + CH * 64;
    float* Bb = Aa + CH * 64;
    float* Rr = Bb + CH * 64;
    float* Vv = Rr + CH * 64;
    float* Gg = Vv + CH * 64;
    float* Yy = Gg + CH * 64;
    float* bon = Yy + CH * 64;
    const int hj0 = h * 64;
    float st[8];
#pragma unroll
    for (int e = 0; e < 8; ++e) st[e] = 0.f;
    const int row_i = wave * 8 + (lane >> 3), cg = lane & 7;
    for (int c0 = 0; c0 < SEQ; c0 += CH) {
        const size_t m0 = (size_t)b * SEQ + c0;
        __syncthreads();
        for (int idx = tid; idx < CH * NLORA; idx += NTHREADS) {
            const int t = idx / NLORA, c = idx % NLORA;
            const float cur = bf2f(LORA[(m0 + t) * NLORA + c]);
            const float prev = (c0 + t == 0) ? 0.f : bf2f(LORA[(m0 + t - 1) * NLORA + c]);
            const float s = cur + mu[C_LORA + c] * (prev - cur);
            if (c < 64) actW[t * 64 + c] = tanhf(s);
            else if (c < 128) actA[t * 64 + c - 64] = s;
            else actG[t * 160 + c - 128] = sigmoidf_(s);
        }
        for (int idx = tid; idx < CH * 64; idx += NTHREADS) {
            const int t = idx >> 6, j = idx & 63;
            const bool first = (c0 + t == 0);
#pragma unroll
            for (int q = 0; q < 3; ++q) {
                const int col = q * 1024 + hj0 + j;
                const float cur = bf2f(RKV[(m0 + t) * NRKV + col]);
                const float prev = first ? 0.f : bf2f(RKV[(m0 + t - 1) * NRKV + col]);
                const float s = cur + mu[col] * (prev - cur);
                if (q == 0) Rr[idx] = s; else if (q == 1) Kk[idx] = s; else Vv[idx] = s;
            }
        }
        __syncthreads();
        for (int idx = tid; idx < CH * 64; idx += NTHREADS) {
            const int t = idx >> 6, j = idx & 63, hj = hj0 + j;
            float wp = a.in[I_W0][hj], ap = a.in[I_A0][hj], g = 0.f;
            for (int c = 0; c < 64; ++c) { wp += actW[t * 64 + c] * a.in[I_W2][c * 1024 + hj]; ap += actA[t * 64 + c] * a.in[I_A2][c * 1024 + hj]; }
            for (int c = 0; c < 160; ++c) g += actG[t * 160 + c] * a.in[I_G2][c * 1024 + hj];
            const float z = -wp;
            const float sp = fmaxf(z, 0.f) + log1pf(__expf(-fabsf(z)));
            const float wlog = -sp - 0.5f;
            Wd[idx] = __expf(-__expf(wlog));
            Aa[idx] = sigmoidf_(ap);
            Gg[idx] = g;
        }
        __syncthreads();
#pragma unroll
        for (int q = 0; q < 4; ++q) {
            const int t = wave * 4 + q, idx = t * 64 + lane, hj = hj0 + lane;
            const float pk = Kk[idx], alr = Aa[idx];
            const float kr = pk * a.in[I_KK][hj];
            const float ss = wave_sum(kr * kr);
            const float kk = kr / fmaxf(sqrtf(ss), 1e-12f);
            const float kmod = pk * (1.f + (alr - 1.f) * a.in[I_KA][hj]);
            const float bs = wave_sum(Rr[idx] * kmod * a.in[I_RK][hj]);
            Aa[idx] = -kk; Bb[idx] = kk * alr; Kk[idx] = kmod;
            if (lane == 0) bon[t] = bs;
        }
        __syncthreads();
        for (int t = 0; t < CH; ++t) {
            const float* ap = Aa + t * 64 + cg * 8; const float* wp = Wd + t * 64 + cg * 8; const float* kp = Kk + t * 64 + cg * 8;
            const float* bp = Bb + t * 64 + cg * 8; const float* rp = Rr + t * 64 + cg * 8;
            float sa = 0.f;
#pragma unroll
            for (int e = 0; e < 8; ++e) sa += st[e] * ap[e];
            sa += __shfl_xor(sa, 1); sa += __shfl_xor(sa, 2); sa += __shfl_xor(sa, 4);
            const float vi = Vv[t * 64 + row_i];
            float y = 0.f;
#pragma unroll
            for (int e = 0; e < 8; ++e) { st[e] = st[e] * wp[e] + sa * bp[e] + vi * kp[e]; y += st[e] * rp[e]; }
            y += __shfl_xor(y, 1); y += __shfl_xor(y, 2); y += __shfl_xor(y, 4);
            if (cg == 0) Yy[t * 64 + row_i] = y;
        }
        __syncthreads();
#pragma unroll
        for (int q = 0; q < 4; ++q) {
            const int t = wave * 4 + q, idx = t * 64 + lane, hi = hj0 + lane;
            const float y = Yy[idx];
            const float mean = wave_sum(y) * (1.f / 64.f);
            const float dy = y - mean;
            const float var = wave_sum(dy * dy) * (1.f / 64.f);
            const float yn = dy * rsqrtf(var + 64.f * 1e-5f) * a.in[I_GNW][hi] + a.in[I_GNB][hi];
            const float o = (yn + bon[t] * Vv[idx]) * Gg[idx];
            ACAT[(m0 + t) * KCAT + hi] = f2bf(o);
        }
    }
}

__device__ __forceinline__ void dil_attn_naive(const Args& a, float* lds, int wave_gid, int nwaves_total) {
    const int lane = threadIdx.x & 63, wave = threadIdx.x >> 6;
    const bf16_t* AQ = (const bf16_t*)(a.ws + WS_AQKV);
    bf16_t* ACAT = (bf16_t*)(a.ws + WS_ACAT);
    float* pbuf = lds + wave * 640;
    float* qs = pbuf + 448;
    for (int task = wave_gid; task < M * 4; task += nwaves_total) {
        const int m = task >> 2, s = task & 3, p = m & (SEQ - 1);
#pragma unroll
        for (int g = 0; g < 3; ++g) qs[g * 64 + lane] = bf2f(AQ[(size_t)m * NAQKV + (g * 4 + s) * 64 + lane]);
        float sc[7];
        float mx = -INFINITY;
#pragma unroll
        for (int i = 0; i < 7; ++i) {
            const int idx = lane + i * 64;
            float v = -INFINITY;
            if (idx < 387) {
                const int g = idx / 129, stp = idx % 129, dil = (g == 0) ? 1 : (g == 1 ? 4 : 16), hd = g * 4 + s;
                if (stp * dil <= p) {
                    const bf16_t* kr = AQ + (size_t)(m - stp * dil) * NAQKV + 768 + hd * 64;
                    float dot = 0.f;
                    for (int c = 0; c < 64; ++c) dot += qs[g * 64 + c] * bf2f(kr[c]);
                    const float slope = exp2f(-8.f * (float)(hd + 1) / 12.f);
                    v = dot * 0.125f - slope * (float)(stp * dil);
                }
            }
            sc[i] = v; mx = fmaxf(mx, v);
        }
        mx = wave_max(mx);
        float sum = 0.f;
#pragma unroll
        for (int i = 0; i < 7; ++i) { const int idx = lane + i * 64; const float e = (sc[i] == -INFINITY) ? 0.f : __expf(sc[i] - mx); sum += e; if (idx < 448) pbuf[idx] = e; }
        sum = wave_sum(sum);
        float acc = 0.f;
        for (int idx = 0; idx < 387; ++idx) {
            const int g = idx / 129, stp = idx % 129, dil = (g == 0) ? 1 : (g == 1 ? 4 : 16), hd = g * 4 + s;
            if (stp * dil <= p) acc += pbuf[idx] * bf2f(AQ[(size_t)(m - stp * dil) * NAQKV + 1536 + hd * 64 + lane]);
        }
        ACAT[(size_t)m * KCAT + 1024 + s * 64 + lane] = f2bf(acc / sum);
    }
}

#define LAS __attribute__((address_space(3)))
typedef short bf16x8 __attribute__((ext_vector_type(8)));
typedef unsigned u32x4 __attribute__((ext_vector_type(4)));
namespace ge {
constexpr int BM = 256, BK = 64, HALF = 128, HTB = HALF * BK * 2, STAGE_BYTES = 8 * HTB, NXCD = 8, WGM = 8;
__host__ __device__ __forceinline__ int lds_byte(int r, int c) { const int st = (r >> 4) * 2 + (c >> 5), rr = r & 15, cc = c & 31, ob = rr * 64 + cc * 2; return st * 1024 + (ob ^ (((ob >> 9) & 1) << 5)); }
__host__ __device__ __forceinline__ void stage_rc(int b, int& R, int& C) { const int st = b / 1024, sb = b % 1024, swz = sb ^ (((sb >> 9) & 1) << 5); R = (st >> 1) * 16 + swz / 64; C = (st & 1) * 32 + (swz % 64) / 2; }
__host__ __device__ __forceinline__ int perm32(int rho) { const int n = rho >> 4, i = rho & 15; return 8 * (i >> 2) + 4 * n + (i & 3); }

struct Unit { const char* A; const char* B; int pm, pn; };

struct Order {
    int nM, nN, nwg, G, c;
    __device__ __forceinline__ void init(int nM_, int nN_, int G_, int c_) { nM = nM_; nN = nN_; nwg = nM * nN; G = G_; c = c_; }
    __device__ __forceinline__ bool next(int i, int& pm, int& pn) const {
        const long L = (long)i * G + c; if (L >= nwg) return false;
        int wgid = (int)L; { const int q = nwg / NXCD, r = nwg % NXCD, xcd = wgid % NXCD, off = wgid / NXCD; wgid = (xcd < r ? xcd * (q + 1) : r * (q + 1) + (xcd - r) * q) + off; }
        const int nig = WGM * nN, gid = wgid / nig, fm = gid * WGM, gsz = (nM - fm) < WGM ? (nM - fm) : WGM;
        pm = fm + ((wgid % nig) % gsz); pn = (wgid % nig) / gsz; return true;
    }
};
struct Sched {
    Order o; const char* A; const char* B; size_t a_tile, b_tile, b_batch;
    __device__ __forceinline__ bool next(int i, Unit& u) const {
        int pm, pn; if (!o.next(i, pm, pn)) return false;
        u.pm = pm; u.pn = pn; u.A = A + (size_t)pm * a_tile; u.B = B + (size_t)pn * b_tile + (size_t)(pm >> 5) * b_batch; return true;
    }
};

typedef float f32x2_t __attribute__((ext_vector_type(2))); typedef __bf16 bf16x2_t __attribute__((ext_vector_type(2)));
__device__ __forceinline__ unsigned cvt_pk_bf16(float lo, float hi) { f32x2_t v = {lo, hi}; bf16x2_t b = __builtin_convertvector(v, bf16x2_t); return __builtin_bit_cast(unsigned, b); }
__device__ __forceinline__ u32x4 pack8(const f32x4 v0, const f32x4 v1) { u32x4 w; w.x = cvt_pk_bf16(v0[0], v0[1]); w.y = cvt_pk_bf16(v0[2], v0[3]); w.z = cvt_pk_bf16(v1[0], v1[1]); w.w = cvt_pk_bf16(v1[2], v1[3]); return w; }
__device__ __forceinline__ void unpack8(const u32x4 w, f32x4& v0, f32x4& v1) {
    v0[0] = __uint_as_float(w.x << 16); v0[1] = __uint_as_float(w.x & 0xffff0000u); v0[2] = __uint_as_float(w.y << 16); v0[3] = __uint_as_float(w.y & 0xffff0000u);
    v1[0] = __uint_as_float(w.z << 16); v1[1] = __uint_as_float(w.z & 0xffff0000u); v1[2] = __uint_as_float(w.w << 16); v1[3] = __uint_as_float(w.w & 0xffff0000u);
}

template <class Epi, class SchedT, bool ALIGN_EPI>
__device__ __forceinline__ void gemm_phase(LAS unsigned char* lds, const int lda, const int ldb, const int nt, const SchedT& S, const Epi& E, const int wv) {
    int tid_o = wv * 64 + hw_lane(); asm volatile("" : "+v"(tid_o));
    const int tid = tid_o, wid = __builtin_amdgcn_readfirstlane(tid >> 6), lane = tid & 63, wr = wid >> 2, wc = wid & 3, fr = lane & 15, fq = lane >> 4;
    unsigned voffA[2], voffB[2];
#pragma unroll
    for (int i = 0; i < 2; ++i) { int R, C; stage_rc(tid * 16 + i * 8192, R, C); const int Rb = (R & ~31) + perm32(R & 31);
        voffA[i] = (unsigned)(R * lda + C) * 2u; voffB[i] = (unsigned)(Rb * ldb + C) * 2u; }
    const size_t kstep = (size_t)(BK * 2);
    const size_t hstepA = (size_t)HALF * lda * 2, hstepB = (size_t)HALF * ldb * 2;
    const unsigned ldsw = (unsigned)wid * 1024u;
    const int aoff = lds_byte(wr * 64 + fr, fq * 8), boff = lds_byte(wc * 32 + fr, fq * 8);
#define GE_SA(b, h) (((b) * 2 + (h)) * ge::HTB)
#define GE_SB(b, h) ((4 + (b) * 2 + (h)) * ge::HTB)
#define GE_STAGE(bufoff, gbase, voff) do { _Pragma("unroll") for (int _i = 0; _i < 2; ++_i) \
        __builtin_amdgcn_global_load_lds((const unsigned*)((const char*)(gbase) + (voff)[_i]), (LAS unsigned*)(lds + (bufoff) + ldsw + _i * 8192), 16, 0, 0); } while (0)
#define GE_LDA(dst, b, h) do { _Pragma("unroll") for (int m = 0; m < 4; ++m) _Pragma("unroll") for (int k = 0; k < 2; ++k) dst[m][k] = *(const LAS bf16x8*)(lds + GE_SA(b, h) + aoff + m * 2048 + k * 1024); } while (0)
#define GE_LDB(dst, b, h) do { _Pragma("unroll") for (int n = 0; n < 2; ++n) _Pragma("unroll") for (int k = 0; k < 2; ++k) dst[n][k] = *(const LAS bf16x8*)(lds + GE_SB(b, h) + boff + n * 2048 + k * 1024); } while (0)
#define GE_MMA(ai, bj, At, Bt) do { __builtin_amdgcn_s_setprio(1); _Pragma("unroll") for (int m = 0; m < 4; ++m) _Pragma("unroll") for (int n = 0; n < 2; ++n) _Pragma("unroll") for (int k = 0; k < 2; ++k) \
        acc[ai][bj][m][n] = __builtin_amdgcn_mfma_f32_16x16x32_bf16(Bt[n][k], At[m][k], acc[ai][bj][m][n], 0, 0, 0); __builtin_amdgcn_s_setprio(0); } while (0)
#define GE_WAIT_V(n) asm volatile("s_waitcnt vmcnt(" #n ")" ::: "memory")
#define GE_WAIT_L(n) asm volatile("s_waitcnt lgkmcnt(" #n ")" ::: "memory")
#define GE_BAR __builtin_amdgcn_s_barrier()
#define GE_SCHED __builtin_amdgcn_sched_barrier(0)
    Unit cur, nxt; int ui = 0;
    if (!S.next(0, cur)) return;
    f32x4 acc[2][2][4][2];
#pragma unroll
    for (int a = 0; a < 2; ++a)
#pragma unroll
        for (int b = 0; b < 2; ++b)
#pragma unroll
            for (int m = 0; m < 4; ++m)
#pragma unroll
                for (int n = 0; n < 2; ++n) acc[a][b][m][n] = (f32x4){0.f, 0.f, 0.f, 0.f};
    bf16x8 At[4][2], B0[2][2], B1[2][2];
    const char* cA = cur.A; const char* cB = cur.B;
    GE_STAGE(GE_SB(0, 0), cB, voffB); GE_STAGE(GE_SB(0, 1), cB + hstepB, voffB); GE_STAGE(GE_SA(0, 0), cA, voffA); GE_STAGE(GE_SA(0, 1), cA + hstepA, voffA);
    if (wr == 1) GE_BAR;
    GE_WAIT_V(2); GE_BAR;
    GE_STAGE(GE_SB(1, 0), cB + kstep, voffB); GE_STAGE(GE_SA(1, 0), cA + kstep, voffA); GE_STAGE(GE_SB(1, 1), cB + hstepB + kstep, voffB);
    GE_WAIT_V(6); GE_BAR;
    for (;;) {
        const bool has_next = S.next(ui + 1, nxt);
        const char* nA = has_next ? nxt.A : cA; const char* nB = has_next ? nxt.B : cB;
        for (int t = 0; t < nt; t += 2) {
            if constexpr (Epi::HOOK) { if (t == E.hook_t) E.hook(acc, cur, wr, wc, fr, fq); }
            const bool last = (t == nt - 2);
            const char* a1 = cA + (size_t)(t + 1) * kstep;
            const char* a2 = last ? nA : cA + (size_t)(t + 2) * kstep; const char* b2 = last ? nB : cB + (size_t)(t + 2) * kstep;
            const char* a3 = a2 + kstep; const char* b3 = b2 + kstep;
            GE_LDB(B0, 0, 0); GE_LDB(B1, 0, 1); GE_SCHED; GE_LDA(At, 0, 0); GE_STAGE(GE_SA(1, 1), a1 + hstepA, voffA);
            GE_WAIT_V(8); GE_WAIT_L(0); GE_BAR; GE_MMA(0, 0, At, B0); GE_MMA(0, 1, At, B1); GE_BAR; GE_SCHED;
            GE_LDA(At, 0, 1); GE_STAGE(GE_SB(0, 0), b2, voffB); GE_STAGE(GE_SB(0, 1), b2 + hstepB, voffB); GE_STAGE(GE_SA(0, 0), a2, voffA);
            GE_WAIT_V(8); GE_WAIT_L(0); GE_BAR; GE_MMA(1, 0, At, B0); GE_MMA(1, 1, At, B1); GE_BAR; GE_SCHED;
            GE_LDB(B0, 1, 0); GE_LDB(B1, 1, 1); GE_SCHED; GE_LDA(At, 1, 0); GE_STAGE(GE_SA(0, 1), a2 + hstepA, voffA);
            GE_WAIT_V(8); GE_WAIT_L(0); GE_BAR; GE_MMA(0, 0, At, B0); GE_MMA(0, 1, At, B1); GE_BAR; GE_SCHED;
            GE_LDA(At, 1, 1); GE_STAGE(GE_SB(1, 0), b3, voffB); GE_STAGE(GE_SB(1, 1), b3 + hstepB, voffB); GE_STAGE(GE_SA(1, 0), a3, voffA);
            GE_WAIT_V(8); GE_WAIT_L(0); GE_BAR; GE_MMA(1, 0, At, B0); GE_MMA(1, 1, At, B1); GE_BAR; GE_SCHED;
        }
        if constexpr (ALIGN_EPI) { if (wr == 0) GE_BAR; }
        if constexpr (!Epi::AFTER_DRAIN) { E(acc, cur, wr, wc, fr, fq); }
        if (!has_next) break;
#pragma unroll
        for (int a = 0; a < 2; ++a)
#pragma unroll
            for (int b = 0; b < 2; ++b)
#pragma unroll
                for (int m = 0; m < 4; ++m)
#pragma unroll
                    for (int n = 0; n < 2; ++n) acc[a][b][m][n] = (f32x4){0.f, 0.f, 0.f, 0.f};
        cur = nxt; cA = nA; cB = nB; ++ui;
        if constexpr (ALIGN_EPI) { if (wr == 1) GE_BAR; }
    }
    GE_WAIT_V(0);
    if constexpr (!ALIGN_EPI) { if (wr == 0) GE_BAR; }
    GE_BAR;
    if constexpr (Epi::AFTER_DRAIN) { E.fused(acc, cur, wr, wc, fr, fq, lds, wid, lane); }
#undef GE_SA
#undef GE_SB
#undef GE_STAGE
#undef GE_LDA
#undef GE_LDB
#undef GE_MMA
#undef GE_WAIT_V
#undef GE_WAIT_L
#undef GE_BAR
#undef GE_SCHED
}

#define GE_ROW(ai, m) (u.pm * 256 + (ai) * 128 + wr * 64 + (m) * 16 + fr)
#define GE_COL(bj) (u.pn * 256 + (bj) * 128 + wc * 32 + 8 * fq)
typedef f32x4 Acc[2][2][4][2];

__device__ __forceinline__ float fast_sigmoid(float x) { return __builtin_amdgcn_rcpf(1.f + __expf(-x)); }

struct EpiProj {
    static constexpr bool AFTER_DRAIN = false, HOOK = false; int hook_t;
    bf16_t *RKV, *GATES, *AQKV, *LORA, *KV, *BND;
    __device__ __forceinline__ void hook(Acc&, const Unit&, int, int, int, int) const {}
    __device__ __forceinline__ void operator()(const Acc& acc, const Unit& u, int wr, int wc, int fr, int fq) const {
        const int pn = u.pn; bf16_t* base; int ld, cbase, climit = 1 << 30; bool sig = false;
        if (pn >= 100) { base = KV; ld = 2048; cbase = (pn - 100) * 256; }
        else if (pn < 12) { base = RKV; ld = NRKV; cbase = pn * 256; }
        else if (pn < 20) { base = GATES; ld = NGATE; cbase = (pn - 12) * 256; sig = true; }
        else if (pn < 29) { base = AQKV; ld = NAQKV; cbase = (pn - 20) * 256; }
        else { base = LORA; ld = NLORA; cbase = (pn - 29) * 256; climit = NLORA; }
#pragma unroll
        for (int ai = 0; ai < 2; ++ai)
#pragma unroll
            for (int m = 0; m < 4; ++m) { bf16_t* rowp = base + (size_t)GE_ROW(ai, m) * ld;
#pragma unroll
                for (int bj = 0; bj < 2; ++bj) { const int c = cbase + bj * 128 + wc * 32 + 8 * fq;
                    if (c < climit) { f32x4 v0 = acc[ai][bj][m][0], v1 = acc[ai][bj][m][1];
                        if (sig) {
#pragma unroll
                            for (int j = 0; j < 4; ++j) { v0[j] = fast_sigmoid(v0[j]); v1[j] = fast_sigmoid(v1[j]); } }
                        const u32x4 pw = pack8(v0, v1); *(u32x4*)(rowp + c) = pw;
                        if (pn >= 29 && pn < 100 && (GE_ROW(ai, m) & 63) == 63) *(u32x4*)(BND + (size_t)(GE_ROW(ai, m) >> 6) * NLORA + c) = pw; } } }
    }
};
struct EpiMerged {
    static constexpr bool AFTER_DRAIN = false, HOOK = true; int hook_t;
    const bf16_t* GATES; bf16_t* MERGED;
    __device__ __forceinline__ void hook(Acc& acc, const Unit& u, int wr, int wc, int fr, int fq) const {
#pragma unroll
        for (int ai = 0; ai < 2; ++ai)
#pragma unroll
            for (int m = 0; m < 4; ++m) { const bf16_t* g = GATES + (size_t)GE_ROW(ai, m) * NGATE;
#pragma unroll
                for (int bj = 0; bj < 2; ++bj) { const int c = GE_COL(bj); f32x4 r0, r1, a0, a1;
                    unpack8(*(const u32x4*)(g + c), r0, r1); unpack8(*(const u32x4*)(g + 1024 + c), a0, a1);
#pragma unroll
                    for (int j = 0; j < 4; ++j) { acc[ai][bj][m][0][j] *= r0[j] * __builtin_amdgcn_rcpf(a0[j]); acc[ai][bj][m][1][j] *= r1[j] * __builtin_amdgcn_rcpf(a1[j]); } } }
    }
    __device__ __forceinline__ void operator()(const Acc& acc, const Unit& u, int wr, int wc, int fr, int fq) const {
#pragma unroll
        for (int ai = 0; ai < 2; ++ai)
#pragma unroll
            for (int m = 0; m < 4; ++m) { const size_t r = (size_t)GE_ROW(ai, m);
#pragma unroll
                for (int bj = 0; bj < 2; ++bj) { const int c = GE_COL(bj); f32x4 a0, a1;
                    unpack8(*(const u32x4*)(GATES + r * NGATE + 1024 + c), a0, a1);
                    *(u32x4*)(MERGED + r * D + c) = pack8(acc[ai][bj][m][0] * a0, acc[ai][bj][m][1] * a1); } }
    }
};
template <bool BB>
struct EpiResid {
    static constexpr bool AFTER_DRAIN = false, HOOK = false; int hook_t;
    const float* base; const bf16_t* baseb; float* out; bf16_t* hb; float* SS;
    __device__ __forceinline__ void hook(Acc&, const Unit&, int, int, int, int) const {}
    __device__ __forceinline__ void operator()(const Acc& acc, const Unit& u, int wr, int wc, int fr, int fq) const {
#pragma unroll
        for (int ai = 0; ai < 2; ++ai)
#pragma unroll
            for (int m = 0; m < 4; ++m) { const size_t r = (size_t)GE_ROW(ai, m); float ss = 0.f;
#pragma unroll
                for (int bj = 0; bj < 2; ++bj) { const int c = GE_COL(bj);
                    f32x4 b0, b1;
                    if (BB) unpack8(*(const u32x4*)(baseb + r * D + c), b0, b1); else { b0 = *(const f32x4*)(base + r * D + c); b1 = *(const f32x4*)(base + r * D + c + 4); }
                    const f32x4 o0 = b0 + acc[ai][bj][m][0], o1 = b1 + acc[ai][bj][m][1];
                    if (out) { *(f32x4*)(out + r * D + c) = o0; *(f32x4*)(out + r * D + c + 4) = o1; }
                    ss += (o0[0] * o0[0] + o0[1] * o0[1]) + (o0[2] * o0[2] + o0[3] * o0[3]) + (o1[0] * o1[0] + o1[1] * o1[1]) + (o1[2] * o1[2] + o1[3] * o1[3]);
                    if (hb) *(u32x4*)(hb + r * D + c) = pack8(o0, o1); }
                ss += __shfl_xor(ss, 16); ss += __shfl_xor(ss, 32);
                if (fq == 0) SS[r * 16 + u.pn * 4 + wc] = ss; }
    }
};
__device__ __forceinline__ float rstd_from_ss(const float* SS, size_t r) {
    const f32x4 a = *(const f32x4*)(SS + r * 16), b = *(const f32x4*)(SS + r * 16 + 4), c = *(const f32x4*)(SS + r * 16 + 8), d = *(const f32x4*)(SS + r * 16 + 12);
    const float s = ((a[0] + a[1]) + (a[2] + a[3])) + ((b[0] + b[1]) + (b[2] + b[3])) + ((c[0] + c[1]) + (c[2] + c[3])) + ((d[0] + d[1]) + (d[2] + d[3]));
    return rsqrtf(s * (1.f / D) + 1e-6f);
}
struct EpiRelu2 {
    static constexpr bool AFTER_DRAIN = false, HOOK = false; int hook_t;
    const float* SS; bf16_t* ACT;
    __device__ __forceinline__ void hook(Acc&, const Unit&, int, int, int, int) const {}
    __device__ __forceinline__ void operator()(const Acc& acc, const Unit& u, int wr, int wc, int fr, int fq) const {
#pragma unroll
        for (int ai = 0; ai < 2; ++ai)
#pragma unroll
            for (int m = 0; m < 4; ++m) { const size_t r = (size_t)GE_ROW(ai, m); const float rstd = rstd_from_ss(SS, r);
#pragma unroll
                for (int bj = 0; bj < 2; ++bj) { const int c = GE_COL(bj); f32x4 v0 = acc[ai][bj][m][0] * rstd, v1 = acc[ai][bj][m][1] * rstd;
#pragma unroll
                    for (int j = 0; j < 4; ++j) { const float a = fmaxf(v0[j], 0.f), b = fmaxf(v1[j], 0.f); v0[j] = a * a; v1[j] = b * b; }
                    *(u32x4*)(ACT + r * FF + c) = pack8(v0, v1); } }
    }
};
struct EpiSoftmax {
    static constexpr bool AFTER_DRAIN = true, HOOK = false; int hook_t;
    const float* SS; bf16_t* PROB;
    __device__ __forceinline__ void hook(Acc&, const Unit&, int, int, int, int) const {}
    __device__ __forceinline__ void operator()(const Acc&, const Unit&, int, int, int, int) const {}
    __device__ __forceinline__ void fused(Acc& acc, const Unit& u, int wr, int wc, int fr, int fq, LAS unsigned char* lds, int wid, int lane) const {
        LAS float* Pm = (LAS float*)lds; LAS float* Ps = Pm + 1024;
#pragma unroll
        for (int ai = 0; ai < 2; ++ai)
#pragma unroll
            for (int m = 0; m < 4; ++m) { const float rstd = rstd_from_ss(SS, (size_t)GE_ROW(ai, m)); float mx = -INFINITY;
#pragma unroll
                for (int bj = 0; bj < 2; ++bj)
#pragma unroll
                    for (int n = 0; n < 2; ++n)
#pragma unroll
                        for (int j = 0; j < 4; ++j) { const float s = acc[ai][bj][m][n][j] * rstd; acc[ai][bj][m][n][j] = s; mx = fmaxf(mx, s); }
                mx = fmaxf(mx, __shfl_xor(mx, 16)); mx = fmaxf(mx, __shfl_xor(mx, 32));
                if (fq == 0) Pm[(ai * 128 + wr * 64 + m * 16 + fr) * 4 + wc] = mx; }
        asm volatile("s_waitcnt lgkmcnt(0)" ::: "memory"); __builtin_amdgcn_s_barrier(); asm volatile("" ::: "memory");
#pragma unroll
        for (int ai = 0; ai < 2; ++ai)
#pragma unroll
            for (int m = 0; m < 4; ++m) { const int rl = ai * 128 + wr * 64 + m * 16 + fr; const f32x4 pm4 = *(const LAS f32x4*)(Pm + rl * 4);
                const float mx = fmaxf(fmaxf(pm4[0], pm4[1]), fmaxf(pm4[2], pm4[3])) * 1.44269504f; float sum = 0.f;
#pragma unroll
                for (int bj = 0; bj < 2; ++bj)
#pragma unroll
                    for (int n = 0; n < 2; ++n)
#pragma unroll
                        for (int j = 0; j < 4; ++j) { const float e = __builtin_amdgcn_exp2f(acc[ai][bj][m][n][j] * 1.44269504f - mx); acc[ai][bj][m][n][j] = e; sum += e; }
                sum += __shfl_xor(sum, 16); sum += __shfl_xor(sum, 32);
                if (fq == 0) Ps[rl * 4 + wc] = sum; }
        asm volatile("s_waitcnt lgkmcnt(0)" ::: "memory"); __builtin_amdgcn_s_barrier(); asm volatile("" ::: "memory");
#pragma unroll
        for (int ai = 0; ai < 2; ++ai)
#pragma unroll
            for (int m = 0; m < 4; ++m) { const int rl = ai * 128 + wr * 64 + m * 16 + fr; const f32x4 ps4 = *(const LAS f32x4*)(Ps + rl * 4);
                const float inv = 1.f / ((ps4[0] + ps4[1]) + (ps4[2] + ps4[3])); const size_t r = (size_t)GE_ROW(ai, m);
#pragma unroll
                for (int bj = 0; bj < 2; ++bj) *(u32x4*)(PROB + r * D + GE_COL(bj)) = pack8(acc[ai][bj][m][0] * inv, acc[ai][bj][m][1] * inv); }
    }
};
}

__device__ __forceinline__ void transpose_item(const float* W, int ldw, int k0, int n0, bf16_t* WT, int ldt, int drow0, int dk0, const float* kscale, LAS float* scr, int lane) {
#pragma unroll 8
    for (int i = 0; i < 32; ++i) { const int kk = 2 * i + (lane >> 5); float v = W[(size_t)(k0 + kk) * ldw + n0 + (lane & 31)]; if (kscale) v *= kscale[k0 + kk]; scr[kk * 33 + (lane & 31)] = v; }
    asm volatile("s_waitcnt lgkmcnt(0)" ::: "memory");
    const int c = lane & 7;
#pragma unroll
    for (int j = 0; j < 4; ++j) { const int n = (lane >> 3) + 8 * j; const LAS float* s = scr + (8 * c) * 33 + n;
        u32x4 o; o.x = ge::cvt_pk_bf16(s[0 * 33], s[1 * 33]); o.y = ge::cvt_pk_bf16(s[2 * 33], s[3 * 33]); o.z = ge::cvt_pk_bf16(s[4 * 33], s[5 * 33]); o.w = ge::cvt_pk_bf16(s[6 * 33], s[7 * 33]);
        *(u32x4*)(WT + (size_t)(drow0 + n) * ldt + dk0 + k0 + 8 * c) = o; }
    asm volatile("s_waitcnt lgkmcnt(0)" ::: "memory");
}
__device__ __forceinline__ void transpose_matrix(const float* W, int K, int N, bf16_t* WT, int ldt, int dk0, const float* kscale, LAS float* scr, int lane, int gw, int NGW) {
    const int nblk = N / 32, items = (K / 64) * nblk;
    for (int it = gw; it < items; it += NGW) { const int kb = it / nblk, nb = it % nblk; transpose_item(W, N, kb * 64, nb * 32, WT, ldt, nb * 32, dk0, kscale, scr, lane); }
}
namespace ge {
struct EpiScaleCol {
    static constexpr bool AFTER_DRAIN = false, HOOK = false; int hook_t;
    const float* colscale; float mul; bool use_cs; bf16_t* out; int ld;
    __device__ __forceinline__ void hook(Acc&, const Unit&, int, int, int, int) const {}
    __device__ __forceinline__ void operator()(const Acc& acc, const Unit& u, int wr, int wc, int fr, int fq) const {
#pragma unroll
        for (int bj = 0; bj < 2; ++bj) { const int c = GE_COL(bj);
            f32x4 s0 = (f32x4){mul, mul, mul, mul}, s1 = s0;
            if (use_cs) { s0 = s0 * *(const f32x4*)(colscale + c); s1 = s1 * *(const f32x4*)(colscale + c + 4); }
#pragma unroll
            for (int ai = 0; ai < 2; ++ai)
#pragma unroll
                for (int m = 0; m < 4; ++m) *(u32x4*)(out + (size_t)GE_ROW(ai, m) * ld + c) = pack8(acc[ai][bj][m][0] * s0, acc[ai][bj][m][1] * s1); }
    }
};
struct SchedOne {
    bool has; Unit u;
    __device__ __forceinline__ bool next(int i, Unit& o) const { if (i > 0 || !has) return false; o = u; return true; }
};
struct SchedProj {
    Order o; const char* XN; const char* WINT; const char* MEMN; const char* WKVT;
    __device__ __forceinline__ bool next(int i, Unit& u) const {
        int pm, pn; if (o.next(i, pm, pn)) { u.pm = pm; u.pn = pn; u.A = XN + (size_t)pm * (256 * D * 2); u.B = WINT + (size_t)pn * (256 * D * 2); return true; }
        const long L = (long)i * o.G + o.c - o.nwg; if (L < 0 || L >= 16) return false;
        u.pm = (int)(L >> 3); u.pn = 100 + (int)(L & 7); u.A = MEMN + (size_t)u.pm * (256 * D * 2); u.B = WKVT + (size_t)(L & 7) * (256 * D * 2); return true;
    }
};
}

namespace sc {
constexpr int RS = 72, FS = 68, AL = 296;
constexpr int O_X = 0;
constexpr int O_LAK = 0, O_URB = 9216, O_URK = 18432, O_T = 27648;
constexpr int O_LW = 37888;
constexpr int O_AT = 55296, O_BT = 64512, O_KT = 73728, O_RT = 82944, O_BHT = 92160, O_KHT = 101376, O_VT = 110592, O_S = 119808, O_RHST = 129024, O_CMT = 138240;
constexpr int O_LABB = O_CMT;
constexpr int O_YF = O_AT;
constexpr int O_TTD = O_KT, O_X1T = O_KT + 3072, O_TT32 = O_KT + 4608, O_X2T = O_KT;
constexpr int O_S1 = O_RT, O_RHST1 = O_URB, O_CMT1 = O_URK;
constexpr int O_ZA = 0, O_ZB = 0;
constexpr int O_MH = O_AT, O_ML = O_BT, O_SH = O_KT, O_SL = O_RT;
constexpr int O_GC = 147456, O_BON = O_GC + 256, O_SEG = O_BON + 256, O_PT = O_SEG + 2048, O_END = O_PT + 4096;
constexpr int PT_W0 = 0, PT_A0 = 64, PT_KK = 128, PT_KA = 192, PT_RK = 256, PT_GNW = 320, PT_GNB = 384, PT_MUR = 448, PT_MUK = 512, PT_MUV = 576, PT_MUL = 640;
static_assert(O_END <= LDSCTL_OFF, "scan LDS");
static_assert(O_TT32 + 32 * 40 * 2 <= O_RT, "inverse scratch inside the Kt slot");
typedef unsigned long long u64;
__device__ __forceinline__ f32x4 mma(bf16x8 x, bf16x8 y, f32x4 c) { return __builtin_amdgcn_mfma_f32_16x16x32_bf16(x, y, c, 0, 0, 0); }
__device__ __forceinline__ bf16x8 ldfrag(LAS const unsigned char* base, int rs, int row, int k) { return *(const LAS bf16x8*)(base + (row * rs + k) * 2); }
typedef short v4i16_t __attribute__((ext_vector_type(4)));
__device__ __forceinline__ bf16x8 trfrag(LAS const unsigned char* base, int rs, int k0, int q, int tl, int col0) {
    LAS const unsigned char* p = base + ((k0 + 8 * q + (tl >> 2)) * rs + col0 + 4 * (tl & 3)) * 2;
    const v4i16_t lo = __builtin_amdgcn_ds_read_tr16_b64_v4i16((LAS v4i16_t*)p), hi = __builtin_amdgcn_ds_read_tr16_b64_v4i16((LAS v4i16_t*)(p + 4 * rs * 2));
    return (bf16x8){lo[0], lo[1], lo[2], lo[3], hi[0], hi[1], hi[2], hi[3]};
}
__device__ __forceinline__ u64 pack4(f32x4 v) { return (u64)ge::cvt_pk_bf16(v[0], v[1]) | ((u64)ge::cvt_pk_bf16(v[2], v[3]) << 32); }
__device__ __forceinline__ void st4(LAS unsigned char* base, int rs, int row, int col, f32x4 v) { *(LAS u64*)(base + (row * rs + col) * 2) = pack4(v); }
__device__ __forceinline__ void st1(LAS unsigned char* base, int rs, int row, int col, float v) { *(LAS bf16_t*)(base + (row * rs + col) * 2) = (bf16_t)(ge::cvt_pk_bf16(v, v) & 0xffffu); }
__device__ __forceinline__ f32x4 ld4bf(const bf16_t* p) { const u64 w = *(const u64*)p; f32x4 v; v[0] = __uint_as_float((unsigned)w << 16); v[1] = __uint_as_float((unsigned)w & 0xffff0000u);
    v[2] = __uint_as_float((unsigned)(w >> 32) << 16); v[3] = __uint_as_float((unsigned)(w >> 32) & 0xffff0000u); return v; }
__device__ __forceinline__ f32x4 un4(const u64 w) { f32x4 v; v[0] = __uint_as_float((unsigned)w << 16); v[1] = __uint_as_float((unsigned)w & 0xffff0000u);
    v[2] = __uint_as_float((unsigned)(w >> 32) << 16); v[3] = __uint_as_float((unsigned)(w >> 32) & 0xffff0000u); return v; }
__device__ __forceinline__ f32x4 exp4(f32x4 x) { f32x4 r; r[0] = __expf(x[0]); r[1] = __expf(x[1]); r[2] = __expf(x[2]); r[3] = __expf(x[3]); return r; }
#define SC_BAR() do { asm volatile("s_waitcnt lgkmcnt(0)" ::: "memory"); __builtin_amdgcn_s_barrier(); asm volatile("" ::: "memory"); } while (0)
#define SC_LWAIT() asm volatile("s_waitcnt lgkmcnt(0)" ::: "memory")

template <bool P1>
__device__ __forceinline__ void scan_seg(const Args& a, LAS unsigned char* L, const int b, const int h, const int seg, const int wv) {
    constexpr int NH = P1 ? 2 : 1;
    int tid_o = wv * 64 + hw_lane(); asm volatile("" : "+v"(tid_o));
    const int tid = tid_o, w = __builtin_amdgcn_readfirstlane(tid >> 6);
    const int ts = w & 3, half = w >> 2;
    const int rt = w >> 1, ct0 = (w & 1) * 2;
    const int t0 = seg * 1024, nchunks = 16;
    const bf16_t* RKVp = (const bf16_t*)(a.ws + WS_RKV); const bf16_t* LORAp = (const bf16_t*)(a.ws + WS_LORA); bf16_t* ACATp = (bf16_t*)(a.ws + WS_ACAT);
    const bf16_t* W2T = (const bf16_t*)(a.ws + WS_LW2T); const bf16_t* A2T = (const bf16_t*)(a.ws + WS_LA2T); const bf16_t* G2T = (const bf16_t*)(a.ws + WS_LG2T);
    float* MN = (float*)(a.ws + WS_MN);
    const float* mu = a.in[I_MU];
    const int hj0 = h * 64;
    LAS float* LW = (LAS float*)(L + O_LW); LAS float* GC = (LAS float*)(L + O_GC); LAS float* BON = (LAS float*)(L + O_BON); LAS float* SEG = (LAS float*)(L + O_SEG);
    LAS float* YF = (LAS float*)(L + O_YF);
    LAS float* PT = (LAS float*)(L + O_PT);
    for (int i = tid; i < 928; i += NTHREADS) {
        float v;
        if (i < 448) { const int which = i >> 6, j = i & 63; const float* p = which == 0 ? a.in[I_W0] : which == 1 ? a.in[I_A0] : which == 2 ? a.in[I_KK] : which == 3 ? a.in[I_KA] : which == 4 ? a.in[I_RK] : which == 5 ? a.in[I_GNW] : a.in[I_GNB]; v = p[hj0 + j]; }
        else if (i < 640) { const int which = (i - 448) >> 6, j = i & 63; v = mu[which * 1024 + hj0 + j]; }
        else v = mu[C_LORA + i - 640];
        PT[i] = v;
    }
    SC_BAR();
    f32x4 zacc[NH][2];
    {
        const int lane = tid & 63, tl = lane & 15, q = lane >> 4;
#pragma unroll
        for (int hf = 0; hf < NH; ++hf)
#pragma unroll
            for (int c = 0; c < 2; ++c)
#pragma unroll
                for (int e = 0; e < 4; ++e) zacc[hf][c][e] = (hf == 1 && (16 * rt + 4 * q + e) == (16 * (ct0 + c) + tl)) ? 1.f : 0.f;
        if (!P1 && seg > 0) {
            for (int s2 = 0; s2 < seg; ++s2) {
                const float* mn = MN + (size_t)(((b * 16 + h) * 8) + s2) * (64 * 128);
                { const int row = tid >> 3, c8 = (tid & 7) * 8;
                  const f32x4 m0 = *(const f32x4*)(mn + row * 128 + 64 + c8), m1 = *(const f32x4*)(mn + row * 128 + 64 + c8 + 4);
                  const u32x4 hi = ge::pack8(m0, m1); f32x4 h0, h1; ge::unpack8(hi, h0, h1);
                  *(LAS u32x4*)(L + O_MH + (row * RS + c8) * 2) = hi; *(LAS u32x4*)(L + O_ML + (row * RS + c8) * 2) = ge::pack8(m0 - h0, m1 - h1); }
                f32x4 zn[2];
#pragma unroll
                for (int c = 0; c < 2; ++c) {
                    const u64 hi = pack4(zacc[0][c]); f32x4 hv; hv[0] = __uint_as_float((unsigned)hi << 16); hv[1] = __uint_as_float((unsigned)hi & 0xffff0000u);
                    hv[2] = __uint_as_float((unsigned)(hi >> 32) << 16); hv[3] = __uint_as_float((unsigned)(hi >> 32) & 0xffff0000u);
                    *(LAS u64*)(L + O_SH + ((16 * (ct0 + c) + tl) * RS + 16 * rt + 4 * q) * 2) = hi; st4(L + O_SL, RS, 16 * (ct0 + c) + tl, 16 * rt + 4 * q, zacc[0][c] - hv);
#pragma unroll
                    for (int e = 0; e < 4; ++e) zn[c][e] = mn[(16 * rt + 4 * q + e) * 128 + 16 * (ct0 + c) + tl];
                }
                SC_BAR();
#pragma unroll
                for (int ks = 0; ks < 2; ++ks) {
                    const int k = ks * 32 + 8 * q;
                    const bf16x8 xh = ldfrag(L + O_MH, RS, 16 * rt + tl, k), xl = ldfrag(L + O_ML, RS, 16 * rt + tl, k);
#pragma unroll
                    for (int c = 0; c < 2; ++c) { const int cr = 16 * (ct0 + c) + tl; const bf16x8 yh = ldfrag(L + O_SH, RS, cr, k), yl = ldfrag(L + O_SL, RS, cr, k);
                        zn[c] = mma(xh, yh, zn[c]); zn[c] = mma(xh, yl, zn[c]); zn[c] = mma(xl, yh, zn[c]); }
                }
                zacc[0][0] = zn[0]; zacc[0][1] = zn[1];
                SC_BAR();
            }
        }
#pragma unroll
        for (int c = 0; c < 2; ++c) { st4(L + O_S, RS, 16 * (ct0 + c) + tl, 16 * rt + 4 * q, zacc[0][c]); if (P1) st4(L + O_S1, RS, 16 * (ct0 + c) + tl, 16 * rt + 4 * q, zacc[NH - 1][c]); }
    }

    u32x4 pl[5]; u64 pk0[4], pk1[4], pr0[4], pr1[4]; bf16x8 wf[20];
#define SC_ISSUE(chn) do { \
        const int tcn_ = t0 + (chn) * 64; const size_t mn_ = (size_t)b * SEQ + tcn_; \
        int tido_ = tid; asm volatile("" : "+v"(tido_));     \
        const int lane_ = tido_ & 63, tl_ = lane_ & 15, q_ = lane_ >> 4, c8_ = tido_ % 36, g_ = min(tido_ / 36, 12); \
        _Pragma("unroll") for (int i_ = 0; i_ < 5; ++i_) { const int row_ = min(5 * g_ + i_, 63); pl[i_] = *(const u32x4*)(LORAp + ((long)mn_ + row_) * NLORA + c8_ * 8); } \
        const int t_ = 16 * ts + tl_; const int cb_ = (half == 0) ? 1024 : 2048; \
        _Pragma("unroll") for (int jt_ = 0; jt_ < 4; ++jt_) { const int hj_ = hj0 + 16 * jt_ + 4 * q_; \
            pk0[jt_] = *(const u64*)(RKVp + ((long)mn_ + t_) * NRKV + cb_ + hj_); pk1[jt_] = *(const u64*)(RKVp + ((long)mn_ + t_ - 1) * NRKV + cb_ + hj_); \
            if (!P1) { pr0[jt_] = *(const u64*)(RKVp + ((long)mn_ + t_) * NRKV + hj_); pr1[jt_] = *(const u64*)(RKVp + ((long)mn_ + t_ - 1) * NRKV + hj_); } } \
        if (half == 0) { _Pragma("unroll") for (int ks_ = 0; ks_ < 2; ++ks_) _Pragma("unroll") for (int jt_ = 0; jt_ < 4; ++jt_) { \
                wf[ks_ * 4 + jt_] = *(const bf16x8*)(W2T + (size_t)(hj0 + 16 * jt_ + tl_) * 64 + ks_ * 32 + 8 * q_); wf[8 + ks_ * 4 + jt_] = *(const bf16x8*)(A2T + (size_t)(hj0 + 16 * jt_ + tl_) * 64 + ks_ * 32 + 8 * q_); } } \
        else if (!P1) { _Pragma("unroll") for (int ks_ = 0; ks_ < 5; ++ks_) _Pragma("unroll") for (int jt_ = 0; jt_ < 4; ++jt_) \
                wf[ks_ * 4 + jt_] = *(const bf16x8*)(G2T + (size_t)(hj0 + 16 * jt_ + tl_) * 160 + ks_ * 32 + 8 * q_); } \
        asm volatile("" ::: "memory"); \
    } while (0)
    for (int ch = 0; ch < nchunks; ++ch) {
        const int tc0 = t0 + ch * 64;
        SC_ISSUE(ch);
        int lane_o = tid & 63; asm volatile("" : "+v"(lane_o));
        const int lane = lane_o, tl = lane & 15, q = lane >> 4;
        const size_t m0 = (size_t)b * SEQ + tc0;
        if (tid < 468) {
            int tida = tid; asm volatile("" : "+v"(tida));
            const int c8 = tida % 36, g5 = tida / 36;
#pragma unroll
            for (int i = 0; i < 5; ++i) if (5 * g5 + i < 64) *(LAS u32x4*)(L + O_X + ((5 * g5 + i) * AL + c8 * 8) * 2) = pl[i];
        }
        SC_BAR();
        const int t = 16 * ts + tl;
        const bool first = (tc0 + t == 0);
        f32x4 va[4], vb[4], vk[4];
#define vr va
#define vv vb
#define vg vk
        if (half == 0) {
            f32x4 aw[4], aa[4];
#pragma unroll
            for (int jt = 0; jt < 4; ++jt) { aw[jt] = (f32x4){0.f, 0.f, 0.f, 0.f}; aa[jt] = aw[jt]; }
#pragma unroll
            for (int ks = 0; ks < 2; ++ks) {
                const bf16x8 yw = ldfrag(L + O_X, AL, t, ks * 32 + 8 * q), ya = ldfrag(L + O_X, AL, t, 64 + ks * 32 + 8 * q);
#pragma unroll
                for (int jt = 0; jt < 4; ++jt) {
                    aw[jt] = mma(wf[ks * 4 + jt], yw, aw[jt]); aa[jt] = mma(wf[8 + ks * 4 + jt], ya, aa[jt]);
                }
            }
            float ss = 0.f;
#pragma unroll
            for (int jt = 0; jt < 4; ++jt) {
                const int j = 16 * jt + 4 * q, hj = hj0 + j;
                const f32x4 w0v = *(const LAS f32x4*)(PT + PT_W0 + j), a0v = *(const LAS f32x4*)(PT + PT_A0 + j), kkv = *(const LAS f32x4*)(PT + PT_KK + j), kav = *(const LAS f32x4*)(PT + PT_KA + j);
                const f32x4 kc = un4(pk0[jt]), kp = first ? (f32x4){0.f, 0.f, 0.f, 0.f} : un4(pk1[jt]);
                const f32x4 pk = kc + *(const LAS f32x4*)(PT + PT_MUK + j) * (kp - kc);
                f32x4 lw, alr;
#pragma unroll
                for (int e = 0; e < 4; ++e) {
                    lw[e] = -0.60653066f * ge::fast_sigmoid(aw[jt][e] + w0v[e]);
                    alr[e] = ge::fast_sigmoid(aa[jt][e] + a0v[e]);
                }
                const f32x4 kr = pk * kkv;
                ss += (kr[0] * kr[0] + kr[1] * kr[1]) + (kr[2] * kr[2] + kr[3] * kr[3]);
                const f32x4 km = pk * (1.f + (alr - 1.f) * kav);
                va[jt] = kr; vb[jt] = alr; vk[jt] = km;
                *(LAS f32x4*)(LW + t * FS + j) = lw;
            }
            ss += __shfl_xor(ss, 16); ss += __shfl_xor(ss, 32);
            const float inv = 1.f / fmaxf(sqrtf(ss), 1e-12f);
#pragma unroll
            for (int jt = 0; jt < 4; ++jt) { const f32x4 kk = va[jt] * inv; va[jt] = -kk; vb[jt] = kk * vb[jt]; }
        } else {
            f32x4 ag[4];
#pragma unroll
            for (int jt = 0; jt < 4; ++jt) ag[jt] = (f32x4){0.f, 0.f, 0.f, 0.f};
            if (!P1) {
#pragma unroll
                for (int ks = 0; ks < 5; ++ks) {
                    const bf16x8 yg = ldfrag(L + O_X, AL, t, 128 + ks * 32 + 8 * q);
#pragma unroll
                    for (int jt = 0; jt < 4; ++jt) ag[jt] = mma(wf[ks * 4 + jt], yg, ag[jt]);
                }
            }
#pragma unroll
            for (int jt = 0; jt < 4; ++jt) {
                const int hj = hj0 + 16 * jt + 4 * q;
                const f32x4 vc = un4(pk0[jt]), vp = first ? (f32x4){0.f, 0.f, 0.f, 0.f} : un4(pk1[jt]);
                vv[jt] = vc + *(const LAS f32x4*)(PT + PT_MUV + 16 * jt + 4 * q) * (vp - vc); vg[jt] = ag[jt];
                if (!P1) { const f32x4 rc = un4(pr0[jt]), rp = first ? (f32x4){0.f, 0.f, 0.f, 0.f} : un4(pr1[jt]); vr[jt] = rc + *(const LAS f32x4*)(PT + PT_MUR + 16 * jt + 4 * q) * (rp - rc); }
            }
        }
        SC_BAR();
        { const int j = tid & 63, sg = tid >> 6; float s = 0.f;
#pragma unroll
          for (int tt = 0; tt < 8; ++tt) { s += LW[(8 * sg + tt) * FS + j]; LW[(8 * sg + tt) * FS + j] = s; }
          SEG[sg * 64 + j] = s;
          SC_BAR();
          float off = 0.f;
          for (int s2 = 0; s2 < sg; ++s2) off += SEG[s2 * 64 + j];
#pragma unroll
          for (int tt = 0; tt < 8; ++tt) LW[(8 * sg + tt) * FS + j] += off;
          if (sg == 7) GC[j] = __expf(LW[63 * FS + j]);
        }
        SC_BAR();
#pragma unroll
        for (int jt = 0; jt < 4; ++jt) {
            const int j = 16 * jt + 4 * q;
            const f32x4 cum = *(const LAS f32x4*)(LW + t * FS + j);
            if (half == 0) {
                f32x4 cprev = (f32x4){0.f, 0.f, 0.f, 0.f}; if (t > 0) cprev = *(const LAS f32x4*)(LW + (t - 1) * FS + j);
                const f32x4 eprev = exp4(cprev), einv = exp4(-cum), erem = einv * *(const LAS f32x4*)(GC + j);
                const f32x4 bt = vb[jt] * einv, kt = vk[jt] * einv;
                st4(L + O_AT, RS, t, j, va[jt] * eprev); st4(L + O_BT, RS, t, j, bt); st4(L + O_KT, RS, t, j, kt);
                st4(L + O_BHT, RS, t, j, vb[jt] * erem); st4(L + O_KHT, RS, t, j, vk[jt] * erem);
            } else {
                if (!P1) st4(L + O_RT, RS, t, j, vr[jt] * exp4(cum));
                st4(L + O_VT, RS, t, j, vv[jt]);
            }
        }
        SC_BAR();
        f32x4 pacc[NH][2], yacc[2];
        {
            f32x4 lab[2], lak[2], urb[2], urk[2];
#pragma unroll
            for (int c = 0; c < 2; ++c) { lab[c] = (f32x4){0.f, 0.f, 0.f, 0.f}; lak[c] = lab[c]; urb[c] = lab[c]; urk[c] = lab[c]; yacc[c] = lab[c];
#pragma unroll
                for (int hf = 0; hf < NH; ++hf) pacc[hf][c] = lab[c]; }
            const f32x4 gc = *(const LAS f32x4*)(GC + 16 * rt + 4 * q);
#pragma unroll
            for (int hf = 0; hf < NH; ++hf) { zacc[hf][0] = zacc[hf][0] * gc; zacc[hf][1] = zacc[hf][1] * gc; }
#pragma unroll
            for (int ks = 0; ks < 2; ++ks) {
                const int k = ks * 32 + 8 * q;
                const bf16x8 xb = ldfrag(L + O_BT, RS, 16 * rt + tl, k), xk = ldfrag(L + O_KT, RS, 16 * rt + tl, k), xa = ldfrag(L + O_AT, RS, 16 * rt + tl, k);
                const bf16x8 xkh = trfrag(L + O_KHT, RS, ks * 32, q, tl, 16 * rt);
#pragma unroll
                for (int c = 0; c < 2; ++c) {
                    const int cr = 16 * (ct0 + c) + tl;
                    const bf16x8 ya = ldfrag(L + O_AT, RS, cr, k), ys = ldfrag(L + O_S, RS, cr, k), yv = trfrag(L + O_VT, RS, ks * 32, q, tl, 16 * (ct0 + c));
                    lab[c] = mma(xb, ya, lab[c]); lak[c] = mma(xk, ya, lak[c]);
                    pacc[0][c] = mma(xa, ys, pacc[0][c]);
                    if (P1) pacc[NH - 1][c] = mma(xa, ldfrag(L + O_S1, RS, cr, k), pacc[NH - 1][c]);
                    zacc[0][c] = mma(xkh, yv, zacc[0][c]);
                    if (!P1) { const bf16x8 yr = ldfrag(L + O_RT, RS, cr, k), xs = ldfrag(L + O_S, RS, 16 * rt + tl, k);
                        urb[c] = mma(xb, yr, urb[c]); urk[c] = mma(xk, yr, urk[c]);
                        yacc[c] = mma(xs, yr, yacc[c]); }
                }
            }
#pragma unroll
            for (int c = 0; c < 2; ++c) {
                const int tcol = 16 * (ct0 + c) + tl, u0 = 16 * rt + 4 * q;
#pragma unroll
                for (int e = 0; e < 4; ++e) { const bool lt = (u0 + e) < tcol, le = (u0 + e) <= tcol; lab[c][e] = lt ? lab[c][e] : 0.f; lak[c][e] = lt ? lak[c][e] : 0.f; urb[c][e] = le ? urb[c][e] : 0.f; urk[c][e] = le ? urk[c][e] : 0.f; }
                *(LAS f32x4*)(LW + tcol * FS + u0) = lab[c];
                st4(L + O_LABB, RS, tcol, u0, lab[c]); st4(L + O_LAK, RS, tcol, u0, lak[c]);
                if (!P1) { st4(L + O_URB, RS, tcol, u0, urb[c]); st4(L + O_URK, RS, tcol, u0, urk[c]); }
            }
            if (!P1) {
                const int tb = tid >> 3, j8 = (tid & 7) * 8;
                f32x4 r0, r1, k0, k1; ge::unpack8(*(const LAS u32x4*)(L + O_RT + (tb * RS + j8) * 2), r0, r1); ge::unpack8(*(const LAS u32x4*)(L + O_KT + (tb * RS + j8) * 2), k0, k1);
                const f32x4 p0 = r0 * k0 * *(const LAS f32x4*)(PT + PT_RK + j8), p1 = r1 * k1 * *(const LAS f32x4*)(PT + PT_RK + j8 + 4);
                float bs = ((p0[0] + p0[1]) + (p0[2] + p0[3])) + ((p1[0] + p1[1]) + (p1[2] + p1[3]));
                bs += __shfl_xor(bs, 1); bs += __shfl_xor(bs, 2); bs += __shfl_xor(bs, 4);
                if ((tid & 7) == 0) BON[tb] = bs;
            }
        }
        SC_BAR();
#pragma unroll
        for (int ks = 0; ks < 2; ++ks) {
            const int k = ks * 32 + 8 * q;
            const bf16x8 xl = ldfrag(L + O_LAK, RS, 16 * rt + tl, k);
#pragma unroll
            for (int c = 0; c < 2; ++c) {
                const int cr = 16 * (ct0 + c) + tl;
                pacc[0][c] = mma(xl, trfrag(L + O_VT, RS, ks * 32, q, tl, 16 * (ct0 + c)), pacc[0][c]);
                if (!P1) yacc[c] = mma(trfrag(L + O_VT, RS, ks * 32, q, tl, 16 * rt), ldfrag(L + O_URK, RS, cr, k), yacc[c]);
            }
        }
#pragma unroll
        for (int c = 0; c < 2; ++c) { st4(L + O_RHST, RS, 16 * (ct0 + c) + tl, 16 * rt + 4 * q, pacc[0][c]); if (P1) st4(L + O_RHST1, RS, 16 * (ct0 + c) + tl, 16 * rt + 4 * q, pacc[NH - 1][c]); }
        if (w == 0) {
            const unsigned zz = (unsigned)(lane >> 6);
            const u32x4 zv = (u32x4){zz, zz, zz, zz};
            const int p = q, c = tl;
            float Tc[16];
#pragma unroll
            for (int k = 0; k < 16; ++k) Tc[k] = (k == c) ? 1.f : 0.f;
#pragma unroll
            for (int rg = 0; rg < 4; ++rg) {
                f32x4 lr[4][4];
#pragma unroll
                for (int rr = 0; rr < 4; ++rr)
#pragma unroll
                    for (int k4 = 0; k4 <= rg; ++k4) lr[rr][k4] = *(const LAS f32x4*)(LW + (16 * p + 4 * rg + rr) * FS + 16 * p + 4 * k4);
#pragma unroll
                for (int rr = 0; rr < 4; ++rr) {
                    const int r = 4 * rg + rr;
                    if (r >= 1) {
                        float acc0 = 0.f, acc1 = 0.f;
#pragma unroll
                        for (int k = 0; k < r; k += 2) { acc0 += lr[rr][k >> 2][k & 3] * Tc[k]; if (k + 1 < r) acc1 += lr[rr][(k + 1) >> 2][(k + 1) & 3] * Tc[k + 1]; }
                        Tc[r] = (r > c) ? (acc0 + acc1) : Tc[r];
                    }
                }
                asm volatile("" : "+v"(Tc[4 * rg]), "+v"(Tc[4 * rg + 1]), "+v"(Tc[4 * rg + 2]), "+v"(Tc[4 * rg + 3]) :: "memory");
            }
            for (int i = lane; i < 6 * 16 * 2; i += 64) { const int blk = i >> 5, rr = (i >> 1) & 15, hf = i & 1;
                const int pr_ = (blk < 3) ? 0 : (blk < 5 ? 1 : 2), qc = (blk < 3) ? blk + 1 : (blk < 5 ? blk - 1 : 3);
                *(LAS u32x4*)(L + O_T + ((16 * pr_ + rr) * RS + 16 * qc + 8 * hf) * 2) = zv; }
#pragma unroll
            for (int k = 0; k < 16; ++k) st1(L + O_T, RS, 16 * p + k, 16 * p + c, Tc[k]);
            { u32x4 w0, w1; w0.x = ge::cvt_pk_bf16(Tc[0], Tc[1]); w0.y = ge::cvt_pk_bf16(Tc[2], Tc[3]); w0.z = ge::cvt_pk_bf16(Tc[4], Tc[5]); w0.w = ge::cvt_pk_bf16(Tc[6], Tc[7]);
              w1.x = ge::cvt_pk_bf16(Tc[8], Tc[9]); w1.y = ge::cvt_pk_bf16(Tc[10], Tc[11]); w1.z = ge::cvt_pk_bf16(Tc[12], Tc[13]); w1.w = ge::cvt_pk_bf16(Tc[14], Tc[15]);
              *(LAS u32x4*)(L + O_TTD + ((p * 16 + c) * 24) * 2) = w0; *(LAS u32x4*)(L + O_TTD + ((p * 16 + c) * 24 + 8) * 2) = w1;
              if (p < 2) {
                  *(LAS u32x4*)(L + O_TT32 + ((16 * p + c) * 40 + 16 * p) * 2) = w0; *(LAS u32x4*)(L + O_TT32 + ((16 * p + c) * 40 + 16 * p + 8) * 2) = w1;
                  if (p == 1) { *(LAS u32x4*)(L + O_TT32 + ((16 + c) * 40) * 2) = zv; *(LAS u32x4*)(L + O_TT32 + ((16 + c) * 40 + 8) * 2) = zv; }
              } }
            SC_LWAIT();
            const bf16x8 zf = (bf16x8){0, 0, 0, 0, 0, 0, 0, 0};
            const f32x4 z4 = (f32x4){0.f, 0.f, 0.f, 0.f};
#pragma unroll
            for (int pi = 0; pi < 2; ++pi) {
                const int pp = 2 * pi + 1, qq = 2 * pi;
                const bf16x8 xl = (q < 2) ? ldfrag(L + O_LABB, RS, 16 * pp + tl, 16 * qq + 8 * q) : zf;
                const bf16x8 yt = (q < 2) ? ldfrag(L + O_TTD, 24, qq * 16 + tl, 8 * q) : zf;
                const f32x4 x1 = mma(xl, yt, z4);
                st4(L + O_X1T, 24, pi * 16 + tl, 4 * q, x1);
                SC_LWAIT();
                const bf16x8 xx = (q < 2) ? ldfrag(L + O_X1T, 24, pi * 16 + tl, 8 * q) : zf;
                const bf16x8 ytp = (q < 2) ? ldfrag(L + O_T, RS, 16 * pp + tl, 16 * pp + 8 * q) : zf;
                const f32x4 tpqT = mma(xx, ytp, z4);
                st4(L + O_T, RS, 16 * pp + tl, 16 * qq + 4 * q, tpqT);
                if (pi == 0) { const f32x4 tpq = mma(ytp, xx, z4);
                    st4(L + O_TT32, 40, tl, 16 + 4 * q, tpq); }
            }
            SC_LWAIT();
            f32x4 x2[2][2];
#pragma unroll
            for (int r2 = 0; r2 < 2; ++r2) { const bf16x8 xl = ldfrag(L + O_LABB, RS, 32 + 16 * r2 + tl, 8 * q);
#pragma unroll
                for (int c2 = 0; c2 < 2; ++c2) x2[r2][c2] = mma(xl, ldfrag(L + O_TT32, 40, 16 * c2 + tl, 8 * q), z4); }
#pragma unroll
            for (int r2 = 0; r2 < 2; ++r2)
#pragma unroll
                for (int c2 = 0; c2 < 2; ++c2) st4(L + O_X2T, 40, 16 * c2 + tl, 16 * r2 + 4 * q, x2[r2][c2]);
            SC_LWAIT();
#pragma unroll
            for (int c2 = 0; c2 < 2; ++c2) { const bf16x8 xx = ldfrag(L + O_X2T, 40, 16 * c2 + tl, 8 * q);
#pragma unroll
                for (int r2 = 0; r2 < 2; ++r2) { const f32x4 d = mma(xx, ldfrag(L + O_T, RS, 32 + 16 * r2 + tl, 32 + 8 * q), z4);
                    st4(L + O_T, RS, 32 + 16 * r2 + tl, 16 * c2 + 4 * q, d); } }
        }
        SC_BAR();
        {
            f32x4 cacc[NH][2];
#pragma unroll
            for (int hf = 0; hf < NH; ++hf) { cacc[hf][0] = (f32x4){0.f, 0.f, 0.f, 0.f}; cacc[hf][1] = cacc[hf][0]; }
#pragma unroll
            for (int ks = 0; ks < 2; ++ks) {
                const int k = ks * 32 + 8 * q;
                const bf16x8 xt = ldfrag(L + O_T, RS, 16 * rt + tl, k);
#pragma unroll
                for (int c = 0; c < 2; ++c) { cacc[0][c] = mma(xt, ldfrag(L + O_RHST, RS, 16 * (ct0 + c) + tl, k), cacc[0][c]);
                    if (P1) cacc[NH - 1][c] = mma(xt, ldfrag(L + O_RHST1, RS, 16 * (ct0 + c) + tl, k), cacc[NH - 1][c]); }
            }
#pragma unroll
            for (int c = 0; c < 2; ++c) { st4(L + O_CMT, RS, 16 * (ct0 + c) + tl, 16 * rt + 4 * q, cacc[0][c]); if (P1) st4(L + O_CMT1, RS, 16 * (ct0 + c) + tl, 16 * rt + 4 * q, cacc[NH - 1][c]); }
        }
        SC_BAR();
#pragma unroll
        for (int ks = 0; ks < 2; ++ks) {
            const int k = ks * 32 + 8 * q;
            const bf16x8 xbh = trfrag(L + O_BHT, RS, ks * 32, q, tl, 16 * rt);
#pragma unroll
            for (int c = 0; c < 2; ++c) {
                const int cr = 16 * (ct0 + c) + tl;
                zacc[0][c] = mma(xbh, ldfrag(L + O_CMT, RS, cr, k), zacc[0][c]);
                if (P1) zacc[NH - 1][c] = mma(xbh, ldfrag(L + O_CMT1, RS, cr, k), zacc[NH - 1][c]);
                if (!P1) yacc[c] = mma(ldfrag(L + O_CMT, RS, 16 * rt + tl, k), ldfrag(L + O_URB, RS, cr, k), yacc[c]);
            }
        }
#pragma unroll
        for (int c = 0; c < 2; ++c) { st4(L + O_S, RS, 16 * (ct0 + c) + tl, 16 * rt + 4 * q, zacc[0][c]);
            if (P1) st4(L + O_S1, RS, 16 * (ct0 + c) + tl, 16 * rt + 4 * q, zacc[NH - 1][c]);
            else *(LAS f32x4*)(YF + (16 * (ct0 + c) + tl) * FS + 16 * rt + 4 * q) = yacc[c]; }
        SC_BAR();
        if (!P1 && half == 1) {
            f32x4 y[4]; float s = 0.f;
#pragma unroll
            for (int jt = 0; jt < 4; ++jt) { y[jt] = *(const LAS f32x4*)(YF + t * FS + 16 * jt + 4 * q); s += (y[jt][0] + y[jt][1]) + (y[jt][2] + y[jt][3]); }
            s += __shfl_xor(s, 16); s += __shfl_xor(s, 32);
            const float mean = s * (1.f / 64.f); float vs = 0.f;
#pragma unroll
            for (int jt = 0; jt < 4; ++jt) { y[jt] = y[jt] - mean; vs += (y[jt][0] * y[jt][0] + y[jt][1] * y[jt][1]) + (y[jt][2] * y[jt][2] + y[jt][3] * y[jt][3]); }
            vs += __shfl_xor(vs, 16); vs += __shfl_xor(vs, 32);
            const float rstd = rsqrtf(vs * (1.f / 64.f) + 64.f * 1e-5f), bon = BON[t];
#pragma unroll
            for (int jt = 0; jt < 4; ++jt) { const int hi = hj0 + 16 * jt + 4 * q;
                const f32x4 o = (y[jt] * rstd * *(const LAS f32x4*)(PT + PT_GNW + 16 * jt + 4 * q) + *(const LAS f32x4*)(PT + PT_GNB + 16 * jt + 4 * q) + bon * vv[jt]) * vg[jt];
                *(u64*)(ACATp + (m0 + t) * KCAT + hi) = pack4(o); }
        }
    }
    if (P1) {
        const int lane = tid & 63, tl = lane & 15, q = lane >> 4;
        float* mn = MN + (size_t)(((b * 16 + h) * 8) + seg) * (64 * 128);
#pragma unroll
        for (int hf = 0; hf < NH; ++hf)
#pragma unroll
            for (int c = 0; c < 2; ++c)
#pragma unroll
                for (int e = 0; e < 4; ++e) mn[(16 * rt + 4 * q + e) * 128 + hf * 64 + 16 * (ct0 + c) + tl] = zacc[hf][c][e];
    }
}
#undef vr
#undef vv
#undef vg
}
namespace da {
constexpr int OS = 68;
constexpr int O_OACC = 0, O_M = 256 * OS * 4, O_L = O_M + 1024, O_WAVE = O_L + 1024;
constexpr int PST = 168, VST = 72;
constexpr int WAVE_BYTES = 16 * PST * 2 + 32 * VST * 2;
static_assert(O_WAVE + 8 * WAVE_BYTES <= LDSCTL_OFF, "attention LDS");
typedef short v4i16_t __attribute__((ext_vector_type(4)));
__device__ __forceinline__ bf16x8 tr8(LAS const unsigned char* p0, LAS const unsigned char* p1) {
    const v4i16_t lo = __builtin_amdgcn_ds_read_tr16_b64_v4i16((LAS v4i16_t*)p0), hi = __builtin_amdgcn_ds_read_tr16_b64_v4i16((LAS v4i16_t*)p1);
    return (bf16x8){lo[0], lo[1], lo[2], lo[3], hi[0], hi[1], hi[2], hi[3]};
}
__device__ __forceinline__ void attn_item(const Args& a, LAS unsigned char* L, const int b, const int slot, const int p0, const int wv) {
    int tid_o = wv * 64 + hw_lane(); asm volatile("" : "+v"(tid_o));
    const int tid = tid_o, lane = tid & 63, w = __builtin_amdgcn_readfirstlane(tid >> 6), tl = lane & 15, q4 = lane >> 4;
    const bf16_t* AQ = (const bf16_t*)(a.ws + WS_AQKV) + (size_t)b * SEQ * NAQKV;
    bf16_t* ACATp = (bf16_t*)(a.ws + WS_ACAT) + (size_t)b * SEQ * KCAT + 1024 + slot * 64;
    LAS float* OA = (LAS float*)(L + O_OACC); LAS float* MA = (LAS float*)(L + O_M); LAS float* LA = (LAS float*)(L + O_L);
    LAS unsigned char* Pst = L + O_WAVE + w * WAVE_BYTES; LAS unsigned char* Vst = Pst + 16 * PST * 2;
    const bf16x8 zf = (bf16x8){0, 0, 0, 0, 0, 0, 0, 0};
    const f32x4 z4 = (f32x4){0.f, 0.f, 0.f, 0.f};
#pragma unroll 1
    for (int g = 0; g < 3; ++g) {
        const int dsh = 2 * g, d = 1 << dsh, hd = g * 4 + slot;
        const float slope2 = exp2f(-8.f * (float)(hd + 1) / 12.f) * (float)d * 1.44269504f;
        const bf16_t* Qb = AQ + hd * 64; const bf16_t* Kb = Qb + 768; const bf16_t* Vb = Qb + 1536;
#pragma unroll 1
        for (int rr = 0; rr < 2; ++rr) {
            const int rti = w + 8 * rr;
            const int r = (g == 0) ? 0 : (g == 1 ? (rti >> 2) : rti);
            const int j0 = (p0 >> dsh) + ((g == 0) ? 16 * rti : (g == 1 ? 16 * (rti & 3) : 0));
            const int posq = ((j0 + tl) << dsh) + r;
            bf16x8 yq[2];
#pragma unroll
            for (int ks = 0; ks < 2; ++ks) yq[ks] = *(const bf16x8*)(Qb + (size_t)posq * NAQKV + ks * 32 + 8 * q4);
            f32x4 st[9];
#pragma unroll
            for (int kt = 0; kt < 9; ++kt) {
                const int jk = j0 - 128 + 16 * kt + tl;
                bf16x8 x0 = zf, x1 = zf;
                if (jk >= 0) { const bf16_t* kp = Kb + (size_t)((jk << dsh) + r) * NAQKV + 8 * q4; x0 = *(const bf16x8*)kp; x1 = *(const bf16x8*)(kp + 32); }
                st[kt] = sc::mma(x0, yq[0], z4); st[kt] = sc::mma(x1, yq[1], st[kt]);
            }
            float mx = -INFINITY;
#pragma unroll
            for (int kt = 0; kt < 9; ++kt)
#pragma unroll
                for (int e = 0; e < 4; ++e) {
                    const int kq = 16 * kt + 4 * q4 + e, steps = tl + 128 - kq;
                    const bool ok = (steps >= 0) && (steps <= 128) && (j0 - 128 + kq >= 0);
                    const float s = ok ? (st[kt][e] * (0.125f * 1.44269504f) - slope2 * (float)steps) : -INFINITY;
                    st[kt][e] = s; mx = fmaxf(mx, s);
                }
            mx = fmaxf(mx, __shfl_xor(mx, 16)); mx = fmaxf(mx, __shfl_xor(mx, 32));
            float ls = 0.f;
#pragma unroll
            for (int kt = 0; kt < 9; ++kt) {
#pragma unroll
                for (int e = 0; e < 4; ++e) { const float ev = __builtin_amdgcn_exp2f(st[kt][e] - mx); st[kt][e] = ev; ls += ev; }
                *(LAS unsigned long long*)(Pst + (tl * PST + 16 * kt + 4 * q4) * 2) = sc::pack4(st[kt]);
            }
            *(LAS unsigned long long*)(Pst + (tl * PST + 144 + 4 * q4) * 2) = 0ull;
            ls += __shfl_xor(ls, 16); ls += __shfl_xor(ls, 32);
            f32x4 ot[4]; ot[0] = z4; ot[1] = z4; ot[2] = z4; ot[3] = z4;
            u32x4 vreg[4];
#define DA_VLOAD(ks5) do { _Pragma("unroll") for (int i2 = 0; i2 < 4; ++i2) { const int id = lane + 64 * i2, row = id >> 3, chn = id & 7, jk = j0 - 128 + 32 * (ks5) + row; \
                vreg[i2] = (u32x4){0u, 0u, 0u, 0u}; if (jk >= 0 && 32 * (ks5) + row < 144) vreg[i2] = *(const u32x4*)(Vb + (size_t)((jk << dsh) + r) * NAQKV + chn * 8); } } while (0)
            DA_VLOAD(0);
#pragma unroll 1
            for (int ks5 = 0; ks5 < 5; ++ks5) {
#pragma unroll
                for (int i2 = 0; i2 < 4; ++i2) { const int id = lane + 64 * i2, row = id >> 3, chn = id & 7; *(LAS u32x4*)(Vst + (row * VST + chn * 8) * 2) = vreg[i2]; }
                if (ks5 < 4) DA_VLOAD(ks5 + 1);
                asm volatile("s_waitcnt lgkmcnt(0)" ::: "memory");
                const bf16x8 yp = *(const LAS bf16x8*)(Pst + (tl * PST + 32 * ks5 + 8 * q4) * 2);
                const int qq = tl >> 2, pp = tl & 3;
#pragma unroll
                for (int ct = 0; ct < 4; ++ct) {
                    LAS const unsigned char* vp = Vst + ((8 * q4 + qq) * VST + 16 * ct + 4 * pp) * 2;
                    const bf16x8 xv = tr8(vp, vp + 4 * VST * 2);
                    ot[ct] = sc::mma(xv, yp, ot[ct]);
                }
                asm volatile("s_waitcnt lgkmcnt(0)" ::: "memory");
            }
#undef DA_VLOAD
            const int pidx = posq - p0;
            if (g == 0) {
#pragma unroll
                for (int ct = 0; ct < 4; ++ct) *(LAS f32x4*)(OA + pidx * OS + 16 * ct + 4 * q4) = ot[ct];
                if (q4 == 0) { MA[pidx] = mx; LA[pidx] = ls; }
            } else {
                const float mo = MA[pidx], lo = LA[pidx];
                const float mn = fmaxf(mo, mx), fo = __builtin_amdgcn_exp2f(mo - mn), fn = __builtin_amdgcn_exp2f(mx - mn);
                const float ln = lo * fo + ls * fn;
                if (g == 1) {
#pragma unroll
                    for (int ct = 0; ct < 4; ++ct) { LAS f32x4* op = (LAS f32x4*)(OA + pidx * OS + 16 * ct + 4 * q4); *op = *op * fo + ot[ct] * fn; }
                    asm volatile("s_waitcnt lgkmcnt(0)" ::: "memory");
                    if (q4 == 0) { MA[pidx] = mn; LA[pidx] = ln; }
                } else {
                    const float inv = 1.f / ln;
#pragma unroll
                    for (int ct = 0; ct < 4; ++ct) { const f32x4 o = (*(const LAS f32x4*)(OA + pidx * OS + 16 * ct + 4 * q4) * fo + ot[ct] * fn) * inv;
                        *(unsigned long long*)(ACATp + (size_t)posq * KCAT + 16 * ct + 4 * q4) = sc::pack4(o); }
                }
            }
        }
        asm volatile("s_waitcnt vmcnt(0) lgkmcnt(0)" ::: "memory"); __builtin_amdgcn_s_barrier(); asm volatile("" ::: "memory");
    }
}
}
#define XB_TMO      128
#define XB_XCNT(j)  (256  + 64 * (j))
#define XB_XSUB(j)  (1280 + 64 * (j))
#define XB_XGEN(j)  (2304 + 64 * (j))
#define XB_TOP      3328
#define XB_TOPGEN   3392
#define XCD_BAR_WORDS 3456
#define XB_SPIN_CAP (1u << 18)
__device__ __forceinline__ unsigned xb_ld(unsigned* p)              { return __hip_atomic_load(p, __ATOMIC_RELAXED, __HIP_MEMORY_SCOPE_AGENT); }
__device__ __forceinline__ unsigned xb_add(unsigned* p, unsigned v) { return __hip_atomic_fetch_add(p, v, __ATOMIC_RELAXED, __HIP_MEMORY_SCOPE_AGENT); }
__device__ __forceinline__ unsigned xb_xcc_id() { return (unsigned)__builtin_amdgcn_s_getreg((3 << 11) | 20) & 0xFu; }
#define XB_SPIN(cond, bar) do { unsigned _sp = 0; while (cond) { __builtin_amdgcn_s_sleep(1); \
    if ((++_sp & 255u) == 0u) { if (xb_ld(&(bar)[XB_TMO])) break; if (_sp > XB_SPIN_CAP) { atomicAdd(&(bar)[XB_TMO], 1u); break; } } } } while (0)
struct XcdBarrier { unsigned* bar; unsigned x; volatile LAS unsigned* st; };
__device__ __forceinline__ XcdBarrier xcd_barrier_post(unsigned* bar, volatile LAS unsigned* st, const int wv) {
    XcdBarrier b; b.bar = bar; b.x = xb_xcc_id(); b.st = st;
    if (wv == 0 && hw_lane() == 0) (void)xb_add(&bar[XB_XCNT(b.x)], 1u);
    return b;
}
__device__ __forceinline__ void xcd_barrier_complete(unsigned* bar, unsigned x, unsigned& nloc, unsigned& nx) {
    const unsigned G = gridDim.x * gridDim.y * gridDim.z;
    unsigned sum, cnt, mine, sp = 0u;
    for (;;) {
        sum = 0u; cnt = 0u; mine = 0u;
#pragma unroll
        for (unsigned j = 0; j < 16; ++j) { const unsigned c = xb_ld(&bar[XB_XCNT(j)]); sum += c; cnt += (c > 0u) ? 1u : 0u; mine = (j == x) ? c : mine; }
        if (sum == G) break;
        __builtin_amdgcn_s_sleep(1);
        if ((++sp & 255u) == 0u) { if (xb_ld(&bar[XB_TMO])) break; if (sp > XB_SPIN_CAP) { atomicAdd(&bar[XB_TMO], 1u); break; } }
    }
    nloc = mine > 0u ? mine : 1u; nx = cnt > 0u ? cnt : 1u;
}
__device__ __forceinline__ void xcd_barrier(const XcdBarrier& b, const int wv) {
    asm volatile("s_waitcnt vmcnt(0)" ::: "memory");
    __syncthreads();
    if (wv == 0 && hw_lane() == 0) {
        unsigned* bar = b.bar;
        __builtin_amdgcn_s_waitcnt(0);
        unsigned nloc = b.st[0], nx = b.st[1];
        if (nloc == 0u) { xcd_barrier_complete(bar, b.x, nloc, nx); b.st[0] = nloc; b.st[1] = nx; }
        const unsigned old = xb_add(&bar[XB_XSUB(b.x)], 1u);
        const unsigned gen = old / nloc;
        if (old + 1u == (gen + 1u) * nloc) {
            __builtin_amdgcn_fence(__ATOMIC_RELEASE, "agent");
            asm volatile("s_waitcnt vmcnt(0)" ::: "memory");
            const unsigned og = xb_add(&bar[XB_TOP], 1u);
            const unsigned tg = og / nx;
            if (og + 1u == (tg + 1u) * nx) xb_add(&bar[XB_TOPGEN], 1u);
            else XB_SPIN(xb_ld(&bar[XB_TOPGEN]) == tg, bar);
            __builtin_amdgcn_fence(__ATOMIC_ACQUIRE, "agent");
            xb_add(&bar[XB_XGEN(b.x)], 1u);
            asm volatile("s_waitcnt vmcnt(0)" ::: "memory");
        } else {
            XB_SPIN(xb_ld(&bar[XB_XGEN(b.x)]) == gen, bar);
            __builtin_amdgcn_fence(__ATOMIC_ACQUIRE, "agent");
            asm volatile("s_waitcnt vmcnt(0)" ::: "memory");
        }
    }
    __syncthreads();
}

#define p_XN ((bf16_t*)(a.ws + WS_XN))
#define p_RKV ((bf16_t*)(a.ws + WS_RKV))
#define p_LORA ((bf16_t*)(a.ws + WS_LORA))
#define p_AQKV ((bf16_t*)(a.ws + WS_AQKV))
#define p_GATES ((bf16_t*)a.out)
#define p_ACAT ((bf16_t*)(a.ws + WS_ACAT))
#define p_WST ((bf16_t*)(a.ws + WS_WST))
#define p_VWT ((bf16_t*)(a.ws + WS_VWT))
#define p_KV ((bf16_t*)(a.ws + WS_KV))
#define p_MEMN ((bf16_t*)(a.ws + WS_MEMN))
#define p_SS1 ((float*)(a.ws + WS_SS1))
#define p_SS2 ((float*)(a.ws + WS_SS2))
#define p_SS3 ((float*)(a.ws + WS_SS3))
#define p_H2B ((bf16_t*)(a.ws + WS_H2B))
#define p_MERGED ((bf16_t*)(a.ws + WS_MERGED))
#define p_H1B ((bf16_t*)(a.ws + WS_H1B))
#define p_PROB ((bf16_t*)(a.ws + WS_PROB))
#define p_ACT ((bf16_t*)(a.ws + WS_ACT))
#define p_WINT ((bf16_t*)(a.ws + WS_WINT))
#define p_PCATT ((bf16_t*)(a.ws + WS_PCATT))
#define p_WOUTT ((bf16_t*)(a.ws + WS_WOUTT))
#define p_W1T ((bf16_t*)(a.ws + WS_W1T))
#define p_W2T ((bf16_t*)(a.ws + WS_W2T))
#define p_WKVT ((bf16_t*)(a.ws + WS_WKVT))
#define p_WQB ((bf16_t*)(a.ws + WS_WQB))
#define p_WOT ((bf16_t*)(a.ws + WS_WOT))
#define p_OUT (a.out)
constexpr int MISC_OFF = LDSCTL_OFF;
__global__ void __launch_bounds__(NTHREADS, 2) mk_fwd(Args a) {
    extern __shared__ __attribute__((aligned(16))) unsigned char lds_raw[];
    float* lds = (float*)lds_raw;
    LAS unsigned char* ldsl = (LAS unsigned char*)lds_raw;
    const int wave_s = __builtin_amdgcn_readfirstlane((int)threadIdx.x >> 6);
    const int tid = wave_s * 64 + hw_lane(), lane = tid & 63, wave = wave_s;
    const int G = gridDim.x, bid = blockIdx.x;
    const int gw = bid * NWAVES + wave, NGW = G * NWAVES;
    unsigned char* ws = a.ws;
    LAS float* scr = (LAS float*)(ldsl + wave * 16384);

    for (int u = tid; u < (LDS_BYTES - LDSCTL_OFF) / 4; u += NTHREADS) ((LAS unsigned*)(ldsl + LDSCTL_OFF))[u] = 0u;
    __syncthreads();
    XcdBarrier bar = xcd_barrier_post((unsigned*)(ws + WS_CTL) + 4096, (volatile LAS unsigned*)(ldsl + MISC_OFF) + 8, wave_s);
    cg::grid_group grid = cg::this_grid();

    {
        {
            const float* W = a.in[I_WIN];
            for (int it = gw; it < 16 * 241; it += NGW) { const int kb = it / 241, nb = it % 241, c = nb * 32;
                const int drow = (c < C_LORA) ? c : (c < C_AQ) ? 7424 + (c - C_LORA) : (c < C_GATE) ? 5120 + (c - C_AQ) : 3072 + (c - C_GATE);
                transpose_item(W, NIN, kb * 64, c, p_WINT, D, drow, 0, nullptr, scr, lane); }
            for (int i = gw * 64 + lane; i < 224 * D / 8; i += NGW * 64) *(u32x4*)(p_WINT + (size_t)7712 * D + (size_t)i * 8) = (u32x4){0u, 0u, 0u, 0u};
        }
        for (int i = gw * 64 + lane; i < 1024 * 288; i += NGW * 64) {
            if (i < 1024 * 64) { const int n = i >> 6, c = i & 63; ((bf16_t*)(a.ws + WS_LW2T))[i] = f2bf(a.in[I_W2][c * 1024 + n]); }
            else if (i < 2 * 1024 * 64) { const int i2 = i - 1024 * 64, n = i2 >> 6, c = i2 & 63; ((bf16_t*)(a.ws + WS_LA2T))[i2] = f2bf(a.in[I_A2][c * 1024 + n]); }
            else { const int i2 = i - 2 * 1024 * 64, n = i2 / 160, c = i2 % 160; ((bf16_t*)(a.ws + WS_LG2T))[i2] = f2bf(a.in[I_G2][c * 1024 + n]); }
        }
        transpose_matrix(a.in[I_WKV], 1024, 2048, p_WKVT, D, 0, nullptr, scr, lane, gw, NGW);
        transpose_matrix(a.in[I_PRWKV], 1024, 1024, p_PCATT, KCAT, 0, nullptr, scr, lane, gw, NGW);
        transpose_matrix(a.in[I_PATTN], 256, 1024, p_PCATT, KCAT, 1024, nullptr, scr, lane, gw, NGW);
        transpose_matrix(a.in[I_WOUT], 1024, 1024, p_WOUTT, D, 0, nullptr, scr, lane, gw, NGW);
        transpose_matrix(a.in[I_WO], 1024, 1024, p_WOT, D, 0, nullptr, scr, lane, gw, NGW);
        { const float* WQ = a.in[I_WQ]; for (int i = gw * 64 + lane; i < D * D / 8; i += NGW * 64) { const f32x4 v0 = *(const f32x4*)(WQ + (size_t)i * 8), v1 = *(const f32x4*)(WQ + (size_t)i * 8 + 4); *(u32x4*)(p_WQB + (size_t)i * 8) = ge::pack8(v0, v1); } }
        for (int r = gw; r < M + 512; r += NGW) {
            const bool ism = r >= M; const int rr = ism ? r - M : r;
            const float* src = (ism ? a.in[I_MEM] : a.in[I_X]) + (size_t)rr * D; const float* g = ism ? a.in[I_NMEM] : a.in[I_NMIX];
            bf16_t* dst = (ism ? p_MEMN : p_XN) + (size_t)rr * D;
            f32x4 v[4]; float ss = 0.f;
#pragma unroll
            for (int i = 0; i < 4; ++i) { v[i] = *(const f32x4*)(src + (lane + 64 * i) * 4); ss += (v[i][0] * v[i][0] + v[i][1] * v[i][1]) + (v[i][2] * v[i][2] + v[i][3] * v[i][3]); }
            const float rstd = rsqrtf(wave_sum(ss) * (1.f / D) + 1e-6f);
#pragma unroll
            for (int i = 0; i < 4; ++i) { const f32x4 gg = *(const f32x4*)(g + (lane + 64 * i) * 4), o = v[i] * rstd * gg;
                unsigned long long w = (unsigned long long)ge::cvt_pk_bf16(o[0], o[1]) | ((unsigned long long)ge::cvt_pk_bf16(o[2], o[3]) << 32);
                *(unsigned long long*)(dst + (lane + 64 * i) * 4) = w; }
        }
    }
    if (a.ph_lo != 0) grid.sync();
    xcd_barrier(bar, wave_s);
    {
        ge::SchedProj S; S.o.init(64, 31, G, bid); S.XN = (const char*)p_XN; S.WINT = (const char*)p_WINT; S.MEMN = (const char*)p_MEMN; S.WKVT = (const char*)p_WKVT;
        ge::EpiProj E; E.hook_t = -1; E.RKV = p_RKV; E.GATES = p_GATES; E.AQKV = p_AQKV; E.LORA = p_LORA; E.KV = p_KV; E.BND = (bf16_t*)(a.ws + WS_BND);
        ge::gemm_phase<ge::EpiProj, ge::SchedProj, true>(ldsl, D, D, 16, S, E, wave_s);
    }
    xcd_barrier(bar, wave_s);
    {
        int tidp = wave_s * 64 + hw_lane(); asm volatile("" : "+v"(tidp));
        const float* mu = a.in[I_MU]; bf16_t* LOR = p_LORA; const bf16_t* BNDp = (const bf16_t*)(a.ws + WS_BND);
        for (int tile = bid; tile < M / 64; tile += G) {
            u32x4 res[5];
            if (tidp < 468) {
                const int c8 = tidp % 36, g5 = tidp / 36; const size_t m0 = (size_t)tile * 64;
                const f32x4 m0v = *(const f32x4*)(mu + C_LORA + c8 * 8), m1v = *(const f32x4*)(mu + C_LORA + c8 * 8 + 4);
                f32x4 p0 = (f32x4){0.f, 0.f, 0.f, 0.f}, p1 = p0;
                if (g5 > 0) ge::unpack8(*(const u32x4*)(LOR + (m0 + 5 * g5 - 1) * NLORA + c8 * 8), p0, p1);
                else if ((tile & 127) != 0) ge::unpack8(*(const u32x4*)(BNDp + (size_t)(tile - 1) * NLORA + c8 * 8), p0, p1);
#pragma unroll
                for (int i = 0; i < 5; ++i) {
                    const int row = 5 * g5 + i;
                    if (row < 64) {
                        f32x4 c0, c1; ge::unpack8(*(const u32x4*)(LOR + (m0 + row) * NLORA + c8 * 8), c0, c1);
                        f32x4 s0 = c0 + m0v * (p0 - c0), s1 = c1 + m1v * (p1 - c1);
                        if (c8 < 8) {
#pragma unroll
                            for (int j = 0; j < 4; ++j) { s0[j] = 1.f - 2.f * __builtin_amdgcn_rcpf(1.f + __expf(2.f * s0[j])); s1[j] = 1.f - 2.f * __builtin_amdgcn_rcpf(1.f + __expf(2.f * s1[j])); }
                        } else if (c8 >= 16) {
#pragma unroll
                            for (int j = 0; j < 4; ++j) { s0[j] = ge::fast_sigmoid(s0[j]); s1[j] = ge::fast_sigmoid(s1[j]); }
                        }
                        res[i] = ge::pack8(s0, s1); p0 = c0; p1 = c1;
                    }
                }
            }
            __syncthreads();
            if (tidp < 468) { const int c8 = tidp % 36, g5 = tidp / 36;
#pragma unroll
                for (int i = 0; i < 5; ++i) if (5 * g5 + i < 64) *(u32x4*)(LOR + ((size_t)tile * 64 + 5 * g5 + i) * NLORA + c8 * 8) = res[i]; }
        }
    }
    xcd_barrier(bar, wave_s);
    {
        const int bh = bid >> 3, seg = bid & 7;
        if (seg < 7) sc::scan_seg<true>(a, ldsl, bh >> 4, bh & 15, seg, wave_s);
        else {
#pragma unroll 1
            for (int k2 = 0; k2 < 2; ++k2) {
                const bool isw = (k2 == 0); const int u = bh, pm = u >> 2, pn = u & 3;
                ge::SchedOne S; S.has = true; S.u.pm = pm; S.u.pn = pn;
                S.u.A = isw ? (const char*)(p_KV + (size_t)((pm >> 2) * 256) * 2048 + (pm & 3) * 256) : (const char*)(p_WOT + (size_t)((pm & 3) * 256) * 1024 + pn * 256);
                S.u.B = isw ? (const char*)(p_WQB + (size_t)(pn * 256) * 1024 + (pm & 3) * 256) : (const char*)(p_KV + (size_t)((pm >> 2) * 256) * 2048 + 1024 + pn * 256);
                ge::EpiScaleCol E; E.hook_t = -1; E.colscale = a.in[I_NX]; E.mul = isw ? 0.0625f : 1.f; E.use_cs = isw; E.out = isw ? p_WST : p_VWT; E.ld = 1024;
                ge::gemm_phase<ge::EpiScaleCol, ge::SchedOne, false>(ldsl, isw ? 2048 : 1024, isw ? 1024 : 2048, 4, S, E, wave_s);
                __syncthreads();
            }
            da::attn_item(a, ldsl, bid >> 7, (bid >> 5) & 3, (bid & 31) * 256, wave_s);
        }
    }
    xcd_barrier(bar, wave_s);
    {
        const int bh = bid >> 3, seg = bid & 7;
        sc::scan_seg<false>(a, ldsl, bh >> 4, bh & 15, seg, wave_s);
        __syncthreads();
        if (seg < 7) da::attn_item(a, ldsl, bid >> 7, (bid >> 5) & 3, (bid & 31) * 256, wave_s);
    }
    xcd_barrier(bar, wave_s);
    {
        ge::Sched S; S.o.init(64, 4, G, bid); S.A = (const char*)p_ACAT; S.B = (const char*)p_PCATT; S.a_tile = (size_t)256 * KCAT * 2; S.b_tile = (size_t)256 * KCAT * 2; S.b_batch = 0;
        ge::EpiMerged E; E.hook_t = 16; E.GATES = p_GATES; E.MERGED = p_MERGED;
        ge::gemm_phase<ge::EpiMerged, ge::Sched, false>(ldsl, KCAT, KCAT, 20, S, E, wave_s);
        __syncthreads();
        int tid2 = wave_s * 64 + hw_lane(); asm volatile("" : "+v"(tid2));
        const int lane2 = tid2 & 63, wave2 = tid2 >> 6; LAS float* scr2 = (LAS float*)(ldsl + wave2 * 16384);
        transpose_matrix(a.in[I_W1], 1024, 4096, p_W1T, D, 0, a.in[I_NFFN], scr2, lane2, bid * NWAVES + wave2, NGW);
        transpose_matrix(a.in[I_FW2], 4096, 1024, p_W2T, FF, 0, nullptr, scr2, lane2, bid * NWAVES + wave2, NGW);
    }
    xcd_barrier(bar, wave_s);
    {
        ge::Sched S; S.o.init(64, 4, G, bid); S.A = (const char*)p_MERGED; S.B = (const char*)p_WOUTT; S.a_tile = (size_t)256 * D * 2; S.b_tile = (size_t)256 * D * 2; S.b_batch = 0;
        ge::EpiResid<false> E; E.hook_t = -1; E.base = a.in[I_X]; E.baseb = nullptr; E.out = nullptr; E.hb = p_H1B; E.SS = p_SS1;
        ge::gemm_phase<ge::EpiResid<false>, ge::Sched, false>(ldsl, D, D, 16, S, E, wave_s);
    }
    xcd_barrier(bar, wave_s);
    {
        ge::Sched S; S.o.init(64, 4, G, bid); S.A = (const char*)p_H1B; S.B = (const char*)p_WST; S.a_tile = (size_t)256 * D * 2; S.b_tile = (size_t)256 * D * 2; S.b_batch = (size_t)1024 * 1024 * 2;
        ge::EpiSoftmax E; E.hook_t = -1; E.SS = p_SS1; E.PROB = p_PROB;
        ge::gemm_phase<ge::EpiSoftmax, ge::Sched, false>(ldsl, D, D, 16, S, E, wave_s);
    }
    xcd_barrier(bar, wave_s);
    {
        ge::Sched S; S.o.init(64, 4, G, bid); S.A = (const char*)p_PROB; S.B = (const char*)p_VWT; S.a_tile = (size_t)256 * D * 2; S.b_tile = (size_t)256 * D * 2; S.b_batch = (size_t)1024 * 1024 * 2;
        ge::EpiResid<true> E; E.hook_t = -1; E.base = nullptr; E.baseb = p_H1B; E.out = nullptr; E.hb = p_H2B; E.SS = p_SS2;
        ge::gemm_phase<ge::EpiResid<true>, ge::Sched, false>(ldsl, D, D, 16, S, E, wave_s);
    }
    xcd_barrier(bar, wave_s);
    {
        ge::Sched S; S.o.init(64, 16, G, bid); S.A = (const char*)p_H2B; S.B = (const char*)p_W1T; S.a_tile = (size_t)256 * D * 2; S.b_tile = (size_t)256 * D * 2; S.b_batch = 0;
        ge::EpiRelu2 E; E.hook_t = -1; E.SS = p_SS2; E.ACT = p_ACT;
        ge::gemm_phase<ge::EpiRelu2, ge::Sched, true>(ldsl, D, D, 16, S, E, wave_s);
    }
    xcd_barrier(bar, wave_s);
    {
        ge::Sched S; S.o.init(64, 4, G, bid); S.A = (const char*)p_ACT; S.B = (const char*)p_W2T; S.a_tile = (size_t)256 * FF * 2; S.b_tile = (size_t)256 * FF * 2; S.b_batch = 0;
        ge::EpiResid<true> E; E.hook_t = -1; E.base = nullptr; E.baseb = p_H2B; E.out = p_OUT; E.hb = nullptr; E.SS = p_SS3;
        ge::gemm_phase<ge::EpiResid<true>, ge::Sched, false>(ldsl, FF, FF, 64, S, E, wave_s);
    }
    xcd_barrier(bar, wave_s);
    {
        const float* g = a.in[I_NFIN];
        int tid3 = wave_s * 64 + hw_lane(); asm volatile("" : "+v"(tid3));
        const int lane = tid3 & 63;
        for (int r = bid * NWAVES + (tid3 >> 6); r < M; r += NGW) {
            const float rstd = ge::rstd_from_ss(p_SS3, (size_t)r);
#pragma unroll
            for (int i = 0; i < 4; ++i) { const size_t o = (size_t)r * D + (lane + 64 * i) * 4; const f32x4 v = *(const f32x4*)(p_OUT + o), gg = *(const f32x4*)(g + (lane + 64 * i) * 4); *(f32x4*)(p_OUT + o) = v * rstd * gg; }
        }
    }
}

extern "C" void kernel_launch(void* const* d_in, const int* in_sizes, int n_in, void* d_out, int out_size, void* d_ws, size_t ws_size, hipStream_t stream) {
    static int grid = 0;
    if (grid == 0) {
        if (n_in != 27 || out_size != M * D || ws_size < 256 * MiB) { fprintf(stderr, "kernel_launch: unexpected shapes (n_in %d out %d ws %zu)\n", n_in, out_size, ws_size); grid = -1; return; }
        int dev = 0, cus = 0, per_cu = 0;
        if (hipGetDevice(&dev) != hipSuccess || hipDeviceGetAttribute(&cus, hipDeviceAttributeMultiprocessorCount, dev) != hipSuccess) { fprintf(stderr, "kernel_launch: device query failed\n"); grid = -1; return; }
        if (hipFuncSetAttribute((const void*)mk_fwd, hipFuncAttributeMaxDynamicSharedMemorySize, LDS_BYTES) != hipSuccess) { fprintf(stderr, "kernel_launch: hipFuncSetAttribute failed\n"); grid = -1; return; }
        if (hipOccupancyMaxActiveBlocksPerMultiprocessor(&per_cu, (const void*)mk_fwd, NTHREADS, LDS_BYTES) != hipSuccess || per_cu < 1) { fprintf(stderr, "kernel_launch: occupancy query says %d blocks per CU\n", per_cu); per_cu = 1; }
        (void)hipGetLastError();
        grid = cus;
        if (grid != 256) fprintf(stderr, "kernel_launch: %d CUs; this kernel is built for 256\n", grid);
    }
    if (grid < 0) return;
    (void)hipMemsetAsync((char*)d_ws + WS_CTL, 0, 64 * 1024, stream);
    Args a{};
    for (int i = 0; i < 27; ++i) a.in[i] = (const float*)d_in[i];
    a.out = (float*)d_out; a.ws = (unsigned char*)d_ws;
    void* kargs[] = {&a};
    hipError_t e = hipLaunchCooperativeKernel((const void*)mk_fwd, dim3(grid), dim3(NTHREADS), kargs, LDS_BYTES, stream);
    if (e != hipSuccess) fprintf(stderr, "kernel_launch: cooperative launch failed: %s (grid %d)\n", hipGetErrorString(e), grid);
}
```
